# Optimizing an MI355X kernel written in HIP

```python
import jax, jax.numpy as jnp
from jax import lax
import numpy as np

D_MODEL = 1024
BATCH = 16
SEQ = 2048
DEPTH = 1

HEAD_DIM = 64
SB_HEADS = 8
SB_W = SB_HEADS * HEAD_DIM
CV_W = D_MODEL // 4
CV_GROUPS = CV_W // HEAD_DIM
CONV_K = 31
MX_HEADS = 4
MX_W = MX_HEADS * HEAD_DIM
MIX_W = SB_W + CV_W + MX_W
IN_W = 3 * SB_W + 2 * CV_W + MX_W
N_MEM = 256
Q_BLOCK = 128
N_EXPERTS = 32
TOP_K = 4
D_FF = D_MODEL
SWIGLU_ALPHA = 1.702
SWIGLU_LIMIT = 7.0
MOE_BLOCK = 128
EPS = 1e-6

kernel_name = "hybrid_sb_conformer_memx_moe"


def rms_norm(x, g):
    xf = x.astype(jnp.float32)
    y = xf * lax.rsqrt(jnp.mean(xf * xf, axis=-1, keepdims=True) + EPS)
    return (y * g.astype(jnp.float32)).astype(x.dtype)


def layer_norm(x, g, b):
    xf = x.astype(jnp.float32)
    mu = jnp.mean(xf, axis=-1, keepdims=True)
    var = jnp.mean(jnp.square(xf - mu), axis=-1, keepdims=True)
    y = (xf - mu) * lax.rsqrt(var + EPS)
    return (y * g.astype(jnp.float32) + b.astype(jnp.float32)).astype(x.dtype)


def split_heads(t, n_heads):
    B, S, _ = t.shape
    return t.reshape(B, S, n_heads, -1).transpose(0, 2, 1, 3)


def merge_heads(t):
    B, H, S, Dh = t.shape
    return t.transpose(0, 2, 1, 3).reshape(B, S, H * Dh)


def stick_breaking_attention(q, k, v):
    B, H, S, Dh = q.shape
    scale = Dh ** -0.5
    outs = []
    for qb in range(S // Q_BLOCK):
        t0 = qb * Q_BLOCK
        kv_len = t0 + Q_BLOCK
        qs = q[:, :, t0:kv_len]
        ks = k[:, :, :kv_len]
        vs = v[:, :, :kv_len]
        z = jnp.einsum('bhqd,bhkd->bhqk', qs, ks).astype(jnp.float32) * scale
        t_idx = t0 + jnp.arange(Q_BLOCK)[:, None]
        s_idx = jnp.arange(kv_len)[None, :]
        mask = s_idx < t_idx
        log_beta = jax.nn.log_sigmoid(z)
        log_1m_beta = jnp.where(mask, jax.nn.log_sigmoid(-z), 0.0)
        after = lax.cumsum(log_1m_beta, axis=3, reverse=True) - log_1m_beta
        a = jnp.where(mask, jnp.exp(log_beta + after), 0.0)
        outs.append(jnp.einsum('bhqk,bhkd->bhqd', a.astype(vs.dtype), vs))
    return jnp.concatenate(outs, axis=2)


def conformer_conv(glu_in, b_glu, w_dw, b_dw, g_ln, b_ln, w_pw2, b_pw2):
    a, gt = jnp.split(glu_in + b_glu, 2, axis=-1)
    u = a * jax.nn.sigmoid(gt)
    u = lax.conv_general_dilated(
        u, w_dw.astype(u.dtype), window_strides=(1,), padding=[(CONV_K - 1, 0)],
        dimension_numbers=('NWC', 'WIO', 'NWC'), feature_group_count=CV_W) + b_dw
    u = layer_norm(u, g_ln, b_ln)
    u = jax.nn.silu(u)
    return u @ w_pw2 + b_pw2


def memory_cross_attention(q_mx, mem, g_mem, w_mem_kv):
    mem_n = rms_norm(mem, g_mem)
    k_m, v_m = jnp.split(mem_n @ w_mem_kv, 2, axis=-1)
    q = split_heads(q_mx, MX_HEADS)
    k = split_heads(k_m, MX_HEADS)
    v = split_heads(v_m, MX_HEADS)
    s = jnp.einsum('bhsd,bhmd->bhsm', q, k).astype(jnp.float32) * (HEAD_DIM ** -0.5)
    p = jax.nn.softmax(s, axis=-1).astype(v.dtype)
    return merge_heads(jnp.einsum('bhsm,bhmd->bhsd', p, v))


def hybrid_mixer(xn, mem, w_in, b_glu, w_dw, b_dw, g_cv_ln, b_cv_ln, w_pw2, b_pw2,
                 g_mem, w_mem_kv, g_sb_out, g_cv_out, g_mx_out, w_out):
    proj = xn @ w_in
    q_sb, k_sb, v_sb, glu_in, q_mx = jnp.split(
        proj, [SB_W, 2 * SB_W, 3 * SB_W, 3 * SB_W + 2 * CV_W], axis=-1)
    o_sb = merge_heads(stick_breaking_attention(
        split_heads(q_sb, SB_HEADS), split_heads(k_sb, SB_HEADS), split_heads(v_sb, SB_HEADS)))
    o_cv = conformer_conv(glu_in, b_glu, w_dw, b_dw, g_cv_ln, b_cv_ln, w_pw2, b_pw2)
    o_mx = memory_cross_attention(q_mx, mem, g_mem, w_mem_kv)
    cat = jnp.concatenate([rms_norm(o_sb, g_sb_out), rms_norm(o_cv, g_cv_out),
                           rms_norm(o_mx, g_mx_out)], axis=-1)
    return cat @ w_out


def moe_ffn(xn, w_router, b_router, w_gu, b_gu, w_down, b_down):
    T, D = xn.shape
    logits = (xn @ w_router + b_router).astype(jnp.float32)
    top_val, top_idx = lax.top_k(logits, TOP_K)
    gates = jax.nn.softmax(top_val, axis=-1)
    M = T * TOP_K
    e_flat = top_idx.reshape(M).astype(jnp.int32)
    tok_flat = jnp.broadcast_to(jnp.arange(T, dtype=jnp.int32)[:, None], (T, TOP_K)).reshape(M)
    g_flat = gates.reshape(M)
    order = jnp.argsort(e_flat)
    e_sorted = e_flat[order]
    counts = jnp.bincount(e_flat, length=N_EXPERTS)
    starts = jnp.cumsum(counts) - counts
    padded = ((counts + MOE_BLOCK - 1) // MOE_BLOCK) * MOE_BLOCK
    pends = jnp.cumsum(padded)
    pstarts = pends - padded
    dest = pstarts[e_sorted] + (jnp.arange(M, dtype=jnp.int32) - starts[e_sorted])
    P = (-(-M // MOE_BLOCK)) * MOE_BLOCK + N_EXPERTS * MOE_BLOCK
    NB = P // MOE_BLOCK
    row_tok = jnp.zeros((P,), jnp.int32).at[dest].set(tok_flat[order])
    row_gate = jnp.zeros((P,), jnp.float32).at[dest].set(g_flat[order])
    block_exp = jnp.minimum(
        jnp.searchsorted(pends, jnp.arange(NB) * MOE_BLOCK, side='right'), N_EXPERTS - 1)
    xs = xn[row_tok].reshape(NB, MOE_BLOCK, D)

    def expert_block(args):
        xb, e = args
        gate, up = jnp.split(xb @ w_gu[e] + b_gu[e], 2, axis=-1)
        gate = jnp.minimum(gate, SWIGLU_LIMIT)
        up = jnp.clip(up, -SWIGLU_LIMIT, SWIGLU_LIMIT)
        h = (up + 1.0) * (gate * jax.nn.sigmoid(SWIGLU_ALPHA * gate))
        return h @ w_down[e] + b_down[e]

    ys = lax.map(expert_block, (xs, block_exp)).reshape(P, D)
    ys = ys * row_gate[:, None].astype(ys.dtype)
    return jnp.zeros((T, D), ys.dtype).at[row_tok].add(ys)


def setup_inputs(seed: int = 0) -> dict:
    key = jax.random.key(seed)
    ks = jax.random.split(key, 32)
    f32 = jnp.float32
    L = DEPTH

    def nrm(k, shape, scale):
        return jax.random.normal(k, shape, f32) * scale

    def gain(k, shape):
        return 1.0 + 0.02 * jax.random.normal(k, shape, f32)

    return {
        "x": jax.random.normal(ks[0], (BATCH, SEQ, D_MODEL), f32),
        "mem": jax.random.normal(ks[1], (BATCH, N_MEM, D_MODEL), f32),
        "g_attn_norm": gain(ks[2], (L, D_MODEL)),
        "w_in": nrm(ks[3], (L, D_MODEL, IN_W), D_MODEL ** -0.5),
        "b_glu": nrm(ks[4], (L, 2 * CV_W), 0.02),
        "w_dw": nrm(ks[5], (L, CONV_K, 1, CV_W), CONV_K ** -0.5),
        "b_dw": nrm(ks[6], (L, CV_W), 0.02),
        "g_cv_ln": gain(ks[7], (L, CV_W)),
        "b_cv_ln": nrm(ks[8], (L, CV_W), 0.02),
        "w_pw2": nrm(ks[9], (L, CV_W, CV_W), CV_W ** -0.5),
        "b_pw2": nrm(ks[10], (L, CV_W), 0.02),
        "g_mem": gain(ks[11], (L, D_MODEL)),
        "w_mem_kv": nrm(ks[12], (L, D_MODEL, 2 * MX_W), D_MODEL ** -0.5),
        "g_sb_out": gain(ks[13], (L, SB_W)),
        "g_cv_out": gain(ks[14], (L, CV_W)),
        "g_mx_out": gain(ks[15], (L, MX_W)),
        "w_out": nrm(ks[16], (L, MIX_W, D_MODEL), MIX_W ** -0.5),
        "g_ffn_norm": gain(ks[17], (L, D_MODEL)),
        "w_router": nrm(ks[18], (L, D_MODEL, N_EXPERTS), D_MODEL ** -0.5),
        "b_router": nrm(ks[19], (L, N_EXPERTS), 0.01),
        "w_gu": nrm(ks[20], (L, N_EXPERTS, D_MODEL, 2 * D_FF), D_MODEL ** -0.5),
        "b_gu": nrm(ks[21], (L, N_EXPERTS, 2 * D_FF), 0.02),
        "w_down": nrm(ks[22], (L, N_EXPERTS, D_FF, D_MODEL), D_FF ** -0.5),
        "b_down": nrm(ks[23], (L, N_EXPERTS, D_MODEL), 0.02),
        "g_final": gain(ks[24], (D_MODEL,)),
    }


def reference(x, mem, g_attn_norm, w_in, b_glu, w_dw, b_dw, g_cv_ln, b_cv_ln, w_pw2, b_pw2,
              g_mem, w_mem_kv, g_sb_out, g_cv_out, g_mx_out, w_out, g_ffn_norm,
              w_router, b_router, w_gu, b_gu, w_down, b_down, g_final):
    B, S, D = x.shape
    h = x
    for l in range(DEPTH):
        xn = rms_norm(h, g_attn_norm[l])
        h = h + hybrid_mixer(xn, mem, w_in[l], b_glu[l], w_dw[l], b_dw[l], g_cv_ln[l],
                             b_cv_ln[l], w_pw2[l], b_pw2[l], g_mem[l], w_mem_kv[l],
                             g_sb_out[l], g_cv_out[l], g_mx_out[l], w_out[l])
        hn = rms_norm(h, g_ffn_norm[l]).reshape(B * S, D)
        h = h + moe_ffn(hn, w_router[l], b_router[l], w_gu[l], b_gu[l],
                        w_down[l], b_down[l]).reshape(B, S, D)
    return rms_norm(h, g_final)
```

```cpp
#include <hip/hip_runtime.h>
#include <cstdio>
#include <cstdint>

typedef unsigned short bf16;
typedef unsigned v4u __attribute__((ext_vector_type(4)));
typedef float f32x4 __attribute__((ext_vector_type(4)));

constexpr int NB = 16, S = 2048, T = NB * S, D = 1024;
constexpr int SBH = 8, HD = 64, SBW = 512, CVW = 256, MXH = 4, MXW = 256, INW = 2304, NMEM = 256, TM = NB * NMEM;
constexpr int NE = 32, TOPK = 4, DFF = 1024, CONVK = 31;
constexpr int PMAX = T * TOPK + NE * 256;
constexpr float EPS = 1e-6f;
constexpr float SB_EXIT = -60.0f;

constexpr size_t MiB = 1u << 20;
constexpr size_t WS_CTL = 0, CTL_BYTES = 1 * MiB;
constexpr size_t WS_WIN = 2 * MiB;
constexpr size_t WS_WOUT = 7 * MiB;
constexpr size_t WS_WMKV = 9 * MiB;
constexpr size_t WS_WPW2 = 10 * MiB;
constexpr size_t WS_WGU = 16 * MiB;
constexpr size_t WS_WDN = 144 * MiB;
constexpr size_t WS_MEMN = 208 * MiB;
constexpr size_t WS_MEMK = 216 * MiB;
constexpr size_t WS_MEMVT = 218 * MiB;
constexpr size_t WS_LIST = 220 * MiB;
constexpr size_t WS_TOKE = 224 * MiB;
constexpr size_t WS_TOKS = 224 * MiB + 512 * 1024;
constexpr size_t WS_TOKG = 225 * MiB;
constexpr size_t WS_HN = 226 * MiB;
constexpr size_t WS_XN = 290 * MiB;
constexpr size_t WS_Q = 354 * MiB;
constexpr size_t WS_K = 386 * MiB;
constexpr size_t WS_VT = 418 * MiB;
constexpr size_t WS_GLU = 450 * MiB;
constexpr size_t WS_QMX = 482 * MiB;
constexpr size_t WS_CAT = 498 * MiB;
constexpr size_t WS_HACT = 562 * MiB;
constexpr size_t WS_Y = 290 * MiB;
constexpr size_t WS_END = 834 * MiB;
constexpr size_t WS_OSB = 562 * MiB;
constexpr size_t WS_OCV = 626 * MiB;
constexpr size_t WS_OMX = 658 * MiB;
static_assert((size_t)PMAX * 1024 * 2 == 272 * MiB, "padded rows");
constexpr int CW_CNT = 64;

__device__ __forceinline__ float bf2f(unsigned v) { return __uint_as_float(v << 16); }
__device__ __forceinline__ unsigned f2bf(float f) { unsigned u = __float_as_uint(f); return (u + 0x7fffu + ((u >> 16) & 1u)) >> 16; }
__device__ __forceinline__ unsigned pk2(float lo, float hi) { return f2bf(lo) | (f2bf(hi) << 16); }
__device__ __forceinline__ float wave_sum(float v) {
#pragma unroll
    for (int o = 1; o < 64; o <<= 1) v += __shfl_xor(v, o);
    return v;
}
__device__ __forceinline__ float wave_max(float v) {
#pragma unroll
    for (int o = 1; o < 64; o <<= 1) v = fmaxf(v, __shfl_xor(v, o));
    return v;
}

__device__ __forceinline__ void transpose_item(const float* W, int K, int N, bf16* WT, int k0, int n0, int dstrow0, const float* kscale, float* scr, int lane) {
#pragma unroll 8
    for (int i = 0; i < 32; ++i) { const int kk = 2 * i + (lane >> 5); float v = W[(size_t)(k0 + kk) * N + n0 + (lane & 31)]; if (kscale) v *= kscale[k0 + kk]; scr[kk * 33 + (lane & 31)] = v; }
    asm volatile("s_waitcnt lgkmcnt(0)" ::: "memory");
    const int c = lane & 7;
#pragma unroll
    for (int j = 0; j < 4; ++j) { const int n = (lane >> 3) + 8 * j; const float* s = scr + (8 * c) * 33 + n;
        v4u o; o.x = pk2(s[0 * 33], s[1 * 33]); o.y = pk2(s[2 * 33], s[3 * 33]); o.z = pk2(s[4 * 33], s[5 * 33]); o.w = pk2(s[6 * 33], s[7 * 33]);
        *(v4u*)(WT + (size_t)(dstrow0 + n) * K + k0 + 8 * c) = o; }
    asm volatile("s_waitcnt lgkmcnt(0)" ::: "memory");
}
__device__ __forceinline__ void rms_row_to_bf16(const float* xrow, const float* g, bf16* orow, int lane) {
    const f32x4* xr = (const f32x4*)xrow + lane; const f32x4* gr = (const f32x4*)g + lane;
    f32x4 v[4]; float s = 0.f;
#pragma unroll
    for (int j = 0; j < 4; ++j) { v[j] = xr[64 * j]; s += (v[j].x * v[j].x + v[j].y * v[j].y) + (v[j].z * v[j].z + v[j].w * v[j].w); }
    const float rs = 1.0f / sqrtf(wave_sum(s) * (1.f / D) + EPS);
    unsigned long long* o8 = (unsigned long long*)orow + lane;
#pragma unroll
    for (int j = 0; j < 4; ++j) { const f32x4 gg = gr[64 * j]; o8[64 * j] = (unsigned long long)pk2(v[j].x * rs * gg.x, v[j].y * rs * gg.y) | ((unsigned long long)pk2(v[j].z * rs * gg.z, v[j].w * rs * gg.w) << 32); }
}

struct Ptrs {
    const float* in[25]; float* out; unsigned char* ws;
};

__global__ void __launch_bounds__(256) k_prologue(Ptrs p) {
    __shared__ float scr_all[4][64 * 33];
    const int lane = threadIdx.x & 63, wave = threadIdx.x >> 6;
    float* scr = scr_all[wave];
    const int gw = blockIdx.x * 4 + wave, NGW = gridDim.x * 4;
    unsigned char* ws = p.ws;
    constexpr int I_IN = 16 * 72, I_OUT = 16 * 32, I_MKV = 16 * 16, I_PW2 = 4 * 8, I_GU = 32 * 16 * 64, I_DN = 32 * 16 * 32;
    constexpr int NIT = I_IN + I_OUT + I_MKV + I_PW2 + I_GU + I_DN;
    for (int it = gw; it < NIT; it += NGW) {
        int r = it;
        if (r < I_IN) { const int kb = r / 72, nb = r % 72; transpose_item(p.in[3], 1024, INW, (bf16*)(ws + WS_WIN), 64 * kb, 32 * nb, 32 * nb, nullptr, scr, lane); continue; } r -= I_IN;
        if (r < I_OUT) { const int kb = r / 32, nb = r % 32; const int k0 = 64 * kb;
            const float* ks = k0 < 512 ? p.in[13] : (k0 < 768 ? p.in[14] - 512 : p.in[15] - 768);
            transpose_item(p.in[16], 1024, 1024, (bf16*)(ws + WS_WOUT), k0, 32 * nb, 32 * nb, ks, scr, lane); continue; } r -= I_OUT;
        if (r < I_MKV) { const int kb = r / 16, nb = r % 16; transpose_item(p.in[12], 1024, 512, (bf16*)(ws + WS_WMKV), 64 * kb, 32 * nb, 32 * nb, nullptr, scr, lane); continue; } r -= I_MKV;
        if (r < I_PW2) { const int kb = r / 8, nb = r % 8; transpose_item(p.in[9], 256, 256, (bf16*)(ws + WS_WPW2), 64 * kb, 32 * nb, 32 * nb, nullptr, scr, lane); continue; } r -= I_PW2;
        if (r < I_GU) { const int e = r / 1024, q = r % 1024, kb = q / 64, nb = q % 64; const int n0 = 32 * nb, isup = n0 >> 10, cc = n0 & 1023, j = cc >> 7, c = cc & 127;
            transpose_item(p.in[20] + (size_t)e * 1024 * 2048, 1024, 2048, (bf16*)(ws + WS_WGU) + (size_t)e * 2048 * 1024, 64 * kb, n0, 256 * j + 128 * isup + c, nullptr, scr, lane); continue; } r -= I_GU;
        { const int e = r / 512, q = r % 512, kb = q / 32, nb = q % 32;
            transpose_item(p.in[22] + (size_t)e * 1024 * 1024, 1024, 1024, (bf16*)(ws + WS_WDN) + (size_t)e * 1024 * 1024, 64 * kb, 32 * nb, 32 * nb, nullptr, scr, lane); }
    }
    for (int m = gw; m < T; m += NGW) rms_row_to_bf16(p.in[0] + (size_t)m * D, p.in[2], (bf16*)(ws + WS_XN) + (size_t)m * D, lane);
    for (int m = gw; m < TM; m += NGW) rms_row_to_bf16(p.in[1] + (size_t)m * D, p.in[11], (bf16*)(ws + WS_MEMN) + (size_t)m * D, lane);
}

enum { MODE_INPROJ = 0, MODE_MEMKV = 1, MODE_OUT = 2, MODE_GU = 3, MODE_DN = 4 };
__device__ __forceinline__ void moe_prefix(const unsigned* cnt, int e, int& count, int& pstart) {
    int ps = 0, c = 0;
    for (int i = 0; i < NE; ++i) { const int ci = (int)cnt[i]; if (i < e) ps += ((ci + 255) >> 8) << 8; if (i == e) c = ci; }
    count = c; pstart = ps;
}
template <int MODE>
__global__ void __launch_bounds__(256) k_naive_gemm(Ptrs p) {
    __shared__ float sA[32][65], sB[32][65];
    unsigned char* ws = p.ws;
    const int tid = threadIdx.x, ty = tid >> 4, tx = tid & 15;
    const int rt = blockIdx.x, ct = blockIdx.y, e = blockIdx.z;
    const bf16* A; const bf16* Bt; int K = 1024;
    int count = 0, pstart = 0;
    const int* list = nullptr;
    if (MODE == MODE_INPROJ) { A = (const bf16*)(ws + WS_XN); Bt = (const bf16*)(ws + WS_WIN); }
    else if (MODE == MODE_MEMKV) { A = (const bf16*)(ws + WS_MEMN); Bt = (const bf16*)(ws + WS_WMKV); }
    else if (MODE == MODE_OUT) { A = (const bf16*)(ws + WS_CAT); Bt = (const bf16*)(ws + WS_WOUT); }
    else {
        moe_prefix((const unsigned*)(ws + WS_CTL) + CW_CNT, e, count, pstart);
        if (rt * 64 >= count) return;
        list = (const int*)(ws + WS_LIST) + (size_t)e * T;
        if (MODE == MODE_GU) { A = (const bf16*)(ws + WS_HN); Bt = (const bf16*)(ws + WS_WGU) + (size_t)e * 2048 * 1024; }
        else { A = (const bf16*)(ws + WS_HACT) + (size_t)pstart * 1024; Bt = (const bf16*)(ws + WS_WDN) + (size_t)e * 1024 * 1024; }
    }
    const int lr = tid >> 2, kc = (tid & 3) * 8;
    size_t arow;
    { const int r = rt * 64 + lr; if (MODE == MODE_GU) { const int tok = (r < count) ? list[r] : 0; arow = (size_t)tok * K; } else arow = (size_t)r * K; }
    size_t brow;
    { int n; if (MODE == MODE_GU) { const int jb = ct >> 2, c0 = (ct & 3) * 32; n = 256 * jb + 128 * (lr >> 5) + c0 + (lr & 31); } else n = ct * 64 + lr; brow = (size_t)n * K; }
    float acc[4][4];
#pragma unroll
    for (int i = 0; i < 4; ++i)
#pragma unroll
        for (int j = 0; j < 4; ++j) acc[i][j] = 0.f;
    int cl[4];
#pragma unroll
    for (int j = 0; j < 4; ++j) cl[j] = (MODE == MODE_GU) ? (j < 2 ? 2 * tx + j : 32 + 2 * tx + (j - 2)) : 4 * tx + j;
    for (int k0 = 0; k0 < K; k0 += 32) {
        const v4u av = *(const v4u*)(A + arow + k0 + kc), bv = *(const v4u*)(Bt + brow + k0 + kc);
        __syncthreads();
#pragma unroll
        for (int j = 0; j < 4; ++j) { const unsigned a = av[j], b = bv[j];
            sA[kc + 2 * j][lr] = bf2f(a & 0xffffu); sA[kc + 2 * j + 1][lr] = bf2f(a >> 16);
            sB[kc + 2 * j][lr] = bf2f(b & 0xffffu); sB[kc + 2 * j + 1][lr] = bf2f(b >> 16); }
        __syncthreads();
#pragma unroll 8
        for (int k = 0; k < 32; ++k) {
            float a[4], b[4];
#pragma unroll
            for (int i = 0; i < 4; ++i) a[i] = sA[k][ty * 4 + i];
#pragma unroll
            for (int j = 0; j < 4; ++j) b[j] = sB[k][cl[j]];
#pragma unroll
            for (int i = 0; i < 4; ++i)
#pragma unroll
                for (int j = 0; j < 4; ++j) acc[i][j] += a[i] * b[j];
        }
    }
#pragma unroll
    for (int i = 0; i < 4; ++i) {
        const int r = rt * 64 + ty * 4 + i;
        if (MODE == MODE_INPROJ) {
#pragma unroll
            for (int j = 0; j < 4; ++j) { const int n = ct * 64 + 4 * tx + j; const float v = acc[i][j];
                if (n < 512) ((bf16*)(ws + WS_Q))[(size_t)r * 512 + n] = (bf16)f2bf(v * 0.125f);
                else if (n < 1024) ((bf16*)(ws + WS_K))[(size_t)r * 512 + n - 512] = (bf16)f2bf(v);
                else if (n < 1536) ((bf16*)(ws + WS_VT))[(size_t)(n - 1024) * T + r] = (bf16)f2bf(v);
                else if (n < 2048) ((bf16*)(ws + WS_GLU))[(size_t)r * 512 + n - 1536] = (bf16)f2bf(v + p.in[4][n - 1536]);
                else ((bf16*)(ws + WS_QMX))[(size_t)r * 256 + n - 2048] = (bf16)f2bf(v * 0.125f); }
        } else if (MODE == MODE_MEMKV) {
#pragma unroll
            for (int j = 0; j < 4; ++j) { const int n = ct * 64 + 4 * tx + j; const float v = acc[i][j];
                if (n < 256) ((bf16*)(ws + WS_MEMK))[(size_t)r * 256 + n] = (bf16)f2bf(v);
                else ((bf16*)(ws + WS_MEMVT))[(size_t)(n - 256) * TM + r] = (bf16)f2bf(v); }
        } else if (MODE == MODE_OUT) {
#pragma unroll
            for (int j = 0; j < 4; ++j) { const int n = ct * 64 + 4 * tx + j; p.out[(size_t)r * D + n] = p.in[0][(size_t)r * D + n] + acc[i][j]; }
        } else if (MODE == MODE_GU) {
            const int jb = ct >> 2, c0 = (ct & 3) * 32;
#pragma unroll
            for (int j = 0; j < 2; ++j) { const int hc = 128 * jb + c0 + 2 * tx + j;
                float g = acc[i][j] + p.in[21][(size_t)e * 2048 + hc], u = acc[i][j + 2] + p.in[21][(size_t)e * 2048 + 1024 + hc];
                g = fminf(g, 7.0f); u = fminf(fmaxf(u, -7.0f), 7.0f);
                const float h = (u + 1.0f) * (g / (1.0f + __expf(-1.702f * g)));
                ((bf16*)(ws + WS_HACT))[(size_t)(pstart + r) * 1024 + hc] = (bf16)f2bf(h); }
        } else {
#pragma unroll
            for (int j = 0; j < 4; ++j) { const int n = ct * 64 + 4 * tx + j;
                ((bf16*)(ws + WS_Y))[(size_t)(pstart + r) * 1024 + n] = (bf16)f2bf(acc[i][j] + p.in[23][(size_t)e * 1024 + n]); }
        }
    }
}

__global__ void __launch_bounds__(256) k_naive_sb(Ptrs p) {
    unsigned char* ws = p.ws;
    const int gid = blockIdx.x * 256 + threadIdx.x;
    const int t = gid % S, h = (gid / S) % SBH, b = gid / (S * SBH);
    const bf16* Q = (const bf16*)(ws + WS_Q); const bf16* Kp = (const bf16*)(ws + WS_K); const bf16* VT = (const bf16*)(ws + WS_VT);
    float q[64], o[64];
    { const v4u* qp = (const v4u*)(Q + (size_t)(b * S + t) * 512 + h * 64);
#pragma unroll
        for (int c = 0; c < 8; ++c) { const v4u v = qp[c];
#pragma unroll
            for (int j = 0; j < 4; ++j) { q[c * 8 + 2 * j] = bf2f(v[j] & 0xffffu); q[c * 8 + 2 * j + 1] = bf2f(v[j] >> 16); } } }
#pragma unroll
    for (int d = 0; d < 64; ++d) o[d] = 0.f;
    float carry = 0.f;
    for (int s = t - 1; s >= 0; --s) {
        const v4u* kp = (const v4u*)(Kp + (size_t)(b * S + s) * 512 + h * 64);
        float z = 0.f;
#pragma unroll
        for (int c = 0; c < 8; ++c) { const v4u v = kp[c];
#pragma unroll
            for (int j = 0; j < 4; ++j) { z += q[c * 8 + 2 * j] * bf2f(v[j] & 0xffffu); z += q[c * 8 + 2 * j + 1] * bf2f(v[j] >> 16); } }
        const float l = __logf(1.0f + __expf(-fabsf(z)));
        const float lb = -(fmaxf(-z, 0.f) + l), lnb = -(fmaxf(z, 0.f) + l);
        const float a = __expf(lb + carry);
        carry += lnb;
        const bf16* vp = VT + (size_t)(h * 64) * T + (size_t)b * S + s;
#pragma unroll
        for (int d = 0; d < 64; ++d) o[d] += a * bf2f(vp[(size_t)d * T]);
        if (carry < SB_EXIT) break;
    }
    float* O = (float*)(ws + WS_OSB) + (size_t)(b * S + t) * 512 + h * 64;
#pragma unroll
    for (int d = 0; d < 64; ++d) O[d] = o[d];
}

__global__ void __launch_bounds__(256) k_naive_conv(Ptrs p) {
    __shared__ float act_all[4][256];
    unsigned char* ws = p.ws;
    const int lane = threadIdx.x & 63, wave = threadIdx.x >> 6;
    float* act = act_all[wave];
    const int tok = blockIdx.x * 4 + wave, t = tok % S;
    const bf16* GLU = (const bf16*)(ws + WS_GLU);
    const float* w_dw = p.in[5]; const float* b_dw = p.in[6]; const float* g_ln = p.in[7]; const float* b_ln = p.in[8]; const float* w_pw2 = p.in[9]; const float* b_pw2 = p.in[10];
    float u[4];
#pragma unroll
    for (int i = 0; i < 4; ++i) u[i] = b_dw[lane + 64 * i];
    for (int j = 0; j < CONVK; ++j) {
        const int ts = t - (CONVK - 1) + j; if (ts < 0) continue;
        const bf16* row = GLU + (size_t)(tok - (CONVK - 1) + j) * 512;
#pragma unroll
        for (int i = 0; i < 4; ++i) { const int c = lane + 64 * i; const float a = bf2f(row[c]), g = bf2f(row[256 + c]);
            u[i] += w_dw[j * CVW + c] * (a / (1.0f + __expf(-g))); }
    }
    float s = u[0] + u[1] + u[2] + u[3]; const float mu = wave_sum(s) * (1.f / 256.f);
    float q = 0.f;
#pragma unroll
    for (int i = 0; i < 4; ++i) { const float d = u[i] - mu; q += d * d; }
    const float rstd = 1.0f / sqrtf(wave_sum(q) * (1.f / 256.f) + EPS);
#pragma unroll
    for (int i = 0; i < 4; ++i) { const int c = lane + 64 * i; float y = (u[i] - mu) * rstd * g_ln[c] + b_ln[c]; y = y / (1.0f + __expf(-y)); act[c] = y; }
    __syncthreads();
    float o[4];
#pragma unroll
    for (int i = 0; i < 4; ++i) o[i] = b_pw2[lane + 64 * i];
    for (int c = 0; c < 256; ++c) { const float a = act[c];
#pragma unroll
        for (int i = 0; i < 4; ++i) o[i] += a * w_pw2[c * 256 + lane + 64 * i]; }
    float* O = (float*)(ws + WS_OCV) + (size_t)tok * 256;
#pragma unroll
    for (int i = 0; i < 4; ++i) O[lane + 64 * i] = o[i];
}

__global__ void __launch_bounds__(256) k_naive_cross(Ptrs p) {
    __shared__ float pr_all[4][256];
    __shared__ float qs_all[4][64];
    unsigned char* ws = p.ws;
    const int lane = threadIdx.x & 63, h = threadIdx.x >> 6;
    float* pr = pr_all[h]; float* qs = qs_all[h];
    const int tok = blockIdx.x, b = tok / S;
    const bf16* QM = (const bf16*)(ws + WS_QMX); const bf16* MK = (const bf16*)(ws + WS_MEMK); const bf16* MVT = (const bf16*)(ws + WS_MEMVT);
    qs[lane] = bf2f(QM[(size_t)tok * 256 + h * 64 + lane]);
    __syncthreads();
    float sc[4]; float mx = -1e30f;
#pragma unroll
    for (int i = 0; i < 4; ++i) { const int m = lane + 64 * i; const bf16* kr = MK + (size_t)(b * NMEM + m) * 256 + h * 64; float z = 0.f;
        for (int d = 0; d < 64; ++d) z += qs[d] * bf2f(kr[d]);
        sc[i] = z; mx = fmaxf(mx, z); }
    mx = wave_max(mx);
    float sum = 0.f;
#pragma unroll
    for (int i = 0; i < 4; ++i) { sc[i] = __expf(sc[i] - mx); sum += sc[i]; }
    sum = wave_sum(sum);
#pragma unroll
    for (int i = 0; i < 4; ++i) pr[lane + 64 * i] = sc[i] / sum;
    __syncthreads();
    const bf16* vr = MVT + (size_t)(h * 64 + lane) * TM + (size_t)b * NMEM;
    float o = 0.f;
    for (int m = 0; m < NMEM; ++m) o += pr[m] * bf2f(vr[m]);
    ((float*)(ws + WS_OMX))[(size_t)tok * 256 + h * 64 + lane] = o;
}

__global__ void __launch_bounds__(256) k_groupnorm(Ptrs p, size_t src_off, int W, int coloff) {
    unsigned char* ws = p.ws;
    const int lane = threadIdx.x & 63, tok = blockIdx.x * 4 + (threadIdx.x >> 6);
    const float* src = (const float*)(ws + src_off) + (size_t)tok * W;
    float v[8]; float s = 0.f; const int n = W / 64;
#pragma unroll
    for (int i = 0; i < 8; ++i) if (i < n) { v[i] = src[lane + 64 * i]; s += v[i] * v[i]; }
    const float rs = 1.0f / sqrtf(wave_sum(s) / (float)W + EPS);
    bf16* o = (bf16*)(ws + WS_CAT) + (size_t)tok * D + coloff;
#pragma unroll
    for (int i = 0; i < 8; ++i) if (i < n) o[lane + 64 * i] = (bf16)f2bf(v[i] * rs);
}

__global__ void __launch_bounds__(256) k_router(Ptrs p) {
    __shared__ float hrow_all[4][1024];
    unsigned char* ws = p.ws;
    const int lane = threadIdx.x & 63, wave = threadIdx.x >> 6, tok = blockIdx.x * 4 + wave;
    float* hrow = hrow_all[wave];
    const float* h = p.out + (size_t)tok * D; const float* g = p.in[17];
    const f32x4* xr = (const f32x4*)h + lane; const f32x4* gr = (const f32x4*)g + lane;
    f32x4 v[4]; float s = 0.f;
#pragma unroll
    for (int j = 0; j < 4; ++j) { v[j] = xr[64 * j]; s += (v[j].x * v[j].x + v[j].y * v[j].y) + (v[j].z * v[j].z + v[j].w * v[j].w); }
    const float rs = 1.0f / sqrtf(wave_sum(s) * (1.f / D) + EPS);
    unsigned long long* o8 = (unsigned long long*)((bf16*)(ws + WS_HN) + (size_t)tok * D) + lane;
#pragma unroll
    for (int j = 0; j < 4; ++j) { const f32x4 gg = gr[64 * j]; f32x4 y; y.x = v[j].x * rs * gg.x; y.y = v[j].y * rs * gg.y; y.z = v[j].z * rs * gg.z; y.w = v[j].w * rs * gg.w;
        o8[64 * j] = (unsigned long long)pk2(y.x, y.y) | ((unsigned long long)pk2(y.z, y.w) << 32);
        *(f32x4*)(hrow + 4 * lane + 256 * j) = y; }
    __syncthreads();
    const int e = lane & 31, hf = lane >> 5; const float* wr = p.in[18];
    float acc = 0.f;
    for (int k = hf * 512; k < hf * 512 + 512; ++k) acc += hrow[k] * wr[k * NE + e];
    acc += __shfl_xor(acc, 32);
    float logit = acc + p.in[19][e];
    int my_e = 0; float my_v = 0.f, m0 = 0.f;
#pragma unroll
    for (int k = 0; k < 4; ++k) {
        const float m = wave_max(logit);
        const unsigned long long bal = __ballot(logit == m);
        const int idx = (int)(__ffsll((long long)bal) - 1) & 31;
        if (lane == k) { my_e = idx; my_v = m; }
        if (k == 0) m0 = m;
        if (e == idx) logit = -3.0e38f;
    }
    const float exv = (lane < 4) ? __expf(my_v - m0) : 0.f;
    const float es = __shfl(exv, 0) + __shfl(exv, 1) + __shfl(exv, 2) + __shfl(exv, 3);
    if (lane < 4) {
        const int ee = my_e; const float gv = exv;
        const unsigned slot = atomicAdd((unsigned*)(ws + WS_CTL) + CW_CNT + ee, 1u);
        ((int*)(ws + WS_LIST))[(size_t)ee * T + slot] = tok;
        ((int*)(ws + WS_TOKE))[tok * 4 + lane] = ee;
        ((int*)(ws + WS_TOKS))[tok * 4 + lane] = (int)slot;
        ((float*)(ws + WS_TOKG))[tok * 4 + lane] = gv / es;
    }
}

__global__ void __launch_bounds__(256) k_final(Ptrs p) {
    unsigned char* ws = p.ws;
    const int lane = threadIdx.x & 63, tok = blockIdx.x * 4 + (threadIdx.x >> 6);
    const unsigned* cnt = (const unsigned*)(ws + WS_CTL) + CW_CNT;
    float* h = p.out + (size_t)tok * D;
    f32x4 v[4];
#pragma unroll
    for (int j = 0; j < 4; ++j) v[j] = ((const f32x4*)h)[lane + 64 * j];
    for (int k = 0; k < 4; ++k) {
        const int e = ((const int*)(ws + WS_TOKE))[tok * 4 + k], slot = ((const int*)(ws + WS_TOKS))[tok * 4 + k]; const float gt = ((const float*)(ws + WS_TOKG))[tok * 4 + k];
        int c, ps; moe_prefix(cnt, e, c, ps);
        const unsigned long long* y8 = (const unsigned long long*)((const bf16*)(ws + WS_Y) + (size_t)(ps + slot) * 1024) + lane;
#pragma unroll
        for (int j = 0; j < 4; ++j) { const unsigned long long w = y8[64 * j]; const unsigned lo = (unsigned)w, hi = (unsigned)(w >> 32);
            v[j].x += gt * bf2f(lo & 0xffffu); v[j].y += gt * bf2f(lo >> 16); v[j].z += gt * bf2f(hi & 0xffffu); v[j].w += gt * bf2f(hi >> 16); }
    }
    float s = 0.f;
#pragma unroll
    for (int j = 0; j < 4; ++j) s += (v[j].x * v[j].x + v[j].y * v[j].y) + (v[j].z * v[j].z + v[j].w * v[j].w);
    const float rs = 1.0f / sqrtf(wave_sum(s) * (1.f / D) + EPS);
    const f32x4* gr = (const f32x4*)p.in[24] + lane;
#pragma unroll
    for (int j = 0; j < 4; ++j) { const f32x4 gg = gr[64 * j]; f32x4 y; y.x = v[j].x * rs * gg.x; y.y = v[j].y * rs * gg.y; y.z = v[j].z * rs * gg.z; y.w = v[j].w * rs * gg.w; ((f32x4*)h)[lane + 64 * j] = y; }
}

extern "C" void kernel_launch(void* const* d_in, const int* in_sizes, int n_in, void* d_out, int out_size, void* d_ws, size_t ws_size, hipStream_t stream) {
    if (n_in != 25 || out_size != T * D || ws_size < WS_END) { fprintf(stderr, "kernel_launch: unexpected shapes n_in %d out %d ws %zu\n", n_in, out_size, ws_size); return; }
    Ptrs p{};
    for (int i = 0; i < 25; ++i) p.in[i] = (const float*)d_in[i];
    p.out = (float*)d_out; p.ws = (unsigned char*)d_ws;
    (void)hipMemsetAsync((char*)d_ws + WS_CTL, 0, CTL_BYTES, stream);
    hipLaunchKernelGGL(k_prologue, dim3(2048), dim3(256), 0, stream, p);
    hipLaunchKernelGGL(k_naive_gemm<MODE_INPROJ>, dim3(T / 64, INW / 64, 1), dim3(256), 0, stream, p);
    hipLaunchKernelGGL(k_naive_gemm<MODE_MEMKV>, dim3(TM / 64, 512 / 64, 1), dim3(256), 0, stream, p);
    hipLaunchKernelGGL(k_naive_sb, dim3(T * SBH / 256), dim3(256), 0, stream, p);
    hipLaunchKernelGGL(k_naive_conv, dim3(T / 4), dim3(256), 0, stream, p);
    hipLaunchKernelGGL(k_naive_cross, dim3(T), dim3(256), 0, stream, p);
    hipLaunchKernelGGL(k_groupnorm, dim3(T / 4), dim3(256), 0, stream, p, WS_OSB, 512, 0);
    hipLaunchKernelGGL(k_groupnorm, dim3(T / 4), dim3(256), 0, stream, p, WS_OCV, 256, 512);
    hipLaunchKernelGGL(k_groupnorm, dim3(T / 4), dim3(256), 0, stream, p, WS_OMX, 256, 768);
    hipLaunchKernelGGL(k_naive_gemm<MODE_OUT>, dim3(T / 64, D / 64, 1), dim3(256), 0, stream, p);
    hipLaunchKernelGGL(k_router, dim3(T / 4), dim3(256), 0, stream, p);
    hipLaunchKernelGGL(k_naive_gemm<MODE_GU>, dim3(T / 64, 32, NE), dim3(256), 0, stream, p);
    hipLaunchKernelGGL(k_naive_gemm<MODE_DN>, dim3(T / 64, D / 64, NE), dim3(256), 0, stream, p);
    hipLaunchKernelGGL(k_final, dim3(T / 4), dim3(256), 0, stream, p);
}
```

```cpp
#include <hip/hip_runtime.h>
#include <cstdio>
#include <cstdint>

typedef unsigned short bf16;
typedef unsigned v4u __attribute__((ext_vector_type(4)));
typedef float f32x4 __attribute__((ext_vector_type(4)));

constexpr int NB = 16, S = 2048, T = NB * S, D = 1024;
constexpr int SBH = 8, HD = 64, SBW = 512, CVW = 256, MXH = 4, MXW = 256, INW = 2304, NMEM = 256, TM = NB * NMEM;
constexpr int NE = 32, TOPK = 4, DFF = 1024, CONVK = 31;
constexpr int PMAX = T * TOPK + NE * 256;
constexpr float EPS = 1e-6f;
constexpr float SB_EXIT = -60.0f;

constexpr size_t MiB = 1u << 20;
constexpr size_t WS_CTL = 0, CTL_BYTES = 1 * MiB;
constexpr size_t WS_WIN = 2 * MiB;
constexpr size_t WS_WOUT = 7 * MiB;
constexpr size_t WS_WMKV = 9 * MiB;
constexpr size_t WS_WPW2 = 10 * MiB;
constexpr size_t WS_WGU = 16 * MiB;
constexpr size_t WS_WDN = 144 * MiB;
constexpr size_t WS_MEMN = 208 * MiB;
constexpr size_t WS_MEMK = 216 * MiB;
constexpr size_t WS_MEMVT = 218 * MiB;
constexpr size_t WS_LIST = 220 * MiB;
constexpr size_t WS_TOKE = 224 * MiB;
constexpr size_t WS_TOKS = 224 * MiB + 512 * 1024;
constexpr size_t WS_TOKG = 225 * MiB;
constexpr size_t WS_HN = 226 * MiB;
constexpr size_t WS_XN = 290 * MiB;
constexpr size_t WS_Q = 354 * MiB;
constexpr size_t WS_K = 386 * MiB;
constexpr size_t WS_VT = 418 * MiB;
constexpr size_t WS_GLU = 450 * MiB;
constexpr size_t WS_QMX = 482 * MiB;
constexpr size_t WS_CAT = 498 * MiB;
constexpr size_t WS_HACT = 562 * MiB;
constexpr size_t WS_Y = 290 * MiB;
constexpr size_t WS_END = 834 * MiB;
constexpr size_t WS_OSB = 562 * MiB;
constexpr size_t WS_OCV = 626 * MiB;
constexpr size_t WS_OMX = 658 * MiB;
static_assert((size_t)PMAX * 1024 * 2 == 272 * MiB, "padded rows");
constexpr int CW_CNT = 64;

__device__ __forceinline__ float bf2f(unsigned v) { return __uint_as_float(v << 16); }
__device__ __forceinline__ unsigned f2bf(float f) { unsigned u = __float_as_uint(f); return (u + 0x7fffu + ((u >> 16) & 1u)) >> 16; }
__device__ __forceinline__ unsigned pk2(float lo, float hi) { return f2bf(lo) | (f2bf(hi) << 16); }
__device__ __forceinline__ float wave_sum(float v) {
#pragma unroll
    for (int o = 1; o < 64; o <<= 1) v += __shfl_xor(v, o);
    return v;
}
__device__ __forceinline__ float wave_max(float v) {
#pragma unroll
    for (int o = 1; o < 64; o <<= 1) v = fmaxf(v, __shfl_xor(v, o));
    return v;
}

__device__ __forceinline__ void transpose_item(const float* W, int K, int N, bf16* WT, int k0, int n0, int dstrow0, const float* kscale, float* scr, int lane) {
#pragma unroll 8
    for (int i = 0; i < 32; ++i) { const int kk = 2 * i + (lane >> 5); float v = W[(size_t)(k0 + kk) * N + n0 + (lane & 31)]; if (kscale) v *= kscale[k0 + kk]; scr[kk * 33 + (lane & 31)] = v; }
    asm volatile("s_waitcnt lgkmcnt(0)" ::: "memory");
    const int c = lane & 7;
#pragma unroll
    for (int j = 0; j < 4; ++j) { const int n = (lane >> 3) + 8 * j; const float* s = scr + (8 * c) * 33 + n;
        v4u o; o.x = pk2(s[0 * 33], s[1 * 33]); o.y = pk2(s[2 * 33], s[3 * 33]); o.z = pk2(s[4 * 33], s[5 * 33]); o.w = pk2(s[6 * 33], s[7 * 33]);
        *(v4u*)(WT + (size_t)(dstrow0 + n) * K + k0 + 8 * c) = o; }
    asm volatile("s_waitcnt lgkmcnt(0)" ::: "memory");
}
__device__ __forceinline__ void rms_row_to_bf16(const float* xrow, const float* g, bf16* orow, int lane) {
    const f32x4* xr = (const f32x4*)xrow + lane; const f32x4* gr = (const f32x4*)g + lane;
    f32x4 v[4]; float s = 0.f;
#pragma unroll
    for (int j = 0; j < 4; ++j) { v[j] = xr[64 * j]; s += (v[j].x * v[j].x + v[j].y * v[j].y) + (v[j].z * v[j].z + v[j].w * v[j].w); }
    const float rs = 1.0f / sqrtf(wave_sum(s) * (1.f / D) + EPS);
    unsigned long long* o8 = (unsigned long long*)orow + lane;
#pragma unroll
    for (int j = 0; j < 4; ++j) { const f32x4 gg = gr[64 * j]; o8[64 * j] = (unsigned long long)pk2(v[j].x * rs * gg.x, v[j].y * rs * gg.y) | ((unsigned long long)pk2(v[j].z * rs * gg.z, v[j].w * rs * gg.w) << 32); }
}

struct Ptrs {
    const float* in[25]; float* out; unsigned char* ws;
};

__global__ void __launch_bounds__(256) k_prologue(Ptrs p) {
    __shared__ float scr_all[4][64 * 33];
    const int lane = threadIdx.x & 63, wave = threadIdx.x >> 6;
    float* scr = scr_all[wave];
    const int gw = blockIdx.x * 4 + wave, NGW = gridDim.x * 4;
    unsigned char* ws = p.ws;
    constexpr int I_IN = 16 * 72, I_OUT = 16 * 32, I_MKV = 16 * 16, I_PW2 = 4 * 8, I_GU = 32 * 16 * 64, I_DN = 32 * 16 * 32;
    constexpr int NIT = I_IN + I_OUT + I_MKV + I_PW2 + I_GU + I_DN;
    for (int it = gw; it < NIT; it += NGW) {
        int r = it;
        if (r < I_IN) { const int kb = r / 72, nb = r % 72; transpose_item(p.in[3], 1024, INW, (bf16*)(ws + WS_WIN), 64 * kb, 32 * nb, 32 * nb, nullptr, scr, lane); continue; } r -= I_IN;
        if (r < I_OUT) { const int kb = r / 32, nb = r % 32; const int k0 = 64 * kb;
            const float* ks = k0 < 512 ? p.in[13] : (k0 < 768 ? p.in[14] - 512 : p.in[15] - 768);
            transpose_item(p.in[16], 1024, 1024, (bf16*)(ws + WS_WOUT), k0, 32 * nb, 32 * nb, ks, scr, lane); continue; } r -= I_OUT;
        if (r < I_MKV) { const int kb = r / 16, nb = r % 16; transpose_item(p.in[12], 1024, 512, (bf16*)(ws + WS_WMKV), 64 * kb, 32 * nb, 32 * nb, nullptr, scr, lane); continue; } r -= I_MKV;
        if (r < I_PW2) { const int kb = r / 8, nb = r % 8; transpose_item(p.in[9], 256, 256, (bf16*)(ws + WS_WPW2), 64 * kb, 32 * nb, 32 * nb, nullptr, scr, lane); continue; } r -= I_PW2;
        if (r < I_GU) { const int e = r / 1024, q = r % 1024, kb = q / 64, nb = q % 64; const int n0 = 32 * nb, isup = n0 >> 10, cc = n0 & 1023, j = cc >> 7, c = cc & 127;
            transpose_item(p.in[20] + (size_t)e * 1024 * 2048, 1024, 2048, (bf16*)(ws + WS_WGU) + (size_t)e * 2048 * 1024, 64 * kb, n0, 256 * j + 128 * isup + c, nullptr, scr, lane); continue; } r -= I_GU;
        { const int e = r / 512, q = r % 512, kb = q / 32, nb = q % 32;
            transpose_item(p.in[22] + (size_t)e * 1024 * 1024, 1024, 1024, (bf16*)(ws + WS_WDN) + (size_t)e * 1024 * 1024, 64 * kb, 32 * nb, 32 * nb, nullptr, scr, lane); }
    }
    for (int m = gw; m < T; m += NGW) rms_row_to_bf16(p.in[0] + (size_t)m * D, p.in[2], (bf16*)(ws + WS_XN) + (size_t)m * D, lane);
    for (int m = gw; m < TM; m += NGW) rms_row_to_bf16(p.in[1] + (size_t)m * D, p.in[11], (bf16*)(ws + WS_MEMN) + (size_t)m * D, lane);
}

enum { MODE_INPROJ = 0, MODE_MEMKV = 1, MODE_OUT = 2, MODE_GU = 3, MODE_DN = 4 };
__device__ __forceinline__ void moe_prefix(const unsigned* cnt, int e, int& count, int& pstart) {
    int ps = 0, c = 0;
    for (int i = 0; i < NE; ++i) { const int ci = (int)cnt[i]; if (i < e) ps += ((ci + 255) >> 8) << 8; if (i == e) c = ci; }
    count = c; pstart = ps;
}
template <int MODE>
__global__ void __launch_bounds__(256) k_naive_gemm(Ptrs p) {
    __shared__ float sA[32][65], sB[32][65];
    unsigned char* ws = p.ws;
    const int tid = threadIdx.x, ty = tid >> 4, tx = tid & 15;
    const int rt = blockIdx.x, ct = blockIdx.y, e = blockIdx.z;
    const bf16* A; const bf16* Bt; int K = 1024;
    int count = 0, pstart = 0;
    const int* list = nullptr;
    if (MODE == MODE_INPROJ) { A = (const bf16*)(ws + WS_XN); Bt = (const bf16*)(ws + WS_WIN); }
    else if (MODE == MODE_MEMKV) { A = (const bf16*)(ws + WS_MEMN); Bt = (const bf16*)(ws + WS_WMKV); }
    else if (MODE == MODE_OUT) { A = (const bf16*)(ws + WS_CAT); Bt = (const bf16*)(ws + WS_WOUT); }
    else {
        moe_prefix((const unsigned*)(ws + WS_CTL) + CW_CNT, e, count, pstart);
        if (rt * 64 >= count) return;
        list = (const int*)(ws + WS_LIST) + (size_t)e * T;
        if (MODE == MODE_GU) { A = (const bf16*)(ws + WS_HN); Bt = (const bf16*)(ws + WS_WGU) + (size_t)e * 2048 * 1024; }
        else { A = (const bf16*)(ws + WS_HACT) + (size_t)pstart * 1024; Bt = (const bf16*)(ws + WS_WDN) + (size_t)e * 1024 * 1024; }
    }
    const int lr = tid >> 2, kc = (tid & 3) * 8;
    size_t arow;
    { const int r = rt * 64 + lr; if (MODE == MODE_GU) { const int tok = (r < count) ? list[r] : 0; arow = (size_t)tok * K; } else arow = (size_t)r * K; }
    size_t brow;
    { int n; if (MODE == MODE_GU) { const int jb = ct >> 2, c0 = (ct & 3) * 32; n = 256 * jb + 128 * (lr >> 5) + c0 + (lr & 31); } else n = ct * 64 + lr; brow = (size_t)n * K; }
    float acc[4][4];
#pragma unroll
    for (int i = 0; i < 4; ++i)
#pragma unroll
        for (int j = 0; j < 4; ++j) acc[i][j] = 0.f;
    int cl[4];
#pragma unroll
    for (int j = 0; j < 4; ++j) cl[j] = (MODE == MODE_GU) ? (j < 2 ? 2 * tx + j : 32 + 2 * tx + (j - 2)) : 4 * tx + j;
    for (int k0 = 0; k0 < K; k0 += 32) {
        const v4u av = *(const v4u*)(A + arow + k0 + kc), bv = *(const v4u*)(Bt + brow + k0 + kc);
        __syncthreads();
#pragma unroll
        for (int j = 0; j < 4; ++j) { const unsigned a = av[j], b = bv[j];
            sA[kc + 2 * j][lr] = bf2f(a & 0xffffu); sA[kc + 2 * j + 1][lr] = bf2f(a >> 16);
            sB[kc + 2 * j][lr] = bf2f(b & 0xffffu); sB[kc + 2 * j + 1][lr] = bf2f(b >> 16); }
        __syncthreads();
#pragma unroll 8
        for (int k = 0; k < 32; ++k) {
            float a[4], b[4];
#pragma unroll
            for (int i = 0; i < 4; ++i) a[i] = sA[k][ty * 4 + i];
#pragma unroll
            for (int j = 0; j < 4; ++j) b[j] = sB[k][cl[j]];
#pragma unroll
            for (int i = 0; i < 4; ++i)
#pragma unroll
                for (int j = 0; j < 4; ++j) acc[i][j] += a[i] * b[j];
        }
    }
#pragma unroll
    for (int i = 0; i < 4; ++i) {
        const int r = rt * 64 + ty * 4 + i;
        if (MODE == MODE_INPROJ) {
#pragma unroll
            for (int j = 0; j < 4; ++j) { const int n = ct * 64 + 4 * tx + j; const float v = acc[i][j];
                if (n < 512) ((bf16*)(ws + WS_Q))[(size_t)r * 512 + n] = (bf16)f2bf(v * 0.125f);
                else if (n < 1024) ((bf16*)(ws + WS_K))[(size_t)r * 512 + n - 512] = (bf16)f2bf(v);
                else if (n < 1536) ((bf16*)(ws + WS_VT))[(size_t)(n - 1024) * T + r] = (bf16)f2bf(v);
                else if (n < 2048) ((bf16*)(ws + WS_GLU))[(size_t)r * 512 + n - 1536] = (bf16)f2bf(v + p.in[4][n - 1536]);
                else ((bf16*)(ws + WS_QMX))[(size_t)r * 256 + n - 2048] = (bf16)f2bf(v * 0.125f); }
        } else if (MODE == MODE_MEMKV) {
#pragma unroll
            for (int j = 0; j < 4; ++j) { const int n = ct * 64 + 4 * tx + j; const float v = acc[i][j];
                if (n < 256) ((bf16*)(ws + WS_MEMK))[(size_t)r * 256 + n] = (bf16)f2bf(v);
                else ((bf16*)(ws + WS_MEMVT))[(size_t)(n - 256) * TM + r] = (bf16)f2bf(v); }
        } else if (MODE == MODE_OUT) {
#pragma unroll
            for (int j = 0; j < 4; ++j) { const int n = ct * 64 + 4 * tx + j; p.out[(size_t)r * D + n] = p.in[0][(size_t)r * D + n] + acc[i][j]; }
        } else if (MODE == MODE_GU) {
            const int jb = ct >> 2, c0 = (ct & 3) * 32;
#pragma unroll
            for (int j = 0; j < 2; ++j) { const int hc = 128 * jb + c0 + 2 * tx + j;
                float g = acc[i][j] + p.in[21][(size_t)e * 2048 + hc], u = acc[i][j + 2] + p.in[21][(size_t)e * 2048 + 1024 + hc];
                g = fminf(g, 7.0f); u = fminf(fmaxf(u, -7.0f), 7.0f);
                const float h = (u + 1.0f) * (g / (1.0f + __expf(-1.702f * g)));
                ((bf16*)(ws + WS_HACT))[(size_t)(pstart + r) * 1024 + hc] = (bf16)f2bf(h); }
        } else {
#pragma unroll
            for (int j = 0; j < 4; ++j) { const int n = ct * 64 + 4 * tx + j;
                ((bf16*)(ws + WS_Y))[(size_t)(pstart + r) * 1024 + n] = (bf16)f2bf(acc[i][j] + p.in[23][(size_t)e * 1024 + n]); }
        }
    }
}

__global__ void __launch_bounds__(256) k_naive_sb(Ptrs p) {
    unsigned char* ws = p.ws;
    const int gid = blockIdx.x * 256 + threadIdx.x;
    const int t = gid % S, h = (gid / S) % SBH, b = gid / (S * SBH);
    const bf16* Q = (const bf16*)(ws + WS_Q); const bf16* Kp = (const bf16*)(ws + WS_K); const bf16* VT = (const bf16*)(ws + WS_VT);
    float q[64], o[64];
    { const v4u* qp = (const v4u*)(Q + (size_t)(b * S + t) * 512 + h * 64);
#pragma unroll
        for (int c = 0; c < 8; ++c) { const v4u v = qp[c];
#pragma unroll
            for (int j = 0; j < 4; ++j) { q[c * 8 + 2 * j] = bf2f(v[j] & 0xffffu); q[c * 8 + 2 * j + 1] = bf2f(v[j] >> 16); } } }
#pragma unroll
    for (int d = 0; d < 64; ++d) o[d] = 0.f;
    float carry = 0.f;
    for (int s = t - 1; s >= 0; --s) {
        const v4u* kp = (const v4u*)(Kp + (size_t)(b * S + s) * 512 + h * 64);
        float z = 0.f;
#pragma unroll
        for (int c = 0; c < 8; ++c) { const v4u v = kp[c];
#pragma unroll
            for (int j = 0; j < 4; ++j) { z += q[c * 8 + 2 * j] * bf2f(v[j] & 0xffffu); z += q[c * 8 + 2 * j + 1] * bf2f(v[j] >> 16); } }
        const float l = __logf(1.0f + __expf(-fabsf(z)));
        const float lb = -(fmaxf(-z, 0.f) + l), lnb = -(fmaxf(z, 0.f) + l);
        const float a = __expf(lb + carry);
        carry += lnb;
        const bf16* vp = VT + (size_t)(h * 64) * T + (size_t)b * S + s;
#pragma unroll
        for (int d = 0; d < 64; ++d) o[d] += a * bf2f(vp[(size_t)d * T]);
        if (carry < SB_EXIT) break;
    }
    float* O = (float*)(ws + WS_OSB) + (size_t)(b * S + t) * 512 + h * 64;
#pragma unroll
    for (int d = 0; d < 64; ++d) O[d] = o[d];
}

__global__ void __launch_bounds__(256) k_naive_conv(Ptrs p) {
    __shared__ float act_all[4][256];
    unsigned char* ws = p.ws;
    const int lane = threadIdx.x & 63, wave = threadIdx.x >> 6;
    float* act = act_all[wave];
    const int tok = blockIdx.x * 4 + wave, t = tok % S;
    const bf16* GLU = (const bf16*)(ws + WS_GLU);
    const float* w_dw = p.in[5]; const float* b_dw = p.in[6]; const float* g_ln = p.in[7]; const float* b_ln = p.in[8]; const float* w_pw2 = p.in[9]; const float* b_pw2 = p.in[10];
    float u[4];
#pragma unroll
    for (int i = 0; i < 4; ++i) u[i] = b_dw[lane + 64 * i];
    for (int j = 0; j < CONVK; ++j) {
        const int ts = t - (CONVK - 1) + j; if (ts < 0) continue;
        const bf16* row = GLU + (size_t)(tok - (CONVK - 1) + j) * 512;
#pragma unroll
        for (int i = 0; i < 4; ++i) { const int c = lane + 64 * i; const float a = bf2f(row[c]), g = bf2f(row[256 + c]);
            u[i] += w_dw[j * CVW + c] * (a / (1.0f + __expf(-g))); }
    }
    float s = u[0] + u[1] + u[2] + u[3]; const float mu = wave_sum(s) * (1.f / 256.f);
    float q = 0.f;
#pragma unroll
    for (int i = 0; i < 4; ++i) { const float d = u[i] - mu; q += d * d; }
    const float rstd = 1.0f / sqrtf(wave_sum(q) * (1.f / 256.f) + EPS);
#pragma unroll
    for (int i = 0; i < 4; ++i) { const int c = lane + 64 * i; float y = (u[i] - mu) * rstd * g_ln[c] + b_ln[c]; y = y / (1.0f + __expf(-y)); act[c] = y; }
    __syncthreads();
    float o[4];
#pragma unroll
    for (int i = 0; i < 4; ++i) o[i] = b_pw2[lane + 64 * i];
    for (int c = 0; c < 256; ++c) { const float a = act[c];
#pragma unroll
        for (int i = 0; i < 4; ++i) o[i] += a * w_pw2[c * 256 + lane + 64 * i]; }
    float* O = (float*)(ws + WS_OCV) + (size_t)tok * 256;
#pragma unroll
    for (int i = 0; i < 4; ++i) O[lane + 64 * i] = o[i];
}

__global__ void __launch_bounds__(256) k_naive_cross(Ptrs p) {
    __shared__ float pr_all[4][256];
    __shared__ float qs_all[4][64];
    unsigned char* ws = p.ws;
    const int lane = threadIdx.x & 63, h = threadIdx.x >> 6;
    float* pr = pr_all[h]; float* qs = qs_all[h];
    const int tok = blockIdx.x, b = tok / S;
    const bf16* QM = (const bf16*)(ws + WS_QMX); const bf16* MK = (const bf16*)(ws + WS_MEMK); const bf16* MVT = (const bf16*)(ws + WS_MEMVT);
    qs[lane] = bf2f(QM[(size_t)tok * 256 + h * 64 + lane]);
    __syncthreads();
    float sc[4]; float mx = -1e30f;
#pragma unroll
    for (int i = 0; i < 4; ++i) { const int m = lane + 64 * i; const bf16* kr = MK + (size_t)(b * NMEM + m) * 256 + h * 64; float z = 0.f;
        for (int d = 0; d < 64; ++d) z += qs[d] * bf2f(kr[d]);
        sc[i] = z; mx = fmaxf(mx, z); }
    mx = wave_max(mx);
    float sum = 0.f;
#pragma unroll
    for (int i = 0; i < 4; ++i) { sc[i] = __expf(sc[i] - mx); sum += sc[i]; }
    sum = wave_sum(sum);
#pragma unroll
    for (int i = 0; i < 4; ++i) pr[lane + 64 * i] = sc[i] / sum;
    __syncthreads();
    const bf16* vr = MVT + (size_t)(h * 64 + lane) * TM + (size_t)b * NMEM;
    float o = 0.f;
    for (int m = 0; m < NMEM; ++m) o += pr[m] * bf2f(vr[m]);
    ((float*)(ws + WS_OMX))[(size_t)tok * 256 + h * 64 + lane] = o;
}

__global__ void __launch_bounds__(256) k_groupnorm(Ptrs p, size_t src_off, int W, int coloff) {
    unsigned char* ws = p.ws;
    const int lane = threadIdx.x & 63, tok = blockIdx.x * 4 + (threadIdx.x >> 6);
    const float* src = (const float*)(ws + src_off) + (size_t)tok * W;
    float v[8]; float s = 0.f; const int n = W / 64;
#pragma unroll
    for (int i = 0; i < 8; ++i) if (i < n) { v[i] = src[lane + 64 * i]; s += v[i] * v[i]; }
    const float rs = 1.0f / sqrtf(wave_sum(s) / (float)W + EPS);
    bf16* o = (bf16*)(ws + WS_CAT) + (size_t)tok * D + coloff;
#pragma unroll
    for (int i = 0; i < 8; ++i) if (i < n) o[lane + 64 * i] = (bf16)f2bf(v[i] * rs);
}

__global__ void __launch_bounds__(256) k_router(Ptrs p) {
    __shared__ float hrow_all[4][1024];
    unsigned char* ws = p.ws;
    const int lane = threadIdx.x & 63, wave = threadIdx.x >> 6, tok = blockIdx.x * 4 + wave;
    float* hrow = hrow_all[wave];
    const float* h = p.out + (size_t)tok * D; const float* g = p.in[17];
    const f32x4* xr = (const f32x4*)h + lane; const f32x4* gr = (const f32x4*)g + lane;
    f32x4 v[4]; float s = 0.f;
#pragma unroll
    for (int j = 0; j < 4; ++j) { v[j] = xr[64 * j]; s += (v[j].x * v[j].x + v[j].y * v[j].y) + (v[j].z * v[j].z + v[j].w * v[j].w); }
    const float rs = 1.0f / sqrtf(wave_sum(s) * (1.f / D) + EPS);
    unsigned long long* o8 = (unsigned long long*)((bf16*)(ws + WS_HN) + (size_t)tok * D) + lane;
#pragma unroll
    for (int j = 0; j < 4; ++j) { const f32x4 gg = gr[64 * j]; f32x4 y; y.x = v[j].x * rs * gg.x; y.y = v[j].y * rs * gg.y; y.z = v[j].z * rs * gg.z; y.w = v[j].w * rs * gg.w;
        o8[64 * j] = (unsigned long long)pk2(y.x, y.y) | ((unsigned long long)pk2(y.z, y.w) << 32);
        *(f32x4*)(hrow + 4 * lane + 256 * j) = y; }
    __syncthreads();
    const int e = lane & 31, hf = lane >> 5; const float* wr = p.in[18];
    float acc = 0.f;
    for (int k = hf * 512; k < hf * 512 + 512; ++k) acc += hrow[k] * wr[k * NE + e];
    acc += __shfl_xor(acc, 32);
    float logit = acc + p.in[19][e];
    int my_e = 0; float my_v = 0.f, m0 = 0.f;
#pragma unroll
    for (int k = 0; k < 4; ++k) {
        const float m = wave_max(logit);
        const unsigned long long bal = __ballot(logit == m);
        const int idx = (int)(__ffsll((long long)bal) - 1) & 31;
        if (lane == k) { my_e = idx; my_v = m; }
        if (k == 0) m0 = m;
        if (e == idx) logit = -3.0e38f;
    }
    const float exv = (lane < 4) ? __expf(my_v - m0) : 0.f;
    const float es = __shfl(exv, 0) + __shfl(exv, 1) + __shfl(exv, 2) + __shfl(exv, 3);
    if (lane < 4) {
        const int ee = my_e; const float gv = exv;
        const unsigned slot = atomicAdd((unsigned*)(ws + WS_CTL) + CW_CNT + ee, 1u);
        ((int*)(ws + WS_LIST))[(size_t)ee * T + slot] = tok;
        ((int*)(ws + WS_TOKE))[tok * 4 + lane] = ee;
        ((int*)(ws + WS_TOKS))[tok * 4 + lane] = (int)slot;
        ((float*)(ws + WS_TOKG))[tok * 4 + lane] = gv / es;
    }
}

__global__ void __launch_bounds__(256) k_final(Ptrs p) {
    unsigned char* ws = p.ws;
    const int lane = threadIdx.x & 63, tok = blockIdx.x * 4 + (threadIdx.x >> 6);
    const unsigned* cnt = (const unsigned*)(ws + WS_CTL) + CW_CNT;
    float* h = p.out + (size_t)tok * D;
    f32x4 v[4];
#pragma unroll
    for (int j = 0; j < 4; ++j) v[j] = ((const f32x4*)h)[lane + 64 * j];
    for (int k = 0; k < 4; ++k) {
        const int e = ((const int*)(ws + WS_TOKE))[tok * 4 + k], slot = ((const int*)(ws + WS_TOKS))[tok * 4 + k]; const float gt = ((const float*)(ws + WS_TOKG))[tok * 4 + k];
        int c, ps; moe_prefix(cnt, e, c, ps);
        const unsigned long long* y8 = (const unsigned long long*)((const bf16*)(ws + WS_Y) + (size_t)(ps + slot) * 1024) + lane;
#pragma unroll
        for (int j = 0; j < 4; ++j) { const unsigned long long w = y8[64 * j]; const unsigned lo = (unsigned)w, hi = (unsigned)(w >> 32);
            v[j].x += gt * bf2f(lo & 0xffffu); v[j].y += gt * bf2f(lo >> 16); v[j].z += gt * bf2f(hi & 0xffffu); v[j].w += gt * bf2f(hi >> 16); }
    }
    float s = 0.f;
#pragma unroll
    for (int j = 0; j < 4; ++j) s += (v[j].x * v[j].x + v[j].y * v[j].y) + (v[j].z * v[j].z + v[j].w * v[j].w);
    const float rs = 1.0f / sqrtf(wave_sum(s) * (1.f / D) + EPS);
    const f32x4* gr = (const f32x4*)p.in[24] + lane;
#pragma unroll
    for (int j = 0; j < 4; ++j) { const f32x4 gg = gr[64 * j]; f32x4 y; y.x = v[j].x * rs * gg.x; y.y = v[j].y * rs * gg.y; y.z = v[j].z * rs * gg.z; y.w = v[j].w * rs * gg.w; ((f32x4*)h)[lane + 64 * j] = y; }
}


#define LAS __attribute__((address_space(3)))
typedef short bf16x8 __attribute__((ext_vector_type(8)));
typedef unsigned u32x4 __attribute__((ext_vector_type(4)));
namespace pg {
constexpr int BM = 256, BK = 64, HALF = 128, HTB = HALF * BK * 2, STAGE_BYTES = 8 * HTB, GK = 1024;
__host__ __device__ __forceinline__ int lds_byte(int r, int c) { const int st = (r >> 4) * 2 + (c >> 5), rr = r & 15, cc = c & 31, ob = rr * 64 + cc * 2; return st * 1024 + (ob ^ (((ob >> 9) & 1) << 5)); }
__host__ __device__ __forceinline__ void stage_rc(int b, int& R, int& C) { const int st = b / 1024, sb = b % 1024, swz = sb ^ (((sb >> 9) & 1) << 5); R = (st >> 1) * 16 + swz / 64; C = (st & 1) * 32 + (swz % 64) / 2; }
__host__ __device__ __forceinline__ int perm32(int rho) { const int n = rho >> 4, i = rho & 15; return 8 * (i >> 2) + 4 * n + (i & 3); }
__device__ __forceinline__ unsigned cvt_pk_bf16(float lo, float hi) { unsigned r; asm volatile("v_cvt_pk_bf16_f32 %0, %1, %2" : "=v"(r) : "v"(lo), "v"(hi)); return r; }

struct GU {
    const char* A;
    const char* B;
    char* O;
    const float* bias;
    int ldc; float scale; int gslot; int pad;
};

struct EpiBf16 {
    static constexpr bool PERM = true;
    __device__ __forceinline__ void operator()(const f32x4 (&acc)[2][2][4][2], const GU& u, int wr, int wc, int fr, int fq) const {
        bf16* base = (bf16*)u.O + (size_t)(wr * 64 + fr) * u.ldc + wc * 32 + 8 * fq; const float sc = u.scale;
        f32x4 bv[2][2];
#pragma unroll
        for (int bj = 0; bj < 2; ++bj)
#pragma unroll
            for (int n = 0; n < 2; ++n) bv[bj][n] = u.bias ? *(const f32x4*)(u.bias + bj * HALF + wc * 32 + 8 * fq + 4 * n) : (f32x4){0.f, 0.f, 0.f, 0.f};
#pragma unroll
        for (int ai = 0; ai < 2; ++ai)
#pragma unroll
            for (int m = 0; m < 4; ++m) { bf16* rowp = base + (size_t)(ai * HALF + m * 16) * u.ldc;
#pragma unroll
                for (int bj = 0; bj < 2; ++bj) { const f32x4 v0 = (acc[ai][bj][m][0] + bv[bj][0]) * sc, v1 = (acc[ai][bj][m][1] + bv[bj][1]) * sc;
                    u32x4 w; w.x = cvt_pk_bf16(v0[0], v0[1]); w.y = cvt_pk_bf16(v0[2], v0[3]); w.z = cvt_pk_bf16(v1[0], v1[1]); w.w = cvt_pk_bf16(v1[2], v1[3]);
                    *(u32x4*)(rowp + bj * HALF) = w; } }
    }
};
struct EpiResid {
    static constexpr bool PERM = false;
    __device__ __forceinline__ void operator()(const f32x4 (&acc)[2][2][4][2], const GU& u, int wr, int wc, int fr, int fq) const {
        const size_t o0 = (size_t)(wr * 64 + fr) * u.ldc + wc * 32 + 4 * fq;
#pragma unroll
        for (int ai = 0; ai < 2; ++ai)
#pragma unroll
            for (int m = 0; m < 4; ++m) { const size_t o = o0 + (size_t)(ai * HALF + m * 16) * u.ldc;
#pragma unroll
                for (int bj = 0; bj < 2; ++bj)
#pragma unroll
                    for (int n = 0; n < 2; ++n) *(f32x4*)((float*)u.O + o + bj * HALF + n * 16) = *(const f32x4*)(u.bias + o + bj * HALF + n * 16) + acc[ai][bj][m][n]; }
    }
};
struct EpiSwiGLU {
    static constexpr bool PERM = true;
    __device__ __forceinline__ void operator()(const f32x4 (&acc)[2][2][4][2], const GU& u, int wr, int wc, int fr, int fq) const {
        bf16* base = (bf16*)u.O + (size_t)(wr * 64 + fr) * u.ldc + wc * 32 + 8 * fq;
        f32x4 bg[2], bu[2];
#pragma unroll
        for (int n = 0; n < 2; ++n) { bg[n] = *(const f32x4*)(u.bias + wc * 32 + 8 * fq + 4 * n); bu[n] = *(const f32x4*)(u.bias + 1024 + wc * 32 + 8 * fq + 4 * n); }
#pragma unroll
        for (int ai = 0; ai < 2; ++ai)
#pragma unroll
            for (int m = 0; m < 4; ++m) { bf16* rowp = base + (size_t)(ai * HALF + m * 16) * u.ldc; float h[8];
#pragma unroll
                for (int n = 0; n < 2; ++n)
#pragma unroll
                    for (int j = 0; j < 4; ++j) { float g = acc[ai][0][m][n][j] + bg[n][j], up = acc[ai][1][m][n][j] + bu[n][j];
                        g = fminf(g, 7.0f); up = fminf(fmaxf(up, -7.0f), 7.0f);
                        h[4 * n + j] = (up + 1.0f) * (g * __builtin_amdgcn_rcpf(1.0f + __builtin_amdgcn_exp2f(-1.702f * 1.44269504f * g))); }
                u32x4 w; w.x = cvt_pk_bf16(h[0], h[1]); w.y = cvt_pk_bf16(h[2], h[3]); w.z = cvt_pk_bf16(h[4], h[5]); w.w = cvt_pk_bf16(h[6], h[7]);
                *(u32x4*)rowp = w; }
    }
};

template <class Epi, class Sched, bool GATHER>
__device__ __forceinline__ void gemm_phase(LAS unsigned char* lds, const Sched& S, const Epi& E, const LAS unsigned* gtab) {
    const int tid = threadIdx.x, wid = __builtin_amdgcn_readfirstlane(tid >> 6), lane = tid & 63, wr = wid >> 2, wc = wid & 3, fr = lane & 15, fq = lane >> 4;
    constexpr int K = GK, nt = K / BK;
    unsigned voffB[2]; int Rr[2], Cc2[2];
#pragma unroll
    for (int i = 0; i < 2; ++i) { int R, C; stage_rc(tid * 16 + i * 8192, R, C); const int Rb = Epi::PERM ? ((R & ~31) + perm32(R & 31)) : R;
        voffB[i] = (unsigned)(Rb * K + C) * 2u; Rr[i] = R; Cc2[i] = C * 2; }
    constexpr size_t kstep = (size_t)(BK * 2);
    constexpr size_t hstep = (size_t)HALF * K * 2;
    const unsigned ldsw = (unsigned)wid * 1024u;
    const int aoff = lds_byte(wr * 64 + fr, fq * 8), boff = lds_byte(wc * 32 + fr, fq * 8);
#define PG_SA(b, h) (((b) * 2 + (h)) * HTB)
#define PG_SB(b, h) ((4 + (b) * 2 + (h)) * HTB)
#define PG_STAGE(bufoff, gbase, voff) do { _Pragma("unroll") for (int _i = 0; _i < 2; ++_i) \
        __builtin_amdgcn_global_load_lds((const unsigned*)((const char*)(gbase) + (voff)[_i]), (LAS unsigned*)(lds + (bufoff) + ldsw + _i * 8192), 16, 0, 0); } while (0)
#define PG_LDA(dst, b, h) do { _Pragma("unroll") for (int m = 0; m < 4; ++m) _Pragma("unroll") for (int k = 0; k < 2; ++k) dst[m][k] = *(const LAS bf16x8*)(lds + PG_SA(b, h) + aoff + m * 2048 + k * 1024); } while (0)
#define PG_LDB(dst, b, h) do { _Pragma("unroll") for (int n = 0; n < 2; ++n) _Pragma("unroll") for (int k = 0; k < 2; ++k) dst[n][k] = *(const LAS bf16x8*)(lds + PG_SB(b, h) + boff + n * 2048 + k * 1024); } while (0)
#define PG_MMA(ai, bj, At, Bt) do { __builtin_amdgcn_s_setprio(1); _Pragma("unroll") for (int m = 0; m < 4; ++m) _Pragma("unroll") for (int n = 0; n < 2; ++n) _Pragma("unroll") for (int k = 0; k < 2; ++k) \
        acc[ai][bj][m][n] = __builtin_amdgcn_mfma_f32_16x16x32_bf16(Bt[n][k], At[m][k], acc[ai][bj][m][n], 0, 0, 0); __builtin_amdgcn_s_setprio(0); } while (0)
#define PG_WAIT_V(n) asm volatile("s_waitcnt vmcnt(" #n ")" ::: "memory")
#define PG_WAIT_L(n) asm volatile("s_waitcnt lgkmcnt(" #n ")" ::: "memory")
#define PG_BAR __builtin_amdgcn_s_barrier()
#define PG_SCHED __builtin_amdgcn_sched_barrier(0)
#define PG_LOADVO(vo, u) do { _Pragma("unroll") for (int _h = 0; _h < 2; ++_h) _Pragma("unroll") for (int _i = 0; _i < 2; ++_i) \
        vo[_h][_i] = GATHER ? (gtab[(u).gslot * 256 + _h * HALF + Rr[_i]] + (unsigned)Cc2[_i]) : (unsigned)((_h * HALF + Rr[_i]) * K * 2 + Cc2[_i]); } while (0)
    GU cur, nxt; int ui = 0;
    if (!S.next(0, cur)) return;
    f32x4 acc[2][2][4][2];
#pragma unroll
    for (int a = 0; a < 2; ++a)
#pragma unroll
        for (int b = 0; b < 2; ++b)
#pragma unroll
            for (int m = 0; m < 4; ++m)
#pragma unroll
                for (int n = 0; n < 2; ++n) acc[a][b][m][n] = (f32x4){0.f, 0.f, 0.f, 0.f};
    bf16x8 At[4][2], B0[2][2], B1[2][2];
    unsigned cvo[2][2], nvo[2][2];
    PG_LOADVO(cvo, cur);
    const char* cA = cur.A; const char* cB = cur.B;
    PG_STAGE(PG_SB(0, 0), cB, voffB); PG_STAGE(PG_SB(0, 1), cB + hstep, voffB); PG_STAGE(PG_SA(0, 0), cA, cvo[0]); PG_STAGE(PG_SA(0, 1), cA, cvo[1]);
    if (wr == 1) PG_BAR;
    PG_WAIT_V(2); PG_BAR;
    PG_STAGE(PG_SB(1, 0), cB + kstep, voffB); PG_STAGE(PG_SA(1, 0), cA + kstep, cvo[0]); PG_STAGE(PG_SB(1, 1), cB + hstep + kstep, voffB);
    PG_WAIT_V(6); PG_BAR;
    for (;;) {
        const bool has_next = S.next(ui + 1, nxt);
        const char* nA = has_next ? nxt.A : cA; const char* nB = has_next ? nxt.B : cB;
        if (GATHER) { if (has_next) { PG_LOADVO(nvo, nxt); } else {
#pragma unroll
            for (int h = 0; h < 2; ++h)
#pragma unroll
                for (int i = 0; i < 2; ++i) nvo[h][i] = cvo[h][i]; } }
        for (int t = 0; t < nt; t += 2) {
            const bool last = (t == nt - 2);
            const char* a1 = cA + (size_t)(t + 1) * kstep;
            const char* a2 = last ? nA : cA + (size_t)(t + 2) * kstep; const char* b2 = last ? nB : cB + (size_t)(t + 2) * kstep;
            const char* a3 = a2 + kstep; const char* b3 = b2 + kstep;
            unsigned vo2[2][2];
#pragma unroll
            for (int h = 0; h < 2; ++h)
#pragma unroll
                for (int i = 0; i < 2; ++i) vo2[h][i] = (GATHER && last) ? nvo[h][i] : cvo[h][i];
            PG_LDB(B0, 0, 0); PG_LDB(B1, 0, 1); PG_SCHED; PG_LDA(At, 0, 0); PG_STAGE(PG_SA(1, 1), a1, cvo[1]);
            PG_WAIT_V(8); PG_WAIT_L(0); PG_BAR; PG_MMA(0, 0, At, B0); PG_MMA(0, 1, At, B1); PG_BAR; PG_SCHED;
            PG_LDA(At, 0, 1); PG_STAGE(PG_SB(0, 0), b2, voffB); PG_STAGE(PG_SB(0, 1), b2 + hstep, voffB); PG_STAGE(PG_SA(0, 0), a2, vo2[0]);
            PG_WAIT_V(8); PG_WAIT_L(0); PG_BAR; PG_MMA(1, 0, At, B0); PG_MMA(1, 1, At, B1); PG_BAR; PG_SCHED;
            PG_LDB(B0, 1, 0); PG_LDB(B1, 1, 1); PG_SCHED; PG_LDA(At, 1, 0); PG_STAGE(PG_SA(0, 1), a2, vo2[1]);
            PG_WAIT_V(8); PG_WAIT_L(0); PG_BAR; PG_MMA(0, 0, At, B0); PG_MMA(0, 1, At, B1); PG_BAR; PG_SCHED;
            PG_LDA(At, 1, 1); PG_STAGE(PG_SB(1, 0), b3, voffB); PG_STAGE(PG_SB(1, 1), b3 + hstep, voffB); PG_STAGE(PG_SA(1, 0), a3, vo2[0]);
            PG_WAIT_V(8); PG_WAIT_L(0); PG_BAR; PG_MMA(1, 0, At, B0); PG_MMA(1, 1, At, B1); PG_BAR; PG_SCHED;
        }
        if (wr == 0) PG_BAR;
        E(acc, cur, wr, wc, fr, fq);
        if (!has_next) break;
#pragma unroll
        for (int a = 0; a < 2; ++a)
#pragma unroll
            for (int b = 0; b < 2; ++b)
#pragma unroll
                for (int m = 0; m < 4; ++m)
#pragma unroll
                    for (int n = 0; n < 2; ++n) acc[a][b][m][n] = (f32x4){0.f, 0.f, 0.f, 0.f};
        cur = nxt; cA = nA; cB = nB; ++ui;
        if (GATHER) {
#pragma unroll
            for (int h = 0; h < 2; ++h)
#pragma unroll
                for (int i = 0; i < 2; ++i) cvo[h][i] = nvo[h][i]; }
        if (wr == 1) PG_BAR;
    }
    PG_WAIT_V(0);
    PG_BAR;
#undef PG_SA
#undef PG_SB
#undef PG_STAGE
#undef PG_LDA
#undef PG_LDB
#undef PG_MMA
#undef PG_WAIT_V
#undef PG_WAIT_L
#undef PG_BAR
#undef PG_SCHED
#undef PG_LOADVO
}
}

constexpr int NWAVES = 8;
constexpr int RING_OFF = 0, RING_BYTES = 131072;
constexpr int GTAB_OFF = RING_BYTES, GTAB_BYTES = 18 * 1024;
constexpr int UTAB_OFF = GTAB_OFF + GTAB_BYTES, UTAB_BYTES = 1024;
constexpr int MISC_OFF = UTAB_OFF + UTAB_BYTES;
constexpr int LDS_BYTES = MISC_OFF + 512;
static_assert(LDS_BYTES <= 160 * 1024, "LDS");

struct MKArgs { Ptrs p; int ph_lo, ph_hi; };

#define XB_TMO      128
#define XB_XCNT(j)  (256  + 64 * (j))
#define XB_XSUB(j)  (1280 + 64 * (j))
#define XB_XGEN(j)  (2304 + 64 * (j))
#define XB_TOP      3328
#define XB_TOPGEN   3392
#define XCD_BAR_WORDS 3456
#define XB_SPIN_CAP (1u << 18)
__device__ __forceinline__ unsigned xb_ld(unsigned* p)              { return __hip_atomic_load(p, __ATOMIC_RELAXED, __HIP_MEMORY_SCOPE_AGENT); }
__device__ __forceinline__ unsigned xb_add(unsigned* p, unsigned v) { return __hip_atomic_fetch_add(p, v, __ATOMIC_RELAXED, __HIP_MEMORY_SCOPE_AGENT); }
__device__ __forceinline__ unsigned xb_xcc_id() { return (unsigned)__builtin_amdgcn_s_getreg((3 << 11) | 20) & 0xFu; }
#define XB_SPIN(cond, bar) do { unsigned _sp = 0; while (cond) { __builtin_amdgcn_s_sleep(1); \
    if ((++_sp & 255u) == 0u) { if (xb_ld(&(bar)[XB_TMO])) break; if (_sp > XB_SPIN_CAP) { atomicAdd(&(bar)[XB_TMO], 1u); break; } } } } while (0)
struct XcdBarrier { unsigned* bar; unsigned x; volatile LAS unsigned* st; };
__device__ __forceinline__ XcdBarrier xcd_barrier_post(unsigned* bar, volatile LAS unsigned* st) {
    XcdBarrier b; b.bar = bar; b.x = xb_xcc_id(); b.st = st;
    if (threadIdx.x == 0) (void)xb_add(&bar[XB_XCNT(b.x)], 1u);
    return b;
}
__device__ __forceinline__ void xcd_barrier_complete(unsigned* bar, unsigned x, unsigned& nloc, unsigned& nx) {
    const unsigned G = gridDim.x * gridDim.y * gridDim.z;
    unsigned sum, cnt, mine, sp = 0u;
    for (;;) {
        sum = 0u; cnt = 0u; mine = 0u;
#pragma unroll
        for (unsigned j = 0; j < 16; ++j) { const unsigned c = xb_ld(&bar[XB_XCNT(j)]); sum += c; cnt += (c > 0u) ? 1u : 0u; mine = (j == x) ? c : mine; }
        if (sum == G) break;
        __builtin_amdgcn_s_sleep(1);
        if ((++sp & 255u) == 0u) { if (xb_ld(&bar[XB_TMO])) break; if (sp > XB_SPIN_CAP) { atomicAdd(&bar[XB_TMO], 1u); break; } }
    }
    nloc = mine > 0u ? mine : 1u; nx = cnt > 0u ? cnt : 1u;
}
__device__ __forceinline__ void xcd_barrier(const XcdBarrier& b) {
    asm volatile("s_waitcnt vmcnt(0)" ::: "memory");
    __syncthreads();
    if (threadIdx.x == 0) {
        unsigned* bar = b.bar;
        __builtin_amdgcn_s_waitcnt(0);
        unsigned nloc = b.st[0], nx = b.st[1];
        if (nloc == 0u) { xcd_barrier_complete(bar, b.x, nloc, nx); b.st[0] = nloc; b.st[1] = nx; }
        const unsigned old = xb_add(&bar[XB_XSUB(b.x)], 1u);
        const unsigned gen = old / nloc;
        if (old + 1u == (gen + 1u) * nloc) {
            __builtin_amdgcn_fence(__ATOMIC_RELEASE, "agent");
            asm volatile("s_waitcnt vmcnt(0)" ::: "memory");
            const unsigned og = xb_add(&bar[XB_TOP], 1u);
            const unsigned tg = og / nx;
            if (og + 1u == (tg + 1u) * nx) xb_add(&bar[XB_TOPGEN], 1u);
            else XB_SPIN(xb_ld(&bar[XB_TOPGEN]) == tg, bar);
            __builtin_amdgcn_fence(__ATOMIC_ACQUIRE, "agent");
            xb_add(&bar[XB_XGEN(b.x)], 1u);
            asm volatile("s_waitcnt vmcnt(0)" ::: "memory");
        } else {
            XB_SPIN(xb_ld(&bar[XB_XGEN(b.x)]) == gen, bar);
            __builtin_amdgcn_fence(__ATOMIC_ACQUIRE, "agent");
            asm volatile("s_waitcnt vmcnt(0)" ::: "memory");
        }
    }
    __syncthreads();
}
constexpr int CW_BAR = 4096;

struct SchedP1 {
    int G, c; unsigned char* ws; const float* b_glu;
    static constexpr int N_A = 128 * 7, N_B = 256, N_C = 32, NU = N_A + N_B + N_C;
    __device__ __forceinline__ bool next(int i, pg::GU& u) const {
        const int L = i * G + c; if (L >= NU) return false;
        u.bias = nullptr; u.scale = 1.0f; u.gslot = 0; u.pad = 0;
        if (L < N_A) { const int pm = L / 7, pn = L % 7;
            u.A = (const char*)(ws + WS_XN) + (size_t)pm * 256 * 2048;
            const int brow = pn < 4 ? 256 * pn : 256 * (pn + 2); u.B = (const char*)(ws + WS_WIN) + (size_t)brow * 2048;
            if (pn < 2) { u.O = (char*)(ws + WS_Q) + ((size_t)pm * 256 * 512 + pn * 256) * 2; u.ldc = 512; u.scale = 0.125f; }
            else if (pn < 4) { u.O = (char*)(ws + WS_K) + ((size_t)pm * 256 * 512 + (pn - 2) * 256) * 2; u.ldc = 512; }
            else if (pn < 6) { u.O = (char*)(ws + WS_GLU) + ((size_t)pm * 256 * 512 + (pn - 4) * 256) * 2; u.ldc = 512; u.bias = b_glu + (pn - 4) * 256; }
            else { u.O = (char*)(ws + WS_QMX) + ((size_t)pm * 256 * 256) * 2; u.ldc = 256; u.scale = 0.125f; }
        } else if (L < N_A + N_B) { const int q = L - N_A, pn = q >> 1, pm = q & 1;
            u.A = (const char*)(ws + WS_WIN) + (size_t)(1024 + 256 * pm) * 2048; u.B = (const char*)(ws + WS_XN) + (size_t)pn * 256 * 2048;
            u.O = (char*)(ws + WS_VT) + ((size_t)(256 * pm) * T + 256 * pn) * 2; u.ldc = T;
        } else { int q = L - N_A - N_B;
            if (q < 16) { u.A = (const char*)(ws + WS_MEMN) + (size_t)q * 256 * 2048; u.B = (const char*)(ws + WS_WMKV); u.O = (char*)(ws + WS_MEMK) + (size_t)q * 256 * 256 * 2; u.ldc = 256; }
            else { q -= 16; u.A = (const char*)(ws + WS_WMKV) + (size_t)256 * 2048; u.B = (const char*)(ws + WS_MEMN) + (size_t)q * 256 * 2048; u.O = (char*)(ws + WS_MEMVT) + (size_t)q * 256 * 2; u.ldc = TM; }
        }
        return true;
    }
};

struct SchedP3 {
    int G, c; unsigned char* ws; const float* x; float* out;
    __device__ __forceinline__ bool next(int i, pg::GU& u) const {
        const int L = i * G + c; if (L >= 512) return false;
        const int pm = L >> 2, pn = L & 3;
        u.A = (const char*)(ws + WS_CAT) + (size_t)pm * 256 * 2048; u.B = (const char*)(ws + WS_WOUT) + (size_t)pn * 256 * 2048;
        const size_t o = (size_t)pm * 256 * 1024 + pn * 256; u.O = (char*)(out + o); u.bias = x + o; u.ldc = 1024; u.scale = 1.0f; u.gslot = 0; u.pad = 0;
        return true;
    }
};
constexpr int UT_CNT = 0, UT_PST = 32, UT_UST = 64, UT_TOT = 96, UT_UNIT = 128, MAXU = 18;
template <int NPN>
__device__ __forceinline__ void moe_tables(LAS int* ut, const unsigned* cnt, int G, int vcu, int tid) {
    if (tid < 64) {
        const int c = tid < 32 ? (int)cnt[tid] : 0; const int np = (c + 255) >> 8;
        int incl = np;
#pragma unroll
        for (int o = 1; o < 32; o <<= 1) { const int v = __shfl_up(incl, o); if ((tid & 63) >= o) incl += v; }
        const int excl = incl - np;
        if (tid < 32) { ut[UT_CNT + tid] = c; ut[UT_PST + tid] = excl * 256; ut[UT_UST + tid] = excl * NPN; }
        if (tid == 31) ut[UT_TOT] = incl * NPN;
    }
    __syncthreads();
    if (tid < MAXU) {
        const int L = tid * G + vcu, U = ut[UT_TOT];
        int e = -1;
        if (L < U) { e = 0; for (int j = 1; j < 32; ++j) if (ut[UT_UST + j] <= L) e = j; }
        const int q = e >= 0 ? L - ut[UT_UST + e] : 0;
        ut[UT_UNIT + 4 * tid + 0] = e; ut[UT_UNIT + 4 * tid + 1] = q / NPN; ut[UT_UNIT + 4 * tid + 2] = q % NPN; ut[UT_UNIT + 4 * tid + 3] = e >= 0 ? ut[UT_PST + e] : 0;
    }
    __syncthreads();
}
struct SchedGU {
    const LAS int* ut; unsigned char* ws; const float* b_gu;
    __device__ __forceinline__ bool next(int i, pg::GU& u) const {
        if (i >= MAXU) return false;
        const int e = __builtin_amdgcn_readfirstlane(ut[UT_UNIT + 4 * i]); if (e < 0) return false;
        const int panel = __builtin_amdgcn_readfirstlane(ut[UT_UNIT + 4 * i + 1]), pn = __builtin_amdgcn_readfirstlane(ut[UT_UNIT + 4 * i + 2]), pst = __builtin_amdgcn_readfirstlane(ut[UT_UNIT + 4 * i + 3]);
        u.A = (const char*)(ws + WS_HN); u.B = (const char*)(ws + WS_WGU) + ((size_t)e * 2048 + pn * 256) * 2048;
        u.O = (char*)(ws + WS_HACT) + ((size_t)(pst + panel * 256) * 1024 + pn * 128) * 2; u.bias = b_gu + (size_t)e * 2048 + pn * 128; u.ldc = 1024; u.scale = 1.0f; u.gslot = i; u.pad = 0;
        return true;
    }
};
struct SchedDN {
    const LAS int* ut; unsigned char* ws; const float* b_dn;
    __device__ __forceinline__ bool next(int i, pg::GU& u) const {
        if (i >= MAXU) return false;
        const int e = __builtin_amdgcn_readfirstlane(ut[UT_UNIT + 4 * i]); if (e < 0) return false;
        const int panel = __builtin_amdgcn_readfirstlane(ut[UT_UNIT + 4 * i + 1]), pn = __builtin_amdgcn_readfirstlane(ut[UT_UNIT + 4 * i + 2]), pst = __builtin_amdgcn_readfirstlane(ut[UT_UNIT + 4 * i + 3]);
        u.A = (const char*)(ws + WS_HACT) + (size_t)(pst + panel * 256) * 2048; u.B = (const char*)(ws + WS_WDN) + ((size_t)e * 1024 + pn * 256) * 2048;
        u.O = (char*)(ws + WS_Y) + ((size_t)(pst + panel * 256) * 1024 + pn * 256) * 2; u.bias = b_dn + (size_t)e * 1024 + pn * 256; u.ldc = 1024; u.scale = 1.0f; u.gslot = 0; u.pad = 0;
        return true;
    }
};

typedef float f32x16 __attribute__((ext_vector_type(16)));
typedef short s16x4 __attribute__((ext_vector_type(4)));
#define MFMA32(a, b, c) __builtin_amdgcn_mfma_f32_32x32x16_bf16((a), (b), (c), 0, 0, 0)
__device__ __forceinline__ bf16x8 pack8(float a0, float a1, float a2, float a3, float a4, float a5, float a6, float a7) {
    u32x4 p; p.x = pg::cvt_pk_bf16(a0, a1); p.y = pg::cvt_pk_bf16(a2, a3); p.z = pg::cvt_pk_bf16(a4, a5); p.w = pg::cvt_pk_bf16(a6, a7);
    return __builtin_bit_cast(bf16x8, p);
}
__device__ __forceinline__ bf16x8 load_vt_frag(const bf16* rowp, int h) {
    const s16x4 lo = *(const s16x4*)(rowp + 4 * h), hi = *(const s16x4*)(rowp + 8 + 4 * h);
    return __builtin_shufflevector(lo, hi, 0, 1, 2, 3, 4, 5, 6, 7);
}
__device__ __forceinline__ void sb_unit(unsigned char* ws, LAS unsigned char* lds, int unit, int wave, int lane) {
    const int b = unit >> 5, t0 = (unit & 31) * 64, hd = wave, r = lane & 31, h = lane >> 5;
    const size_t tb = (size_t)b * S;
    const bf16* Q = (const bf16*)(ws + WS_Q); const bf16* Kp = (const bf16*)(ws + WS_K); const bf16* VT = (const bf16*)(ws + WS_VT);
    bf16x8 qf[2][4];
#pragma unroll
    for (int ni = 0; ni < 2; ++ni)
#pragma unroll
        for (int kk = 0; kk < 4; ++kk) qf[ni][kk] = *(const bf16x8*)(Q + (tb + t0 + 32 * ni + r) * 512 + hd * 64 + 16 * kk + 8 * h);
    f32x16 oacc[2][2];
#pragma unroll
    for (int di = 0; di < 2; ++di)
#pragma unroll
        for (int ni = 0; ni < 2; ++ni)
#pragma unroll
            for (int i = 0; i < 16; ++i) oacc[di][ni][i] = 0.f;
    float carry[2] = {0.f, 0.f};
    for (int s0 = t0 + 32; s0 >= 0; s0 -= 32) {
        bf16x8 kf[4];
#pragma unroll
        for (int kk = 0; kk < 4; ++kk) kf[kk] = *(const bf16x8*)(Kp + (tb + s0 + r) * 512 + hd * 64 + 16 * kk + 8 * h);
        bf16x8 vf[2][2];
#pragma unroll
        for (int di = 0; di < 2; ++di)
#pragma unroll
            for (int ks = 0; ks < 2; ++ks) vf[di][ks] = load_vt_frag(VT + (size_t)(hd * 64 + 32 * di + r) * T + tb + s0 + 16 * ks, h);
        const bool diag = (s0 + 31 >= t0);
        bf16x8 pf[2][2];
#pragma unroll
        for (int ni = 0; ni < 2; ++ni) {
            f32x16 sa;
#pragma unroll
            for (int i = 0; i < 16; ++i) sa[i] = 0.f;
#pragma unroll
            for (int kk = 0; kk < 4; ++kk) sa = MFMA32(kf[kk], qf[ni][kk], sa);
            float lnb[16], lb[16];
#pragma unroll
            for (int i = 0; i < 16; ++i) {
                const float z = sa[i];
                const float l = __logf(1.0f + __expf(-fabsf(z)));
                float n_ = -(fmaxf(z, 0.f) + l), b_ = n_ + z;
                if (diag) { const int key = s0 + (i & 3) + 8 * (i >> 2) + 4 * h, tq = t0 + 32 * ni + r; if (!(key < tq)) { n_ = 0.f; b_ = -1.0e30f; } }
                lnb[i] = n_; lb[i] = b_;
            }
            float Tg[4], Pg[4];
#pragma unroll
            for (int g = 0; g < 4; ++g) { const float Gs = (lnb[4 * g] + lnb[4 * g + 1]) + (lnb[4 * g + 2] + lnb[4 * g + 3]); Pg[g] = __shfl_xor(Gs, 32); Tg[g] = Gs + Pg[g]; }
            float suf[4]; suf[3] = 0.f; suf[2] = Tg[3]; suf[1] = Tg[3] + Tg[2]; suf[0] = suf[1] + Tg[1];
            const float total = suf[0] + Tg[0];
            float av[16];
#pragma unroll
            for (int g = 0; g < 4; ++g) {
                const float base = carry[ni] + suf[g] + (h == 0 ? Pg[g] : 0.f);
                const float a3 = base, a2 = a3 + lnb[4 * g + 3], a1 = a2 + lnb[4 * g + 2], a0 = a1 + lnb[4 * g + 1];
                av[4 * g + 3] = __expf(lb[4 * g + 3] + a3); av[4 * g + 2] = __expf(lb[4 * g + 2] + a2); av[4 * g + 1] = __expf(lb[4 * g + 1] + a1); av[4 * g] = __expf(lb[4 * g] + a0);
            }
            carry[ni] += total;
            pf[ni][0] = pack8(av[0], av[1], av[2], av[3], av[4], av[5], av[6], av[7]);
            pf[ni][1] = pack8(av[8], av[9], av[10], av[11], av[12], av[13], av[14], av[15]);
        }
#pragma unroll
        for (int di = 0; di < 2; ++di)
#pragma unroll
            for (int ni = 0; ni < 2; ++ni)
#pragma unroll
                for (int ks = 0; ks < 2; ++ks) oacc[di][ni] = MFMA32(vf[di][ks], pf[ni][ks], oacc[di][ni]);
        if (__all((carry[0] < SB_EXIT) && (carry[1] < SB_EXIT))) break;
    }
    LAS float* ssq = (LAS float*)lds;
    float ss[2];
#pragma unroll
    for (int ni = 0; ni < 2; ++ni) { float v = 0.f;
#pragma unroll
        for (int di = 0; di < 2; ++di)
#pragma unroll
            for (int i = 0; i < 16; ++i) v += oacc[di][ni][i] * oacc[di][ni][i];
        v += __shfl_xor(v, 32); ss[ni] = v;
        if (h == 0) ssq[(32 * ni + r) * 8 + hd] = v; }
    __syncthreads();
    bf16* cat = (bf16*)(ws + WS_CAT);
#pragma unroll
    for (int ni = 0; ni < 2; ++ni) {
        float tot = 0.f;
#pragma unroll
        for (int w = 0; w < 8; ++w) tot += ssq[(32 * ni + r) * 8 + w];
        const float rs = 1.0f / sqrtf(tot * (1.f / 512.f) + EPS);
        bf16* rowp = cat + (tb + t0 + 32 * ni + r) * 1024 + hd * 64 + 4 * h;
#pragma unroll
        for (int di = 0; di < 2; ++di)
#pragma unroll
            for (int g = 0; g < 4; ++g) { unsigned long long w = (unsigned long long)pg::cvt_pk_bf16(oacc[di][ni][4 * g] * rs, oacc[di][ni][4 * g + 1] * rs) | ((unsigned long long)pg::cvt_pk_bf16(oacc[di][ni][4 * g + 2] * rs, oacc[di][ni][4 * g + 3] * rs) << 32);
                *(unsigned long long*)(rowp + 32 * di + 8 * g) = w; }
    }
    __syncthreads();
}

__device__ __forceinline__ void mx_unit(unsigned char* ws, LAS unsigned char* lds, int unit, int wave, int lane) {
    const int b = unit >> 5, t0 = (unit & 31) * 64, hd = wave & 3, qh = wave >> 2, r = lane & 31, h = lane >> 5;
    const size_t tb = (size_t)b * S;
    const bf16* QM = (const bf16*)(ws + WS_QMX); const bf16* MK = (const bf16*)(ws + WS_MEMK); const bf16* MVT = (const bf16*)(ws + WS_MEMVT);
    bf16x8 qf[4];
#pragma unroll
    for (int kk = 0; kk < 4; ++kk) qf[kk] = *(const bf16x8*)(QM + (tb + t0 + 32 * qh + r) * 256 + hd * 64 + 16 * kk + 8 * h);
    f32x16 sa[8];
#pragma unroll
    for (int mi = 0; mi < 8; ++mi) {
#pragma unroll
        for (int i = 0; i < 16; ++i) sa[mi][i] = 0.f;
#pragma unroll
        for (int kk = 0; kk < 4; ++kk) { const bf16x8 kf = *(const bf16x8*)(MK + (size_t)(b * NMEM + 32 * mi + r) * 256 + hd * 64 + 16 * kk + 8 * h); sa[mi] = MFMA32(kf, qf[kk], sa[mi]); }
    }
    float mx = -3.0e38f;
#pragma unroll
    for (int mi = 0; mi < 8; ++mi)
#pragma unroll
        for (int i = 0; i < 16; ++i) mx = fmaxf(mx, sa[mi][i]);
    mx = fmaxf(mx, __shfl_xor(mx, 32));
    float sum = 0.f;
#pragma unroll
    for (int mi = 0; mi < 8; ++mi)
#pragma unroll
        for (int i = 0; i < 16; ++i) { const float pv = __expf(sa[mi][i] - mx); sa[mi][i] = pv; sum += pv; }
    sum += __shfl_xor(sum, 32);
    f32x16 oacc[2];
#pragma unroll
    for (int di = 0; di < 2; ++di)
#pragma unroll
        for (int i = 0; i < 16; ++i) oacc[di][i] = 0.f;
#pragma unroll
    for (int mi = 0; mi < 8; ++mi)
#pragma unroll
        for (int s2 = 0; s2 < 2; ++s2) {
            const bf16x8 pf = pack8(sa[mi][8 * s2], sa[mi][8 * s2 + 1], sa[mi][8 * s2 + 2], sa[mi][8 * s2 + 3], sa[mi][8 * s2 + 4], sa[mi][8 * s2 + 5], sa[mi][8 * s2 + 6], sa[mi][8 * s2 + 7]);
#pragma unroll
            for (int di = 0; di < 2; ++di) { const bf16x8 vf = load_vt_frag(MVT + (size_t)(hd * 64 + 32 * di + r) * TM + b * NMEM + 32 * mi + 16 * s2, h); oacc[di] = MFMA32(vf, pf, oacc[di]); }
        }
    const float inv = 1.0f / sum;
    LAS float* ssq = (LAS float*)lds;
    float v = 0.f;
#pragma unroll
    for (int di = 0; di < 2; ++di)
#pragma unroll
        for (int i = 0; i < 16; ++i) { oacc[di][i] *= inv; v += oacc[di][i] * oacc[di][i]; }
    v += __shfl_xor(v, 32);
    if (h == 0) ssq[(32 * qh + r) * 4 + hd] = v;
    __syncthreads();
    const float tot = (ssq[(32 * qh + r) * 4 + 0] + ssq[(32 * qh + r) * 4 + 1]) + (ssq[(32 * qh + r) * 4 + 2] + ssq[(32 * qh + r) * 4 + 3]);
    const float rs = 1.0f / sqrtf(tot * (1.f / 256.f) + EPS);
    bf16* rowp = (bf16*)(ws + WS_CAT) + (tb + t0 + 32 * qh + r) * 1024 + 768 + hd * 64 + 4 * h;
#pragma unroll
    for (int di = 0; di < 2; ++di)
#pragma unroll
        for (int g = 0; g < 4; ++g) { unsigned long long w = (unsigned long long)pg::cvt_pk_bf16(oacc[di][4 * g] * rs, oacc[di][4 * g + 1] * rs) | ((unsigned long long)pg::cvt_pk_bf16(oacc[di][4 * g + 2] * rs, oacc[di][4 * g + 3] * rs) << 32);
            *(unsigned long long*)(rowp + 32 * di + 8 * g) = w; }
    __syncthreads();
}

constexpr int CV_U_OFF = 0, CV_ACT_OFF = 96256, CV_ACT_PITCH = 528, CV_SSQ_OFF = 65536;
static_assert(CV_ACT_OFF + 64 * CV_ACT_PITCH <= RING_BYTES, "conv LDS");
__device__ __forceinline__ void cv_unit(const Ptrs& p, LAS unsigned char* lds, int unit, int tid, int wave, int lane) {
    unsigned char* ws = p.ws;
    const int b = unit >> 5, t0 = (unit & 31) * 64;
    const size_t tb = (size_t)b * S;
    LAS float* U = (LAS float*)(lds + CV_U_OFF);
    const bf16* GLU = (const bf16*)(ws + WS_GLU);
    for (int it = tid; it < 94 * 32; it += NWAVES * 64) {
        const int row = it >> 5, ch = (it & 31) * 8, tl = t0 - (CONVK - 1) + row;
        f32x4 u0 = (f32x4){0.f, 0.f, 0.f, 0.f}, u1 = u0;
        if (tl >= 0) {
            const v4u av = *(const v4u*)(GLU + (tb + tl) * 512 + ch), gv = *(const v4u*)(GLU + (tb + tl) * 512 + 256 + ch);
            float uu[8];
#pragma unroll
            for (int j = 0; j < 4; ++j) { const float a0 = bf2f(av[j] & 0xffffu), a1 = bf2f(av[j] >> 16), g0 = bf2f(gv[j] & 0xffffu), g1 = bf2f(gv[j] >> 16);
                uu[2 * j] = a0 / (1.0f + __expf(-g0)); uu[2 * j + 1] = a1 / (1.0f + __expf(-g1)); }
            u0 = (f32x4){uu[0], uu[1], uu[2], uu[3]}; u1 = (f32x4){uu[4], uu[5], uu[6], uu[7]};
        }
        *(LAS f32x4*)(U + row * 256 + ch) = u0; *(LAS f32x4*)(U + row * 256 + ch + 4) = u1;
    }
    __syncthreads();
    {
        const int c = tid & 255, th = tid >> 8;
        float w[CONVK], acc[32];
#pragma unroll
        for (int j = 0; j < CONVK; ++j) w[j] = p.in[5][j * CVW + c];
        const float bd = p.in[6][c];
#pragma unroll
        for (int tt = 0; tt < 32; ++tt) acc[tt] = bd;
#pragma unroll
        for (int ii = 0; ii < 62; ++ii) { const float uv = U[(32 * th + ii) * 256 + c];
#pragma unroll
            for (int tt = 0; tt < 32; ++tt) { const int j = ii - tt; if (j >= 0 && j < CONVK) acc[tt] += w[j] * uv; } }
        __syncthreads();
#pragma unroll
        for (int tt = 0; tt < 32; ++tt) U[(32 * th + tt) * 256 + c] = acc[tt];
    }
    __syncthreads();
    {
        const f32x4 gl = *(const f32x4*)(p.in[7] + 4 * lane), bl = *(const f32x4*)(p.in[8] + 4 * lane);
#pragma unroll
        for (int k = 0; k < 8; ++k) { const int tok = 8 * wave + k;
            const f32x4 x = *(const LAS f32x4*)(U + tok * 256 + 4 * lane);
            const float mu = wave_sum((x.x + x.y) + (x.z + x.w)) * (1.f / 256.f);
            const f32x4 d = x - mu;
            const float rstd = 1.0f / sqrtf(wave_sum((d.x * d.x + d.y * d.y) + (d.z * d.z + d.w * d.w)) * (1.f / 256.f) + EPS);
            f32x4 y = d * rstd * gl + bl;
            y.x = y.x / (1.0f + __expf(-y.x)); y.y = y.y / (1.0f + __expf(-y.y)); y.z = y.z / (1.0f + __expf(-y.z)); y.w = y.w / (1.0f + __expf(-y.w));
            *(LAS unsigned long long*)(lds + CV_ACT_OFF + tok * CV_ACT_PITCH + 8 * lane) = (unsigned long long)pg::cvt_pk_bf16(y.x, y.y) | ((unsigned long long)pg::cvt_pk_bf16(y.z, y.w) << 32);
        }
    }
    __syncthreads();
    {
        const int r = lane & 31, h = lane >> 5;
        const bf16* WT = (const bf16*)(ws + WS_WPW2);
        f32x16 acc[2];
#pragma unroll
        for (int ti = 0; ti < 2; ++ti)
#pragma unroll
            for (int i = 0; i < 16; ++i) acc[ti][i] = 0.f;
#pragma unroll 4
        for (int kk = 0; kk < 16; ++kk) {
            const bf16x8 af = *(const bf16x8*)(WT + (size_t)(32 * wave + r) * 256 + 16 * kk + 8 * h);
#pragma unroll
            for (int ti = 0; ti < 2; ++ti) { const bf16x8 bfr = *(const LAS bf16x8*)(lds + CV_ACT_OFF + (32 * ti + r) * CV_ACT_PITCH + (16 * kk + 8 * h) * 2); acc[ti] = MFMA32(af, bfr, acc[ti]); }
        }
        LAS float* ssq = (LAS float*)(lds + CV_SSQ_OFF);
#pragma unroll
        for (int g = 0; g < 4; ++g) { const f32x4 bb = *(const f32x4*)(p.in[10] + 32 * wave + 8 * g + 4 * h);
#pragma unroll
            for (int ti = 0; ti < 2; ++ti) { acc[ti][4 * g] += bb.x; acc[ti][4 * g + 1] += bb.y; acc[ti][4 * g + 2] += bb.z; acc[ti][4 * g + 3] += bb.w; } }
#pragma unroll
        for (int ti = 0; ti < 2; ++ti) { float v = 0.f;
#pragma unroll
            for (int i = 0; i < 16; ++i) v += acc[ti][i] * acc[ti][i];
            v += __shfl_xor(v, 32);
            if (h == 0) ssq[(32 * ti + r) * 8 + wave] = v; }
        __syncthreads();
#pragma unroll
        for (int ti = 0; ti < 2; ++ti) { float tot = 0.f;
#pragma unroll
            for (int w2 = 0; w2 < 8; ++w2) tot += ssq[(32 * ti + r) * 8 + w2];
            const float rs = 1.0f / sqrtf(tot * (1.f / 256.f) + EPS);
            bf16* rowp = (bf16*)(ws + WS_CAT) + (tb + t0 + 32 * ti + r) * 1024 + 512 + 32 * wave + 4 * h;
#pragma unroll
            for (int g = 0; g < 4; ++g) { unsigned long long wv = (unsigned long long)pg::cvt_pk_bf16(acc[ti][4 * g] * rs, acc[ti][4 * g + 1] * rs) | ((unsigned long long)pg::cvt_pk_bf16(acc[ti][4 * g + 2] * rs, acc[ti][4 * g + 3] * rs) << 32);
                *(unsigned long long*)(rowp + 8 * g) = wv; } }
    }
    __syncthreads();
}

__global__ void __launch_bounds__(NWAVES * 64, 2) mk_fwd(MKArgs a) {
    extern __shared__ __attribute__((aligned(16))) unsigned char lds_raw[];
    LAS unsigned char* lds = (LAS unsigned char*)lds_raw;
    const int tid = threadIdx.x, lane = tid & 63, wave = __builtin_amdgcn_readfirstlane(tid >> 6);
    const int G = gridDim.x; const int bx = blockIdx.x; const int vcu = (G % 8 == 0) ? (bx % 8) * (G / 8) + bx / 8 : bx;
    unsigned char* ws = a.p.ws;
    const int lo = a.ph_lo, hi = a.ph_hi;
#define IN(k) (lo <= (k) && (k) < hi)
#define BOTH(k) (IN(k) && IN((k) + 1))
    volatile LAS unsigned* misc = (volatile LAS unsigned*)(lds + MISC_OFF);
    if (tid < 4) misc[tid] = 0u;
    __syncthreads();
    XcdBarrier bar; bar.bar = (unsigned*)(ws + WS_CTL) + CW_BAR; bar.x = 0; bar.st = misc;
    if (hi - lo > 1) bar = xcd_barrier_post((unsigned*)(ws + WS_CTL) + CW_BAR, misc);
    if (IN(0)) {
        float* scr = (float*)(lds_raw + RING_OFF + wave * 16384);
        const int gw = vcu * NWAVES + wave, NGW = G * NWAVES;
        const Ptrs& p = a.p;
        constexpr int I_IN = 16 * 72, I_OUT = 16 * 32, I_MKV = 16 * 16, I_PW2 = 4 * 8, I_GU = 32 * 16 * 64, I_DN = 32 * 16 * 32;
        constexpr int NIT = I_IN + I_OUT + I_MKV + I_PW2 + I_GU + I_DN;
        for (int it = gw; it < NIT; it += NGW) {
            int r = it;
            if (r < I_IN) { const int kb = r / 72, nb = r % 72; transpose_item(p.in[3], 1024, INW, (bf16*)(ws + WS_WIN), 64 * kb, 32 * nb, 32 * nb, nullptr, scr, lane); continue; } r -= I_IN;
            if (r < I_OUT) { const int kb = r / 32, nb = r % 32; const int k0 = 64 * kb;
                const float* ks = k0 < 512 ? p.in[13] : (k0 < 768 ? p.in[14] - 512 : p.in[15] - 768);
                transpose_item(p.in[16], 1024, 1024, (bf16*)(ws + WS_WOUT), k0, 32 * nb, 32 * nb, ks, scr, lane); continue; } r -= I_OUT;
            if (r < I_MKV) { const int kb = r / 16, nb = r % 16; transpose_item(p.in[12], 1024, 512, (bf16*)(ws + WS_WMKV), 64 * kb, 32 * nb, 32 * nb, nullptr, scr, lane); continue; } r -= I_MKV;
            if (r < I_PW2) { const int kb = r / 8, nb = r % 8; transpose_item(p.in[9], 256, 256, (bf16*)(ws + WS_WPW2), 64 * kb, 32 * nb, 32 * nb, nullptr, scr, lane); continue; } r -= I_PW2;
            if (r < I_GU) { const int e = r / 1024, q = r % 1024, kb = q / 64, nb = q % 64; const int n0 = 32 * nb, isup = n0 >> 10, cc = n0 & 1023, j = cc >> 7, c = cc & 127;
                transpose_item(p.in[20] + (size_t)e * 1024 * 2048, 1024, 2048, (bf16*)(ws + WS_WGU) + (size_t)e * 2048 * 1024, 64 * kb, n0, 256 * j + 128 * isup + c, nullptr, scr, lane); continue; } r -= I_GU;
            { const int e = r / 512, q = r % 512, kb = q / 32, nb = q % 32;
                transpose_item(p.in[22] + (size_t)e * 1024 * 1024, 1024, 1024, (bf16*)(ws + WS_WDN) + (size_t)e * 1024 * 1024, 64 * kb, 32 * nb, 32 * nb, nullptr, scr, lane); }
        }
        for (int m = gw; m < T; m += NGW) rms_row_to_bf16(p.in[0] + (size_t)m * D, p.in[2], (bf16*)(ws + WS_XN) + (size_t)m * D, lane);
        for (int m = gw; m < TM; m += NGW) rms_row_to_bf16(p.in[1] + (size_t)m * D, p.in[11], (bf16*)(ws + WS_MEMN) + (size_t)m * D, lane);
        __syncthreads();
        if (BOTH(0)) xcd_barrier(bar);
    }
    if (IN(1)) {
        SchedP1 Sc{G, vcu, ws, a.p.in[4]}; pg::EpiBf16 E;
        pg::gemm_phase<pg::EpiBf16, SchedP1, false>(lds + RING_OFF, Sc, E, nullptr);
        if (BOTH(1)) xcd_barrier(bar);
    }
    if (IN(2)) {
        for (int u = vcu; u < NB * (S / 64); u += G) sb_unit(ws, lds + RING_OFF, u, wave, lane);
        for (int u = vcu; u < NB * (S / 64); u += G) mx_unit(ws, lds + RING_OFF, u, wave, lane);
        for (int u = vcu; u < NB * (S / 64); u += G) cv_unit(a.p, lds + RING_OFF, u, tid, wave, lane);
        if (BOTH(2)) xcd_barrier(bar);
    }
    if (IN(3)) {
        SchedP3 Sc{G, vcu, ws, a.p.in[0], a.p.out}; pg::EpiResid E;
        pg::gemm_phase<pg::EpiResid, SchedP3, false>(lds + RING_OFF, Sc, E, nullptr);
        if (BOTH(3)) xcd_barrier(bar);
    }
    if (IN(4)) {
        const Ptrs& p = a.p;
        LAS float* hq = (LAS float*)(lds + RING_OFF + wave * 16384);
        const int gw = vcu * NWAVES + wave, NGW = G * NWAVES;
        const int e = lane & 31, hf = lane >> 5; const float* wr = p.in[18]; const float bre = p.in[19][e];
        const f32x4* gr = (const f32x4*)p.in[17] + lane;
        for (int t0 = gw * 4; t0 < T; t0 += NGW * 4) {
#pragma unroll
            for (int j4 = 0; j4 < 4; ++j4) {
                const int tok = t0 + j4;
                const f32x4* xr = (const f32x4*)(p.out + (size_t)tok * D) + lane;
                f32x4 v[4]; float s = 0.f;
#pragma unroll
                for (int j = 0; j < 4; ++j) { v[j] = xr[64 * j]; s += (v[j].x * v[j].x + v[j].y * v[j].y) + (v[j].z * v[j].z + v[j].w * v[j].w); }
                const float rs = 1.0f / sqrtf(wave_sum(s) * (1.f / D) + EPS);
                unsigned long long* o8 = (unsigned long long*)((bf16*)(ws + WS_HN) + (size_t)tok * D) + lane;
#pragma unroll
                for (int j = 0; j < 4; ++j) { const f32x4 gg = gr[64 * j]; f32x4 y; y.x = v[j].x * rs * gg.x; y.y = v[j].y * rs * gg.y; y.z = v[j].z * rs * gg.z; y.w = v[j].w * rs * gg.w;
                    o8[64 * j] = (unsigned long long)pk2(y.x, y.y) | ((unsigned long long)pk2(y.z, y.w) << 32);
                    const int k = 4 * lane + 256 * j;
                    hq[(k + 0) * 4 + j4] = y.x; hq[(k + 1) * 4 + j4] = y.y; hq[(k + 2) * 4 + j4] = y.z; hq[(k + 3) * 4 + j4] = y.w; }
            }
            asm volatile("s_waitcnt lgkmcnt(0)" ::: "memory");
            f32x4 acc = (f32x4){0.f, 0.f, 0.f, 0.f};
#pragma unroll 4
            for (int k = hf * 512; k < hf * 512 + 512; ++k) { const float w = wr[k * NE + e]; const f32x4 hv = *(const LAS f32x4*)(hq + k * 4); acc += hv * w; }
            asm volatile("s_waitcnt lgkmcnt(0)" ::: "memory");
#pragma unroll
            for (int j4 = 0; j4 < 4; ++j4) {
                const int tok = t0 + j4;
                float lg = acc[j4]; lg += __shfl_xor(lg, 32); lg += bre;
                int my_e = 0; float my_v = 0.f, m0 = 0.f;
#pragma unroll
                for (int k = 0; k < 4; ++k) {
                    const float m = wave_max(lg);
                    const unsigned long long bal = __ballot(lg == m);
                    const int idx = (int)(__ffsll((long long)bal) - 1) & 31;
                    if (lane == k) { my_e = idx; my_v = m; }
                    if (k == 0) m0 = m;
                    if (e == idx) lg = -3.0e38f;
                }
                const float exv = (lane < 4) ? __expf(my_v - m0) : 0.f;
                const float es = __shfl(exv, 0) + __shfl(exv, 1) + __shfl(exv, 2) + __shfl(exv, 3);
                if (lane < 4) {
                    const unsigned slot = atomicAdd((unsigned*)(ws + WS_CTL) + CW_CNT + my_e, 1u);
                    ((int*)(ws + WS_LIST))[(size_t)my_e * T + slot] = tok;
                    ((int*)(ws + WS_TOKE))[tok * 4 + lane] = my_e;
                    ((int*)(ws + WS_TOKS))[tok * 4 + lane] = (int)slot;
                    ((float*)(ws + WS_TOKG))[tok * 4 + lane] = exv / es;
                }
            }
        }
        __syncthreads();
        if (BOTH(4)) xcd_barrier(bar);
    }
    if (IN(5)) {
        LAS int* ut = (LAS int*)(lds + UTAB_OFF); LAS unsigned* gt = (LAS unsigned*)(lds + GTAB_OFF);
        moe_tables<8>(ut, (const unsigned*)(ws + WS_CTL) + CW_CNT, G, vcu, tid);
        for (int i = 0; i < MAXU; ++i) {
            const int e = ut[UT_UNIT + 4 * i]; if (e < 0) break;
            if (tid < 256) { const int row = ut[UT_UNIT + 4 * i + 1] * 256 + tid, c = ut[UT_CNT + e]; const int src = row < c ? row : c - 1;
                gt[i * 256 + tid] = (unsigned)((const int*)(ws + WS_LIST))[(size_t)e * T + src] * 2048u; }
        }
        __syncthreads();
        SchedGU Sc{ut, ws, a.p.in[21]}; pg::EpiSwiGLU E;
        pg::gemm_phase<pg::EpiSwiGLU, SchedGU, true>(lds + RING_OFF, Sc, E, gt);
        if (BOTH(5)) xcd_barrier(bar);
    }
    if (IN(6)) {
        LAS int* ut = (LAS int*)(lds + UTAB_OFF);
        moe_tables<4>(ut, (const unsigned*)(ws + WS_CTL) + CW_CNT, G, vcu, tid);
        SchedDN Sc{ut, ws, a.p.in[23]}; pg::EpiBf16 E;
        pg::gemm_phase<pg::EpiBf16, SchedDN, false>(lds + RING_OFF, Sc, E, nullptr);
        if (BOTH(6)) xcd_barrier(bar);
    }
    if (IN(7)) {
        const Ptrs& p = a.p;
        LAS int* ut = (LAS int*)(lds + UTAB_OFF);
        moe_tables<4>(ut, (const unsigned*)(ws + WS_CTL) + CW_CNT, G, vcu, tid);
        const int gw = vcu * NWAVES + wave, NGW = G * NWAVES;
        const f32x4* gr = (const f32x4*)p.in[24] + lane;
        for (int tok = gw; tok < T; tok += NGW) {
            float* h = p.out + (size_t)tok * D;
            f32x4 v[4];
#pragma unroll
            for (int j = 0; j < 4; ++j) v[j] = ((const f32x4*)h)[lane + 64 * j];
#pragma unroll
            for (int k = 0; k < 4; ++k) {
                const int e = ((const int*)(ws + WS_TOKE))[tok * 4 + k], slot = ((const int*)(ws + WS_TOKS))[tok * 4 + k]; const float gt = ((const float*)(ws + WS_TOKG))[tok * 4 + k];
                const int ps = ut[UT_PST + e];
                const unsigned long long* y8 = (const unsigned long long*)((const bf16*)(ws + WS_Y) + (size_t)(ps + slot) * 1024) + lane;
#pragma unroll
                for (int j = 0; j < 4; ++j) { const unsigned long long w = y8[64 * j]; const unsigned lo_ = (unsigned)w, hi_ = (unsigned)(w >> 32);
                    v[j].x += gt * bf2f(lo_ & 0xffffu); v[j].y += gt * bf2f(lo_ >> 16); v[j].z += gt * bf2f(hi_ & 0xffffu); v[j].w += gt * bf2f(hi_ >> 16); }
            }
            float s = 0.f;
#pragma unroll
            for (int j = 0; j < 4; ++j) s += (v[j].x * v[j].x + v[j].y * v[j].y) + (v[j].z * v[j].z + v[j].w * v[j].w);
            const float rs = 1.0f / sqrtf(wave_sum(s) * (1.f / D) + EPS);
#pragma unroll
            for (int j = 0; j < 4; ++j) { const f32x4 gg = gr[64 * j]; f32x4 y; y.x = v[j].x * rs * gg.x; y.y = v[j].y * rs * gg.y; y.z = v[j].z * rs * gg.z; y.w = v[j].w * rs * gg.w; ((f32x4*)h)[lane + 64 * j] = y; }
        }
    }
#undef IN
#undef BOTH
}

extern "C" void kernel_launch(void* const* d_in, const int* in_sizes, int n_in, void* d_out, int out_size, void* d_ws, size_t ws_size, hipStream_t stream) {
    if (n_in != 25 || out_size != T * D || ws_size < WS_END) { fprintf(stderr, "kernel_launch: unexpected shapes n_in %d out %d ws %zu\n", n_in, out_size, ws_size); return; }
    Ptrs p{};
    for (int i = 0; i < 25; ++i) p.in[i] = (const float*)d_in[i];
    p.out = (float*)d_out; p.ws = (unsigned char*)d_ws;
    (void)hipMemsetAsync((char*)d_ws + WS_CTL, 0, CTL_BYTES, stream);
    static int grid = 0;
    if (grid == 0) {
        int dev = 0, cus = 0;
        if (hipGetDevice(&dev) != hipSuccess || hipDeviceGetAttribute(&cus, hipDeviceAttributeMultiprocessorCount, dev) != hipSuccess) { grid = -1; return; }
        if (hipFuncSetAttribute((const void*)mk_fwd, hipFuncAttributeMaxDynamicSharedMemorySize, LDS_BYTES) != hipSuccess) { fprintf(stderr, "hipFuncSetAttribute failed\n"); grid = -1; return; }
        int per_cu = 0;
        if (hipOccupancyMaxActiveBlocksPerMultiprocessor(&per_cu, (const void*)mk_fwd, NWAVES * 64, LDS_BYTES) != hipSuccess || per_cu < 1) { fprintf(stderr, "occupancy query: %d\n", per_cu); }
        (void)hipGetLastError();
        grid = cus;
    }
    if (grid < 0) return;
#ifndef MK_PER_PHASE
    { MKArgs a{}; a.p = p; a.ph_lo = 0; a.ph_hi = 8; hipLaunchKernelGGL(mk_fwd, dim3(grid), dim3(NWAVES * 64), LDS_BYTES, stream, a); }
#else
    for (int ph = 0; ph < 8; ++ph) { MKArgs a{}; a.p = p; a.ph_lo = ph; a.ph_hi = ph + 1; hipLaunchKernelGGL(mk_fwd, dim3(grid), dim3(NWAVES * 64), LDS_BYTES, stream, a); }
#endif
}
```

```cpp
#include <hip/hip_runtime.h>
#include <cstdio>
#include <cstdint>

typedef unsigned short bf16;
typedef unsigned v4u __attribute__((ext_vector_type(4)));
typedef float f32x4 __attribute__((ext_vector_type(4)));

constexpr int NB = 16, S = 2048, T = NB * S, D = 1024;
constexpr int SBH = 8, HD = 64, SBW = 512, CVW = 256, MXH = 4, MXW = 256, INW = 2304, NMEM = 256, TM = NB * NMEM;
constexpr int NE = 32, TOPK = 4, DFF = 1024, CONVK = 31;
constexpr int PMAX = T * TOPK + NE * 256;
constexpr float EPS = 1e-6f;
constexpr float SB_EXIT = -60.0f;

constexpr size_t MiB = 1u << 20;
constexpr size_t WS_CTL = 0, CTL_BYTES = 1 * MiB;
constexpr size_t WS_WIN = 2 * MiB;
constexpr size_t WS_WOUT = 7 * MiB;
constexpr size_t WS_WMKV = 9 * MiB;
constexpr size_t WS_WPW2 = 10 * MiB;
constexpr size_t WS_WGU = 16 * MiB;
constexpr size_t WS_WDN = 144 * MiB;
constexpr size_t WS_MEMN = 208 * MiB;
constexpr size_t WS_MEMK = 216 * MiB;
constexpr size_t WS_MEMVT = 218 * MiB;
constexpr size_t WS_LIST = 220 * MiB;
constexpr size_t WS_TOKE = 224 * MiB;
constexpr size_t WS_TOKS = 224 * MiB + 512 * 1024;
constexpr size_t WS_TOKG = 225 * MiB;
constexpr size_t WS_HN = 226 * MiB;
constexpr size_t WS_XN = 290 * MiB;
constexpr size_t WS_Q = 354 * MiB;
constexpr size_t WS_K = 386 * MiB;
constexpr size_t WS_VT = 418 * MiB;
constexpr size_t WS_GLU = 450 * MiB;
constexpr size_t WS_QMX = 482 * MiB;
constexpr size_t WS_CAT = 498 * MiB;
constexpr size_t WS_HACT = 562 * MiB;
constexpr size_t WS_Y = 290 * MiB;
constexpr size_t WS_END = 834 * MiB;
constexpr size_t WS_OSB = 562 * MiB;
constexpr size_t WS_OCV = 626 * MiB;
constexpr size_t WS_OMX = 658 * MiB;
static_assert((size_t)PMAX * 1024 * 2 == 272 * MiB, "padded rows");
constexpr int CW_CNT = 64;

__device__ __forceinline__ float bf2f(unsigned v) { return __uint_as_float(v << 16); }
__device__ __forceinline__ unsigned f2bf(float f) { unsigned u = __float_as_uint(f); return (u + 0x7fffu + ((u >> 16) & 1u)) >> 16; }
__device__ __forceinline__ unsigned pk2(float lo, float hi) { return f2bf(lo) | (f2bf(hi) << 16); }
__device__ __forceinline__ float wave_sum(float v) {
#pragma unroll
    for (int o = 1; o < 64; o <<= 1) v += __shfl_xor(v, o);
    return v;
}
__device__ __forceinline__ float wave_max(float v) {
#pragma unroll
    for (int o = 1; o < 64; o <<= 1) v = fmaxf(v, __shfl_xor(v, o));
    return v;
}

__device__ __forceinline__ void transpose_item(const float* W, int K, int N, bf16* WT, int k0, int n0, int dstrow0, const float* kscale, float* scr, int lane) {
#pragma unroll 8
    for (int i = 0; i < 32; ++i) { const int kk = 2 * i + (lane >> 5); float v = W[(size_t)(k0 + kk) * N + n0 + (lane & 31)]; if (kscale) v *= kscale[k0 + kk]; scr[kk * 33 + (lane & 31)] = v; }
    asm volatile("s_waitcnt lgkmcnt(0)" ::: "memory");
    const int c = lane & 7;
#pragma unroll
    for (int j = 0; j < 4; ++j) { const int n = (lane >> 3) + 8 * j; const float* s = scr + (8 * c) * 33 + n;
        v4u o; o.x = pk2(s[0 * 33], s[1 * 33]); o.y = pk2(s[2 * 33], s[3 * 33]); o.z = pk2(s[4 * 33], s[5 * 33]); o.w = pk2(s[6 * 33], s[7 * 33]);
        *(v4u*)(WT + (size_t)(dstrow0 + n) * K + k0 + 8 * c) = o; }
    asm volatile("s_waitcnt lgkmcnt(0)" ::: "memory");
}
__device__ __forceinline__ void rms_row_to_bf16(const float* xrow, const float* g, bf16* orow, int lane) {
    const f32x4* xr = (const f32x4*)xrow + lane; const f32x4* gr = (const f32x4*)g + lane;
    f32x4 v[4]; float s = 0.f;
#pragma unroll
    for (int j = 0; j < 4; ++j) { v[j] = xr[64 * j]; s += (v[j].x * v[j].x + v[j].y * v[j].y) + (v[j].z * v[j].z + v[j].w * v[j].w); }
    const float rs = 1.0f / sqrtf(wave_sum(s) * (1.f / D) + EPS);
    unsigned long long* o8 = (unsigned long long*)orow + lane;
#pragma unroll
    for (int j = 0; j < 4; ++j) { const f32x4 gg = gr[64 * j]; o8[64 * j] = (unsigned long long)pk2(v[j].x * rs * gg.x, v[j].y * rs * gg.y) | ((unsigned long long)pk2(v[j].z * rs * gg.z, v[j].w * rs * gg.w) << 32); }
}

struct Ptrs {
    const float* in[25]; float* out; unsigned char* ws;
};

__global__ void __launch_bounds__(256) k_prologue(Ptrs p) {
    __shared__ float scr_all[4][64 * 33];
    const int lane = threadIdx.x & 63, wave = threadIdx.x >> 6;
    float* scr = scr_all[wave];
    const int gw = blockIdx.x * 4 + wave, NGW = gridDim.x * 4;
    unsigned char* ws = p.ws;
    constexpr int I_IN = 16 * 72, I_OUT = 16 * 32, I_MKV = 16 * 16, I_PW2 = 4 * 8, I_GU = 32 * 16 * 64, I_DN = 32 * 16 * 32;
    constexpr int NIT = I_IN + I_OUT + I_MKV + I_PW2 + I_GU + I_DN;
    for (int it = gw; it < NIT; it += NGW) {
        int r = it;
        if (r < I_IN) { const int kb = r / 72, nb = r % 72; transpose_item(p.in[3], 1024, INW, (bf16*)(ws + WS_WIN), 64 * kb, 32 * nb, 32 * nb, nullptr, scr, lane); continue; } r -= I_IN;
        if (r < I_OUT) { const int kb = r / 32, nb = r % 32; const int k0 = 64 * kb;
            const float* ks = k0 < 512 ? p.in[13] : (k0 < 768 ? p.in[14] - 512 : p.in[15] - 768);
            transpose_item(p.in[16], 1024, 1024, (bf16*)(ws + WS_WOUT), k0, 32 * nb, 32 * nb, ks, scr, lane); continue; } r -= I_OUT;
        if (r < I_MKV) { const int kb = r / 16, nb = r % 16; transpose_item(p.in[12], 1024, 512, (bf16*)(ws + WS_WMKV), 64 * kb, 32 * nb, 32 * nb, nullptr, scr, lane); continue; } r -= I_MKV;
        if (r < I_PW2) { const int kb = r / 8, nb = r % 8; transpose_item(p.in[9], 256, 256, (bf16*)(ws + WS_WPW2), 64 * kb, 32 * nb, 32 * nb, nullptr, scr, lane); continue; } r -= I_PW2;
        if (r < I_GU) { const int e = r / 1024, q = r % 1024, kb = q / 64, nb = q % 64; const int n0 = 32 * nb, isup = n0 >> 10, cc = n0 & 1023, j = cc >> 7, c = cc & 127;
            transpose_item(p.in[20] + (size_t)e * 1024 * 2048, 1024, 2048, (bf16*)(ws + WS_WGU) + (size_t)e * 2048 * 1024, 64 * kb, n0, 256 * j + 128 * isup + c, nullptr, scr, lane); continue; } r -= I_GU;
        { const int e = r / 512, q = r % 512, kb = q / 32, nb = q % 32;
            transpose_item(p.in[22] + (size_t)e * 1024 * 1024, 1024, 1024, (bf16*)(ws + WS_WDN) + (size_t)e * 1024 * 1024, 64 * kb, 32 * nb, 32 * nb, nullptr, scr, lane); }
    }
    for (int m = gw; m < T; m += NGW) rms_row_to_bf16(p.in[0] + (size_t)m * D, p.in[2], (bf16*)(ws + WS_XN) + (size_t)m * D, lane);
    for (int m = gw; m < TM; m += NGW) rms_row_to_bf16(p.in[1] + (size_t)m * D, p.in[11], (bf16*)(ws + WS_MEMN) + (size_t)m * D, lane);
}

enum { MODE_INPROJ = 0, MODE_MEMKV = 1, MODE_OUT = 2, MODE_GU = 3, MODE_DN = 4 };
__device__ __forceinline__ void moe_prefix(const unsigned* cnt, int e, int& count, int& pstart) {
    int ps = 0, c = 0;
    for (int i = 0; i < NE; ++i) { const int ci = (int)cnt[i]; if (i < e) ps += ((ci + 255) >> 8) << 8; if (i == e) c = ci; }
    count = c; pstart = ps;
}
template <int MODE>
__global__ void __launch_bounds__(256) k_naive_gemm(Ptrs p) {
    __shared__ float sA[32][65], sB[32][65];
    unsigned char* ws = p.ws;
    const int tid = threadIdx.x, ty = tid >> 4, tx = tid & 15;
    const int rt = blockIdx.x, ct = blockIdx.y, e = blockIdx.z;
    const bf16* A; const bf16* Bt; int K = 1024;
    int count = 0, pstart = 0;
    const int* list = nullptr;
    if (MODE == MODE_INPROJ) { A = (const bf16*)(ws + WS_XN); Bt = (const bf16*)(ws + WS_WIN); }
    else if (MODE == MODE_MEMKV) { A = (const bf16*)(ws + WS_MEMN); Bt = (const bf16*)(ws + WS_WMKV); }
    else if (MODE == MODE_OUT) { A = (const bf16*)(ws + WS_CAT); Bt = (const bf16*)(ws + WS_WOUT); }
    else {
        moe_prefix((const unsigned*)(ws + WS_CTL) + CW_CNT, e, count, pstart);
        if (rt * 64 >= count) return;
        list = (const int*)(ws + WS_LIST) + (size_t)e * T;
        if (MODE == MODE_GU) { A = (const bf16*)(ws + WS_HN); Bt = (const bf16*)(ws + WS_WGU) + (size_t)e * 2048 * 1024; }
        else { A = (const bf16*)(ws + WS_HACT) + (size_t)pstart * 1024; Bt = (const bf16*)(ws + WS_WDN) + (size_t)e * 1024 * 1024; }
    }
    const int lr = tid >> 2, kc = (tid & 3) * 8;
    size_t arow;
    { const int r = rt * 64 + lr; if (MODE == MODE_GU) { const int tok = (r < count) ? list[r] : 0; arow = (size_t)tok * K; } else arow = (size_t)r * K; }
    size_t brow;
    { int n; if (MODE == MODE_GU) { const int jb = ct >> 2, c0 = (ct & 3) * 32; n = 256 * jb + 128 * (lr >> 5) + c0 + (lr & 31); } else n = ct * 64 + lr; brow = (size_t)n * K; }
    float acc[4][4];
#pragma unroll
    for (int i = 0; i < 4; ++i)
#pragma unroll
        for (int j = 0; j < 4; ++j) acc[i][j] = 0.f;
    int cl[4];
#pragma unroll
    for (int j = 0; j < 4; ++j) cl[j] = (MODE == MODE_GU) ? (j < 2 ? 2 * tx + j : 32 + 2 * tx + (j - 2)) : 4 * tx + j;
    for (int k0 = 0; k0 < K; k0 += 32) {
        const v4u av = *(const v4u*)(A + arow + k0 + kc), bv = *(const v4u*)(Bt + brow + k0 + kc);
        __syncthreads();
#pragma unroll
        for (int j = 0; j < 4; ++j) { const unsigned a = av[j], b = bv[j];
            sA[kc + 2 * j][lr] = bf2f(a & 0xffffu); sA[kc + 2 * j + 1][lr] = bf2f(a >> 16);
            sB[kc + 2 * j][lr] = bf2f(b & 0xffffu); sB[kc + 2 * j + 1][lr] = bf2f(b >> 16); }
        __syncthreads();
#pragma unroll 8
        for (int k = 0; k < 32; ++k) {
            float a[4], b[4];
#pragma unroll
            for (int i = 0; i < 4; ++i) a[i] = sA[k][ty * 4 + i];
#pragma unroll
            for (int j = 0; j < 4; ++j) b[j] = sB[k][cl[j]];
#pragma unroll
            for (int i = 0; i < 4; ++i)
#pragma unroll
                for (int j = 0; j < 4; ++j) acc[i][j] += a[i] * b[j];
        }
    }
#pragma unroll
    for (int i = 0; i < 4; ++i) {
        const int r = rt * 64 + ty * 4 + i;
        if (MODE == MODE_INPROJ) {
#pragma unroll
            for (int j = 0; j < 4; ++j) { const int n = ct * 64 + 4 * tx + j; const float v = acc[i][j];
                if (n < 512) ((bf16*)(ws + WS_Q))[(size_t)r * 512 + n] = (bf16)f2bf(v * 0.125f);
                else if (n < 1024) ((bf16*)(ws + WS_K))[(size_t)r * 512 + n - 512] = (bf16)f2bf(v);
                else if (n < 1536) ((bf16*)(ws + WS_VT))[(size_t)(n - 1024) * T + r] = (bf16)f2bf(v);
                else if (n < 2048) ((bf16*)(ws + WS_GLU))[(size_t)r * 512 + n - 1536] = (bf16)f2bf(v + p.in[4][n - 1536]);
                else ((bf16*)(ws + WS_QMX))[(size_t)r * 256 + n - 2048] = (bf16)f2bf(v * 0.125f); }
        } else if (MODE == MODE_MEMKV) {
#pragma unroll
            for (int j = 0; j < 4; ++j) { const int n = ct * 64 + 4 * tx + j; const float v = acc[i][j];
                if (n < 256) ((bf16*)(ws + WS_MEMK))[(size_t)r * 256 + n] = (bf16)f2bf(v);
                else ((bf16*)(ws + WS_MEMVT))[(size_t)(n - 256) * TM + r] = (bf16)f2bf(v); }
        } else if (MODE == MODE_OUT) {
#pragma unroll
            for (int j = 0; j < 4; ++j) { const int n = ct * 64 + 4 * tx + j; p.out[(size_t)r * D + n] = p.in[0][(size_t)r * D + n] + acc[i][j]; }
        } else if (MODE == MODE_GU) {
            const int jb = ct >> 2, c0 = (ct & 3) * 32;
#pragma unroll
            for (int j = 0; j < 2; ++j) { const int hc = 128 * jb + c0 + 2 * tx + j;
                float g = acc[i][j] + p.in[21][(size_t)e * 2048 + hc], u = acc[i][j + 2] + p.in[21][(size_t)e * 2048 + 1024 + hc];
                g = fminf(g, 7.0f); u = fminf(fmaxf(u, -7.0f), 7.0f);
                const float h = (u + 1.0f) * (g / (1.0f + __expf(-1.702f * g)));
                ((bf16*)(ws + WS_HACT))[(size_t)(pstart + r) * 1024 + hc] = (bf16)f2bf(h); }
        } else {
#pragma unroll
            for (int j = 0; j < 4; ++j) { const int n = ct * 64 + 4 * tx + j;
                ((bf16*)(ws + WS_Y))[(size_t)(pstart + r) * 1024 + n] = (bf16)f2bf(acc[i][j] + p.in[23][(size_t)e * 1024 + n]); }
        }
    }
}

__global__ void __launch_bounds__(256) k_naive_sb(Ptrs p) {
    unsigned char* ws = p.ws;
    const int gid = blockIdx.x * 256 + threadIdx.x;
    const int t = gid % S, h = (gid / S) % SBH, b = gid / (S * SBH);
    const bf16* Q = (const bf16*)(ws + WS_Q); const bf16* Kp = (const bf16*)(ws + WS_K); const bf16* VT = (const bf16*)(ws + WS_VT);
    float q[64], o[64];
    { const v4u* qp = (const v4u*)(Q + (size_t)(b * S + t) * 512 + h * 64);
#pragma unroll
        for (int c = 0; c < 8; ++c) { const v4u v = qp[c];
#pragma unroll
            for (int j = 0; j < 4; ++j) { q[c * 8 + 2 * j] = bf2f(v[j] & 0xffffu); q[c * 8 + 2 * j + 1] = bf2f(v[j] >> 16); } } }
#pragma unroll
    for (int d = 0; d < 64; ++d) o[d] = 0.f;
    float carry = 0.f;
    for (int s = t - 1; s >= 0; --s) {
        const v4u* kp = (const v4u*)(Kp + (size_t)(b * S + s) * 512 + h * 64);
        float z = 0.f;
#pragma unroll
        for (int c = 0; c < 8; ++c) { const v4u v = kp[c];
#pragma unroll
            for (int j = 0; j < 4; ++j) { z += q[c * 8 + 2 * j] * bf2f(v[j] & 0xffffu); z += q[c * 8 + 2 * j + 1] * bf2f(v[j] >> 16); } }
        const float l = __logf(1.0f + __expf(-fabsf(z)));
        const float lb = -(fmaxf(-z, 0.f) + l), lnb = -(fmaxf(z, 0.f) + l);
        const float a = __expf(lb + carry);
        carry += lnb;
        const bf16* vp = VT + (size_t)(h * 64) * T + (size_t)b * S + s;
#pragma unroll
        for (int d = 0; d < 64; ++d) o[d] += a * bf2f(vp[(size_t)d * T]);
        if (carry < SB_EXIT) break;
    }
    float* O = (float*)(ws + WS_OSB) + (size_t)(b * S + t) * 512 + h * 64;
#pragma unroll
    for (int d = 0; d < 64; ++d) O[d] = o[d];
}

__global__ void __launch_bounds__(256) k_naive_conv(Ptrs p) {
    __shared__ float act_all[4][256];
    unsigned char* ws = p.ws;
    const int lane = threadIdx.x & 63, wave = threadIdx.x >> 6;
    float* act = act_all[wave];
    const int tok = blockIdx.x * 4 + wave, t = tok % S;
    const bf16* GLU = (const bf16*)(ws + WS_GLU);
    const float* w_dw = p.in[5]; const float* b_dw = p.in[6]; const float* g_ln = p.in[7]; const float* b_ln = p.in[8]; const float* w_pw2 = p.in[9]; const float* b_pw2 = p.in[10];
    float u[4];
#pragma unroll
    for (int i = 0; i < 4; ++i) u[i] = b_dw[lane + 64 * i];
    for (int j = 0; j < CONVK; ++j) {
        const int ts = t - (CONVK - 1) + j; if (ts < 0) continue;
        const bf16* row = GLU + (size_t)(tok - (CONVK - 1) + j) * 512;
#pragma unroll
        for (int i = 0; i < 4; ++i) { const int c = lane + 64 * i; const float a = bf2f(row[c]), g = bf2f(row[256 + c]);
            u[i] += w_dw[j * CVW + c] * (a / (1.0f + __expf(-g))); }
    }
    float s = u[0] + u[1] + u[2] + u[3]; const float mu = wave_sum(s) * (1.f / 256.f);
    float q = 0.f;
#pragma unroll
    for (int i = 0; i < 4; ++i) { const float d = u[i] - mu; q += d * d; }
    const float rstd = 1.0f / sqrtf(wave_sum(q) * (1.f / 256.f) + EPS);
#pragma unroll
    for (int i = 0; i < 4; ++i) { const int c = lane + 64 * i; float y = (u[i] - mu) * rstd * g_ln[c] + b_ln[c]; y = y / (1.0f + __expf(-y)); act[c] = y; }
    __syncthreads();
    float o[4];
#pragma unroll
    for (int i = 0; i < 4; ++i) o[i] = b_pw2[lane + 64 * i];
    for (int c = 0; c < 256; ++c) { const float a = act[c];
#pragma unroll
        for (int i = 0; i < 4; ++i) o[i] += a * w_pw2[c * 256 + lane + 64 * i]; }
    float* O = (float*)(ws + WS_OCV) + (size_t)tok * 256;
#pragma unroll
    for (int i = 0; i < 4; ++i) O[lane + 64 * i] = o[i];
}

__global__ void __launch_bounds__(256) k_naive_cross(Ptrs p) {
    __shared__ float pr_all[4][256];
    __shared__ float qs_all[4][64];
    unsigned char* ws = p.ws;
    const int lane = threadIdx.x & 63, h = threadIdx.x >> 6;
    float* pr = pr_all[h]; float* qs = qs_all[h];
    const int tok = blockIdx.x, b = tok / S;
    const bf16* QM = (const bf16*)(ws + WS_QMX); const bf16* MK = (const bf16*)(ws + WS_MEMK); const bf16* MVT = (const bf16*)(ws + WS_MEMVT);
    qs[lane] = bf2f(QM[(size_t)tok * 256 + h * 64 + lane]);
    __syncthreads();
    float sc[4]; float mx = -1e30f;
#pragma unroll
    for (int i = 0; i < 4; ++i) { const int m = lane + 64 * i; const bf16* kr = MK + (size_t)(b * NMEM + m) * 256 + h * 64; float z = 0.f;
        for (int d = 0; d < 64; ++d) z += qs[d] * bf2f(kr[d]);
        sc[i] = z; mx = fmaxf(mx, z); }
    mx = wave_max(mx);
    float sum = 0.f;
#pragma unroll
    for (int i = 0; i < 4; ++i) { sc[i] = __expf(sc[i] - mx); sum += sc[i]; }
    sum = wave_sum(sum);
#pragma unroll
    for (int i = 0; i < 4; ++i) pr[lane + 64 * i] = sc[i] / sum;
    __syncthreads();
    const bf16* vr = MVT + (size_t)(h * 64 + lane) * TM + (size_t)b * NMEM;
    float o = 0.f;
    for (int m = 0; m < NMEM; ++m) o += pr[m] * bf2f(vr[m]);
    ((float*)(ws + WS_OMX))[(size_t)tok * 256 + h * 64 + lane] = o;
}

__global__ void __launch_bounds__(256) k_groupnorm(Ptrs p, size_t src_off, int W, int coloff) {
    unsigned char* ws = p.ws;
    const int lane = threadIdx.x & 63, tok = blockIdx.x * 4 + (threadIdx.x >> 6);
    const float* src = (const float*)(ws + src_off) + (size_t)tok * W;
    float v[8]; float s = 0.f; const int n = W / 64;
#pragma unroll
    for (int i = 0; i < 8; ++i) if (i < n) { v[i] = src[lane + 64 * i]; s += v[i] * v[i]; }
    const float rs = 1.0f / sqrtf(wave_sum(s) / (float)W + EPS);
    bf16* o = (bf16*)(ws + WS_CAT) + (size_t)tok * D + coloff;
#pragma unroll
    for (int i = 0; i < 8; ++i) if (i < n) o[lane + 64 * i] = (bf16)f2bf(v[i] * rs);
}

__global__ void __launch_bounds__(256) k_router(Ptrs p) {
    __shared__ float hrow_all[4][1024];
    unsigned char* ws = p.ws;
    const int lane = threadIdx.x & 63, wave = threadIdx.x >> 6, tok = blockIdx.x * 4 + wave;
    float* hrow = hrow_all[wave];
    const float* h = p.out + (size_t)tok * D; const float* g = p.in[17];
    const f32x4* xr = (const f32x4*)h + lane; const f32x4* gr = (const f32x4*)g + lane;
    f32x4 v[4]; float s = 0.f;
#pragma unroll
    for (int j = 0; j < 4; ++j) { v[j] = xr[64 * j]; s += (v[j].x * v[j].x + v[j].y * v[j].y) + (v[j].z * v[j].z + v[j].w * v[j].w); }
    const float rs = 1.0f / sqrtf(wave_sum(s) * (1.f / D) + EPS);
    unsigned long long* o8 = (unsigned long long*)((bf16*)(ws + WS_HN) + (size_t)tok * D) + lane;
#pragma unroll
    for (int j = 0; j < 4; ++j) { const f32x4 gg = gr[64 * j]; f32x4 y; y.x = v[j].x * rs * gg.x; y.y = v[j].y * rs * gg.y; y.z = v[j].z * rs * gg.z; y.w = v[j].w * rs * gg.w;
        o8[64 * j] = (unsigned long long)pk2(y.x, y.y) | ((unsigned long long)pk2(y.z, y.w) << 32);
        *(f32x4*)(hrow + 4 * lane + 256 * j) = y; }
    __syncthreads();
    const int e = lane & 31, hf = lane >> 5; const float* wr = p.in[18];
    float acc = 0.f;
    for (int k = hf * 512; k < hf * 512 + 512; ++k) acc += hrow[k] * wr[k * NE + e];
    acc += __shfl_xor(acc, 32);
    float logit = acc + p.in[19][e];
    int my_e = 0; float my_v = 0.f, m0 = 0.f;
#pragma unroll
    for (int k = 0; k < 4; ++k) {
        const float m = wave_max(logit);
        const unsigned long long bal = __ballot(logit == m);
        const int idx = (int)(__ffsll((long long)bal) - 1) & 31;
        if (lane == k) { my_e = idx; my_v = m; }
        if (k == 0) m0 = m;
        if (e == idx) logit = -3.0e38f;
    }
    const float exv = (lane < 4) ? __expf(my_v - m0) : 0.f;
    const float es = __shfl(exv, 0) + __shfl(exv, 1) + __shfl(exv, 2) + __shfl(exv, 3);
    if (lane < 4) {
        const int ee = my_e; const float gv = exv;
        const unsigned slot = atomicAdd((unsigned*)(ws + WS_CTL) + CW_CNT + ee, 1u);
        ((int*)(ws + WS_LIST))[(size_t)ee * T + slot] = tok;
        ((int*)(ws + WS_TOKE))[tok * 4 + lane] = ee;
        ((int*)(ws + WS_TOKS))[tok * 4 + lane] = (int)slot;
        ((float*)(ws + WS_TOKG))[tok * 4 + lane] = gv / es;
    }
}

__global__ void __launch_bounds__(256) k_final(Ptrs p) {
    unsigned char* ws = p.ws;
    const int lane = threadIdx.x & 63, tok = blockIdx.x * 4 + (threadIdx.x >> 6);
    const unsigned* cnt = (const unsigned*)(ws + WS_CTL) + CW_CNT;
    float* h = p.out + (size_t)tok * D;
    f32x4 v[4];
#pragma unroll
    for (int j = 0; j < 4; ++j) v[j] = ((const f32x4*)h)[lane + 64 * j];
    for (int k = 0; k < 4; ++k) {
        const int e = ((const int*)(ws + WS_TOKE))[tok * 4 + k], slot = ((const int*)(ws + WS_TOKS))[tok * 4 + k]; const float gt = ((const float*)(ws + WS_TOKG))[tok * 4 + k];
        int c, ps; moe_prefix(cnt, e, c, ps);
        const unsigned long long* y8 = (const unsigned long long*)((const bf16*)(ws + WS_Y) + (size_t)(ps + slot) * 1024) + lane;
#pragma unroll
        for (int j = 0; j < 4; ++j) { const unsigned long long w = y8[64 * j]; const unsigned lo = (unsigned)w, hi = (unsigned)(w >> 32);
            v[j].x += gt * bf2f(lo & 0xffffu); v[j].y += gt * bf2f(lo >> 16); v[j].z += gt * bf2f(hi & 0xffffu); v[j].w += gt * bf2f(hi >> 16); }
    }
    float s = 0.f;
#pragma unroll
    for (int j = 0; j < 4; ++j) s += (v[j].x * v[j].x + v[j].y * v[j].y) + (v[j].z * v[j].z + v[j].w * v[j].w);
    const float rs = 1.0f / sqrtf(wave_sum(s) * (1.f / D) + EPS);
    const f32x4* gr = (const f32x4*)p.in[24] + lane;
#pragma unroll
    for (int j = 0; j < 4; ++j) { const f32x4 gg = gr[64 * j]; f32x4 y; y.x = v[j].x * rs * gg.x; y.y = v[j].y * rs * gg.y; y.z = v[j].z * rs * gg.z; y.w = v[j].w * rs * gg.w; ((f32x4*)h)[lane + 64 * j] = y; }
}


#define LAS __attribute__((address_space(3)))
typedef short bf16x8 __attribute__((ext_vector_type(8)));
typedef unsigned u32x4 __attribute__((ext_vector_type(4)));
namespace pg {
constexpr int BM = 256, BK = 64, HALF = 128, HTB = HALF * BK * 2, STAGE_BYTES = 8 * HTB, GK = 1024;
__host__ __device__ __forceinline__ int lds_byte(int r, int c) { const int st = (r >> 4) * 2 + (c >> 5), rr = r & 15, cc = c & 31, ob = rr * 64 + cc * 2; return st * 1024 + (ob ^ (((ob >> 9) & 1) << 5)); }
__host__ __device__ __forceinline__ void stage_rc(int b, int& R, int& C) { const int st = b / 1024, sb = b % 1024, swz = sb ^ (((sb >> 9) & 1) << 5); R = (st >> 1) * 16 + swz / 64; C = (st & 1) * 32 + (swz % 64) / 2; }
__host__ __device__ __forceinline__ int perm32(int rho) { const int n = rho >> 4, i = rho & 15; return 8 * (i >> 2) + 4 * n + (i & 3); }
__device__ __forceinline__ unsigned cvt_pk_bf16(float lo, float hi) { unsigned r; asm volatile("v_cvt_pk_bf16_f32 %0, %1, %2" : "=v"(r) : "v"(lo), "v"(hi)); return r; }

struct GU {
    const char* A;
    const char* B;
    char* O;
    const float* bias;
    int ldc; float scale; int gslot; int pad;
};

struct EpiBf16 {
    static constexpr bool PERM = true;
    __device__ __forceinline__ void operator()(const f32x4 (&acc)[2][2][4][2], const GU& u, int wr, int wc, int fr, int fq) const {
        bf16* base = (bf16*)u.O + (size_t)(wr * 64 + fr) * u.ldc + wc * 32 + 8 * fq; const float sc = u.scale;
        f32x4 bv[2][2];
#pragma unroll
        for (int bj = 0; bj < 2; ++bj)
#pragma unroll
            for (int n = 0; n < 2; ++n) bv[bj][n] = u.bias ? *(const f32x4*)(u.bias + bj * HALF + wc * 32 + 8 * fq + 4 * n) : (f32x4){0.f, 0.f, 0.f, 0.f};
#pragma unroll
        for (int ai = 0; ai < 2; ++ai)
#pragma unroll
            for (int m = 0; m < 4; ++m) { bf16* rowp = base + (size_t)(ai * HALF + m * 16) * u.ldc;
#pragma unroll
                for (int bj = 0; bj < 2; ++bj) { const f32x4 v0 = (acc[ai][bj][m][0] + bv[bj][0]) * sc, v1 = (acc[ai][bj][m][1] + bv[bj][1]) * sc;
                    u32x4 w; w.x = cvt_pk_bf16(v0[0], v0[1]); w.y = cvt_pk_bf16(v0[2], v0[3]); w.z = cvt_pk_bf16(v1[0], v1[1]); w.w = cvt_pk_bf16(v1[2], v1[3]);
                    *(u32x4*)(rowp + bj * HALF) = w; } }
    }
};
struct EpiResid {
    static constexpr bool PERM = false;
    __device__ __forceinline__ void operator()(const f32x4 (&acc)[2][2][4][2], const GU& u, int wr, int wc, int fr, int fq) const {
        const size_t o0 = (size_t)(wr * 64 + fr) * u.ldc + wc * 32 + 4 * fq;
#pragma unroll
        for (int ai = 0; ai < 2; ++ai)
#pragma unroll
            for (int m = 0; m < 4; ++m) { const size_t o = o0 + (size_t)(ai * HALF + m * 16) * u.ldc;
#pragma unroll
                for (int bj = 0; bj < 2; ++bj)
#pragma unroll
                    for (int n = 0; n < 2; ++n) *(f32x4*)((float*)u.O + o + bj * HALF + n * 16) = *(const f32x4*)(u.bias + o + bj * HALF + n * 16) + acc[ai][bj][m][n]; }
    }
};
struct EpiSwiGLU {
    static constexpr bool PERM = true;
    __device__ __forceinline__ void operator()(const f32x4 (&acc)[2][2][4][2], const GU& u, int wr, int wc, int fr, int fq) const {
        bf16* base = (bf16*)u.O + (size_t)(wr * 64 + fr) * u.ldc + wc * 32 + 8 * fq;
        f32x4 bg[2], bu[2];
#pragma unroll
        for (int n = 0; n < 2; ++n) { bg[n] = *(const f32x4*)(u.bias + wc * 32 + 8 * fq + 4 * n); bu[n] = *(const f32x4*)(u.bias + 1024 + wc * 32 + 8 * fq + 4 * n); }
#pragma unroll
        for (int ai = 0; ai < 2; ++ai)
#pragma unroll
            for (int m = 0; m < 4; ++m) { bf16* rowp = base + (size_t)(ai * HALF + m * 16) * u.ldc; float h[8];
#pragma unroll
                for (int n = 0; n < 2; ++n)
#pragma unroll
                    for (int j = 0; j < 4; ++j) { float g = acc[ai][0][m][n][j] + bg[n][j], up = acc[ai][1][m][n][j] + bu[n][j];
                        g = fminf(g, 7.0f); up = fminf(fmaxf(up, -7.0f), 7.0f);
                        h[4 * n + j] = (up + 1.0f) * (g * __builtin_amdgcn_rcpf(1.0f + __builtin_amdgcn_exp2f(-1.702f * 1.44269504f * g))); }
                u32x4 w; w.x = cvt_pk_bf16(h[0], h[1]); w.y = cvt_pk_bf16(h[2], h[3]); w.z = cvt_pk_bf16(h[4], h[5]); w.w = cvt_pk_bf16(h[6], h[7]);
                *(u32x4*)rowp = w; }
    }
};

template <class Epi, class Sched, bool GATHER>
__device__ __forceinline__ void gemm_phase(LAS unsigned char* lds, const Sched& S, const Epi& E, const LAS unsigned* gtab) {
    const int tid = threadIdx.x, wid = __builtin_amdgcn_readfirstlane(tid >> 6), lane = tid & 63, wr = wid >> 2, wc = wid & 3, fr = lane & 15, fq = lane >> 4;
    constexpr int K = GK, nt = K / BK;
    unsigned voffB[2]; int Rr[2], Cc2[2];
#pragma unroll
    for (int i = 0; i < 2; ++i) { int R, C; stage_rc(tid * 16 + i * 8192, R, C); const int Rb = Epi::PERM ? ((R & ~31) + perm32(R & 31)) : R;
        voffB[i] = (unsigned)(Rb * K + C) * 2u; Rr[i] = R; Cc2[i] = C * 2; }
    constexpr size_t kstep = (size_t)(BK * 2);
    constexpr size_t hstep = (size_t)HALF * K * 2;
    const unsigned ldsw = (unsigned)wid * 1024u;
    const int aoff = lds_byte(wr * 64 + fr, fq * 8), boff = lds_byte(wc * 32 + fr, fq * 8);
#define PG_SA(b, h) (((b) * 2 + (h)) * HTB)
#define PG_SB(b, h) ((4 + (b) * 2 + (h)) * HTB)
#define PG_STAGE(bufoff, gbase, voff) do { _Pragma("unroll") for (int _i = 0; _i < 2; ++_i) \
        __builtin_amdgcn_global_load_lds((const unsigned*)((const char*)(gbase) + (voff)[_i]), (LAS unsigned*)(lds + (bufoff) + ldsw + _i * 8192), 16, 0, 0); } while (0)
#define PG_LDA(dst, b, h) do { _Pragma("unroll") for (int m = 0; m < 4; ++m) _Pragma("unroll") for (int k = 0; k < 2; ++k) dst[m][k] = *(const LAS bf16x8*)(lds + PG_SA(b, h) + aoff + m * 2048 + k * 1024); } while (0)
#define PG_LDB(dst, b, h) do { _Pragma("unroll") for (int n = 0; n < 2; ++n) _Pragma("unroll") for (int k = 0; k < 2; ++k) dst[n][k] = *(const LAS bf16x8*)(lds + PG_SB(b, h) + boff + n * 2048 + k * 1024); } while (0)
#define PG_MMA(ai, bj, At, Bt) do { __builtin_amdgcn_s_setprio(1); _Pragma("unroll") for (int m = 0; m < 4; ++m) _Pragma("unroll") for (int n = 0; n < 2; ++n) _Pragma("unroll") for (int k = 0; k < 2; ++k) \
        acc[ai][bj][m][n] = __builtin_amdgcn_mfma_f32_16x16x32_bf16(Bt[n][k], At[m][k], acc[ai][bj][m][n], 0, 0, 0); __builtin_amdgcn_s_setprio(0); } while (0)
#define PG_WAIT_V(n) asm volatile("s_waitcnt vmcnt(" #n ")" ::: "memory")
#define PG_WAIT_L(n) asm volatile("s_waitcnt lgkmcnt(" #n ")" ::: "memory")
#define PG_BAR __builtin_amdgcn_s_barrier()
#define PG_SCHED __builtin_amdgcn_sched_barrier(0)
#define PG_LOADVO(vo, u) do { _Pragma("unroll") for (int _h = 0; _h < 2; ++_h) _Pragma("unroll") for (int _i = 0; _i < 2; ++_i) \
        vo[_h][_i] = GATHER ? (gtab[(u).gslot * 256 + _h * HALF + Rr[_i]] + (unsigned)Cc2[_i]) : (unsigned)((_h * HALF + Rr[_i]) * K * 2 + Cc2[_i]); } while (0)
    GU cur, nxt; int ui = 0;
    if (!S.next(0, cur)) return;
    f32x4 acc[2][2][4][2];
#pragma unroll
    for (int a = 0; a < 2; ++a)
#pragma unroll
        for (int b = 0; b < 2; ++b)
#pragma unroll
            for (int m = 0; m < 4; ++m)
#pragma unroll
                for (int n = 0; n < 2; ++n) acc[a][b][m][n] = (f32x4){0.f, 0.f, 0.f, 0.f};
    bf16x8 At[4][2], B0[2][2], B1[2][2];
    unsigned cvo[2][2], nvo[2][2];
    PG_LOADVO(cvo, cur);
    const char* cA = cur.A; const char* cB = cur.B;
    PG_STAGE(PG_SB(0, 0), cB, voffB); PG_STAGE(PG_SB(0, 1), cB + hstep, voffB); PG_STAGE(PG_SA(0, 0), cA, cvo[0]); PG_STAGE(PG_SA(0, 1), cA, cvo[1]);
    if (wr == 1) PG_BAR;
    PG_WAIT_V(2); PG_BAR;
    PG_STAGE(PG_SB(1, 0), cB + kstep, voffB); PG_STAGE(PG_SA(1, 0), cA + kstep, cvo[0]); PG_STAGE(PG_SB(1, 1), cB + hstep + kstep, voffB);
    PG_WAIT_V(6); PG_BAR;
    for (;;) {
        const bool has_next = S.next(ui + 1, nxt);
        const char* nA = has_next ? nxt.A : cA; const char* nB = has_next ? nxt.B : cB;
        if (GATHER) { if (has_next) { PG_LOADVO(nvo, nxt); } else {
#pragma unroll
            for (int h = 0; h < 2; ++h)
#pragma unroll
                for (int i = 0; i < 2; ++i) nvo[h][i] = cvo[h][i]; } }
        for (int t = 0; t < nt; t += 2) {
            const bool last = (t == nt - 2);
            const char* a1 = cA + (size_t)(t + 1) * kstep;
            const char* a2 = last ? nA : cA + (size_t)(t + 2) * kstep; const char* b2 = last ? nB : cB + (size_t)(t + 2) * kstep;
            const char* a3 = a2 + kstep; const char* b3 = b2 + kstep;
            unsigned vo2[2][2];
#pragma unroll
            for (int h = 0; h < 2; ++h)
#pragma unroll
                for (int i = 0; i < 2; ++i) vo2[h][i] = (GATHER && last) ? nvo[h][i] : cvo[h][i];
            PG_LDB(B0, 0, 0); PG_LDB(B1, 0, 1); PG_SCHED; PG_LDA(At, 0, 0); PG_STAGE(PG_SA(1, 1), a1, cvo[1]);
            PG_WAIT_V(8); PG_WAIT_L(0); PG_BAR; PG_MMA(0, 0, At, B0); PG_MMA(0, 1, At, B1); PG_BAR; PG_SCHED;
            PG_LDA(At, 0, 1); PG_STAGE(PG_SB(0, 0), b2, voffB); PG_STAGE(PG_SB(0, 1), b2 + hstep, voffB); PG_STAGE(PG_SA(0, 0), a2, vo2[0]);
            PG_WAIT_V(8); PG_WAIT_L(0); PG_BAR; PG_MMA(1, 0, At, B0); PG_MMA(1, 1, At, B1); PG_BAR; PG_SCHED;
            PG_LDB(B0, 1, 0); PG_LDB(B1, 1, 1); PG_SCHED; PG_LDA(At, 1, 0); PG_STAGE(PG_SA(0, 1), a2, vo2[1]);
            PG_WAIT_V(8); PG_WAIT_L(0); PG_BAR; PG_MMA(0, 0, At, B0); PG_MMA(0, 1, At, B1); PG_BAR; PG_SCHED;
            PG_LDA(At, 1, 1); PG_STAGE(PG_SB(1, 0), b3, voffB); PG_STAGE(PG_SB(1, 1), b3 + hstep, voffB); PG_STAGE(PG_SA(1, 0), a3, vo2[0]);
            PG_WAIT_V(8); PG_WAIT_L(0); PG_BAR; PG_MMA(1, 0, At, B0); PG_MMA(1, 1, At, B1); PG_BAR; PG_SCHED;
        }
        if (wr == 0) PG_BAR;
        E(acc, cur, wr, wc, fr, fq);
        if (!has_next) break;
#pragma unroll
        for (int a = 0; a < 2; ++a)
#pragma unroll
            for (int b = 0; b < 2; ++b)
#pragma unroll
                for (int m = 0; m < 4; ++m)
#pragma unroll
                    for (int n = 0; n < 2; ++n) acc[a][b][m][n] = (f32x4){0.f, 0.f, 0.f, 0.f};
        cur = nxt; cA = nA; cB = nB; ++ui;
        if (GATHER) {
#pragma unroll
            for (int h = 0; h < 2; ++h)
#pragma unroll
                for (int i = 0; i < 2; ++i) cvo[h][i] = nvo[h][i]; }
        if (wr == 1) PG_BAR;
    }
    PG_WAIT_V(0);
    PG_BAR;
#undef PG_SA
#undef PG_SB
#undef PG_STAGE
#undef PG_LDA
#undef PG_LDB
#undef PG_MMA
#undef PG_WAIT_V
#undef PG_WAIT_L
#undef PG_BAR
#undef PG_SCHED
#undef PG_LOADVO
}
}

constexpr int NWAVES = 8;
constexpr int RING_OFF = 0, RING_BYTES = 131072;
constexpr int GTAB_OFF = RING_BYTES, GTAB_BYTES = 18 * 1024;
constexpr int UTAB_OFF = GTAB_OFF + GTAB_BYTES, UTAB_BYTES = 1024;
constexpr int MISC_OFF = UTAB_OFF + UTAB_BYTES;
constexpr int LDS_BYTES = MISC_OFF + 512;
static_assert(LDS_BYTES <= 160 * 1024, "LDS");

#ifndef REP_PHASE
#define REP_PHASE -1
#endif
#define NREP(k) ((REP_PHASE) == (k) ? 2 : 1)
struct MKArgs { Ptrs p; int ph_lo, ph_hi; };

#define XB_TMO      128
#define XB_XCNT(j)  (256  + 64 * (j))
#define XB_XSUB(j)  (1280 + 64 * (j))
#define XB_XGEN(j)  (2304 + 64 * (j))
#define XB_TOP      3328
#define XB_TOPGEN   3392
#define XCD_BAR_WORDS 3456
#define XB_SPIN_CAP (1u << 18)
__device__ __forceinline__ unsigned xb_ld(unsigned* p)              { return __hip_atomic_load(p, __ATOMIC_RELAXED, __HIP_MEMORY_SCOPE_AGENT); }
__device__ __forceinline__ unsigned xb_add(unsigned* p, unsigned v) { return __hip_atomic_fetch_add(p, v, __ATOMIC_RELAXED, __HIP_MEMORY_SCOPE_AGENT); }
__device__ __forceinline__ unsigned xb_xcc_id() { return (unsigned)__builtin_amdgcn_s_getreg((3 << 11) | 20) & 0xFu; }
#define XB_SPIN(cond, bar) do { unsigned _sp = 0; while (cond) { __builtin_amdgcn_s_sleep(1); \
    if ((++_sp & 255u) == 0u) { if (xb_ld(&(bar)[XB_TMO])) break; if (_sp > XB_SPIN_CAP) { atomicAdd(&(bar)[XB_TMO], 1u); break; } } } } while (0)
struct XcdBarrier { unsigned* bar; unsigned x; volatile LAS unsigned* st; };
__device__ __forceinline__ XcdBarrier xcd_barrier_post(unsigned* bar, volatile LAS unsigned* st) {
    XcdBarrier b; b.bar = bar; b.x = xb_xcc_id(); b.st = st;
    if (threadIdx.x == 0) (void)xb_add(&bar[XB_XCNT(b.x)], 1u);
    return b;
}
__device__ __forceinline__ void xcd_barrier_complete(unsigned* bar, unsigned x, unsigned& nloc, unsigned& nx) {
    const unsigned G = gridDim.x * gridDim.y * gridDim.z;
    unsigned sum, cnt, mine, sp = 0u;
    for (;;) {
        sum = 0u; cnt = 0u; mine = 0u;
#pragma unroll
        for (unsigned j = 0; j < 16; ++j) { const unsigned c = xb_ld(&bar[XB_XCNT(j)]); sum += c; cnt += (c > 0u) ? 1u : 0u; mine = (j == x) ? c : mine; }
        if (sum == G) break;
        __builtin_amdgcn_s_sleep(1);
        if ((++sp & 255u) == 0u) { if (xb_ld(&bar[XB_TMO])) break; if (sp > XB_SPIN_CAP) { atomicAdd(&bar[XB_TMO], 1u); break; } }
    }
    nloc = mine > 0u ? mine : 1u; nx = cnt > 0u ? cnt : 1u;
}
__device__ __forceinline__ void xcd_barrier(const XcdBarrier& b) {
    asm volatile("s_waitcnt vmcnt(0)" ::: "memory");
    __syncthreads();
    if (threadIdx.x == 0) {
        unsigned* bar = b.bar;
        __builtin_amdgcn_s_waitcnt(0);
        unsigned nloc = b.st[0], nx = b.st[1];
        if (nloc == 0u) { xcd_barrier_complete(bar, b.x, nloc, nx); b.st[0] = nloc; b.st[1] = nx; }
        const unsigned old = xb_add(&bar[XB_XSUB(b.x)], 1u);
        const unsigned gen = old / nloc;
        if (old + 1u == (gen + 1u) * nloc) {
            __builtin_amdgcn_fence(__ATOMIC_RELEASE, "agent");
            asm volatile("s_waitcnt vmcnt(0)" ::: "memory");
            const unsigned og = xb_add(&bar[XB_TOP], 1u);
            const unsigned tg = og / nx;
            if (og + 1u == (tg + 1u) * nx) xb_add(&bar[XB_TOPGEN], 1u);
            else XB_SPIN(xb_ld(&bar[XB_TOPGEN]) == tg, bar);
            __builtin_amdgcn_fence(__ATOMIC_ACQUIRE, "agent");
            xb_add(&bar[XB_XGEN(b.x)], 1u);
            asm volatile("s_waitcnt vmcnt(0)" ::: "memory");
        } else {
            XB_SPIN(xb_ld(&bar[XB_XGEN(b.x)]) == gen, bar);
            __builtin_amdgcn_fence(__ATOMIC_ACQUIRE, "agent");
            asm volatile("s_waitcnt vmcnt(0)" ::: "memory");
        }
    }
    __syncthreads();
}
constexpr int CW_BAR = 4096;

struct SchedP1 {
    int G, c; unsigned char* ws; const float* b_glu;
    static constexpr int N_A = 128 * 7, N_B = 256, N_C = 32, NU = N_A + N_B + N_C;
    __device__ __forceinline__ bool next(int i, pg::GU& u) const {
        const int L = i * G + c; if (L >= NU) return false;
        u.bias = nullptr; u.scale = 1.0f; u.gslot = 0; u.pad = 0;
        if (L < N_A) { const int pm = L / 7, pn = L % 7;
            u.A = (const char*)(ws + WS_XN) + (size_t)pm * 256 * 2048;
            const int brow = pn < 4 ? 256 * pn : 256 * (pn + 2); u.B = (const char*)(ws + WS_WIN) + (size_t)brow * 2048;
            if (pn < 2) { u.O = (char*)(ws + WS_Q) + ((size_t)pm * 256 * 512 + pn * 256) * 2; u.ldc = 512; u.scale = 0.125f; }
            else if (pn < 4) { u.O = (char*)(ws + WS_K) + ((size_t)pm * 256 * 512 + (pn - 2) * 256) * 2; u.ldc = 512; }
            else if (pn < 6) { u.O = (char*)(ws + WS_GLU) + ((size_t)pm * 256 * 512 + (pn - 4) * 256) * 2; u.ldc = 512; u.bias = b_glu + (pn - 4) * 256; }
            else { u.O = (char*)(ws + WS_QMX) + ((size_t)pm * 256 * 256) * 2; u.ldc = 256; u.scale = 0.125f; }
        } else if (L < N_A + N_B) { const int q = L - N_A, pn = q >> 1, pm = q & 1;
            u.A = (const char*)(ws + WS_WIN) + (size_t)(1024 + 256 * pm) * 2048; u.B = (const char*)(ws + WS_XN) + (size_t)pn * 256 * 2048;
            u.O = (char*)(ws + WS_VT) + ((size_t)(256 * pm) * T + 256 * pn) * 2; u.ldc = T;
        } else { int q = L - N_A - N_B;
            if (q < 16) { u.A = (const char*)(ws + WS_MEMN) + (size_t)q * 256 * 2048; u.B = (const char*)(ws + WS_WMKV); u.O = (char*)(ws + WS_MEMK) + (size_t)q * 256 * 256 * 2; u.ldc = 256; }
            else { q -= 16; u.A = (const char*)(ws + WS_WMKV) + (size_t)256 * 2048; u.B = (const char*)(ws + WS_MEMN) + (size_t)q * 256 * 2048; u.O = (char*)(ws + WS_MEMVT) + (size_t)q * 256 * 2; u.ldc = TM; }
        }
        return true;
    }
};

struct SchedP3 {
    int G, c; unsigned char* ws; const float* x; float* out;
    __device__ __forceinline__ bool next(int i, pg::GU& u) const {
        const int L = i * G + c; if (L >= 512) return false;
        const int pm = L >> 2, pn = L & 3;
        u.A = (const char*)(ws + WS_CAT) + (size_t)pm * 256 * 2048; u.B = (const char*)(ws + WS_WOUT) + (size_t)pn * 256 * 2048;
        const size_t o = (size_t)pm * 256 * 1024 + pn * 256; u.O = (char*)(out + o); u.bias = x + o; u.ldc = 1024; u.scale = 1.0f; u.gslot = 0; u.pad = 0;
        return true;
    }
};
constexpr int UT_CNT = 0, UT_PST = 32, UT_UST = 64, UT_TOT = 96, UT_UNIT = 128, MAXU = 18;
template <int NPN>
__device__ __forceinline__ void moe_tables(LAS int* ut, const unsigned* cnt, int G, int vcu, int tid) {
    if (tid < 64) {
        const int c = tid < 32 ? (int)cnt[tid] : 0; const int np = (c + 255) >> 8;
        int incl = np;
#pragma unroll
        for (int o = 1; o < 32; o <<= 1) { const int v = __shfl_up(incl, o); if ((tid & 63) >= o) incl += v; }
        const int excl = incl - np;
        if (tid < 32) { ut[UT_CNT + tid] = c; ut[UT_PST + tid] = excl * 256; ut[UT_UST + tid] = excl * NPN; }
        if (tid == 31) ut[UT_TOT] = incl * NPN;
    }
    __syncthreads();
    if (tid < MAXU) {
        const int L = tid * G + vcu, U = ut[UT_TOT];
        int e = -1;
        if (L < U) { e = 0; for (int j = 1; j < 32; ++j) if (ut[UT_UST + j] <= L) e = j; }
        const int q = e >= 0 ? L - ut[UT_UST + e] : 0;
        ut[UT_UNIT + 4 * tid + 0] = e; ut[UT_UNIT + 4 * tid + 1] = q / NPN; ut[UT_UNIT + 4 * tid + 2] = q % NPN; ut[UT_UNIT + 4 * tid + 3] = e >= 0 ? ut[UT_PST + e] : 0;
    }
    __syncthreads();
}
struct SchedGU {
    const LAS int* ut; unsigned char* ws; const float* b_gu;
    __device__ __forceinline__ bool next(int i, pg::GU& u) const {
        if (i >= MAXU) return false;
        const int e = __builtin_amdgcn_readfirstlane(ut[UT_UNIT + 4 * i]); if (e < 0) return false;
        const int panel = __builtin_amdgcn_readfirstlane(ut[UT_UNIT + 4 * i + 1]), pn = __builtin_amdgcn_readfirstlane(ut[UT_UNIT + 4 * i + 2]), pst = __builtin_amdgcn_readfirstlane(ut[UT_UNIT + 4 * i + 3]);
        u.A = (const char*)(ws + WS_HN); u.B = (const char*)(ws + WS_WGU) + ((size_t)e * 2048 + pn * 256) * 2048;
        u.O = (char*)(ws + WS_HACT) + ((size_t)(pst + panel * 256) * 1024 + pn * 128) * 2; u.bias = b_gu + (size_t)e * 2048 + pn * 128; u.ldc = 1024; u.scale = 1.0f; u.gslot = i; u.pad = 0;
        return true;
    }
};
struct SchedDN {
    const LAS int* ut; unsigned char* ws; const float* b_dn;
    __device__ __forceinline__ bool next(int i, pg::GU& u) const {
        if (i >= MAXU) return false;
        const int e = __builtin_amdgcn_readfirstlane(ut[UT_UNIT + 4 * i]); if (e < 0) return false;
        const int panel = __builtin_amdgcn_readfirstlane(ut[UT_UNIT + 4 * i + 1]), pn = __builtin_amdgcn_readfirstlane(ut[UT_UNIT + 4 * i + 2]), pst = __builtin_amdgcn_readfirstlane(ut[UT_UNIT + 4 * i + 3]);
        u.A = (const char*)(ws + WS_HACT) + (size_t)(pst + panel * 256) * 2048; u.B = (const char*)(ws + WS_WDN) + ((size_t)e * 1024 + pn * 256) * 2048;
        u.O = (char*)(ws + WS_Y) + ((size_t)(pst + panel * 256) * 1024 + pn * 256) * 2; u.bias = b_dn + (size_t)e * 1024 + pn * 256; u.ldc = 1024; u.scale = 1.0f; u.gslot = 0; u.pad = 0;
        return true;
    }
};

typedef float f32x16 __attribute__((ext_vector_type(16)));
typedef short s16x4 __attribute__((ext_vector_type(4)));
#define MFMA32(a, b, c) __builtin_amdgcn_mfma_f32_32x32x16_bf16((a), (b), (c), 0, 0, 0)
__device__ __forceinline__ bf16x8 pack8(float a0, float a1, float a2, float a3, float a4, float a5, float a6, float a7) {
    u32x4 p; p.x = pg::cvt_pk_bf16(a0, a1); p.y = pg::cvt_pk_bf16(a2, a3); p.z = pg::cvt_pk_bf16(a4, a5); p.w = pg::cvt_pk_bf16(a6, a7);
    return __builtin_bit_cast(bf16x8, p);
}
__device__ __forceinline__ bf16x8 load_vt_frag(const bf16* rowp, int h) {
    const s16x4 lo = *(const s16x4*)(rowp + 4 * h), hi = *(const s16x4*)(rowp + 8 + 4 * h);
    return __builtin_shufflevector(lo, hi, 0, 1, 2, 3, 4, 5, 6, 7);
}
__device__ __forceinline__ void sb_unit(unsigned char* ws, LAS unsigned char* lds, int unit, int wave, int lane) {
    const int b = unit >> 5, t0 = (unit & 31) * 64, hd = wave, r = lane & 31, h = lane >> 5;
    const size_t tb = (size_t)b * S;
    const bf16* Q = (const bf16*)(ws + WS_Q); const bf16* Kp = (const bf16*)(ws + WS_K); const bf16* VT = (const bf16*)(ws + WS_VT);
    bf16x8 qf[2][4];
#pragma unroll
    for (int ni = 0; ni < 2; ++ni)
#pragma unroll
        for (int kk = 0; kk < 4; ++kk) qf[ni][kk] = *(const bf16x8*)(Q + (tb + t0 + 32 * ni + r) * 512 + hd * 64 + 16 * kk + 8 * h);
    f32x16 oacc[2][2];
#pragma unroll
    for (int di = 0; di < 2; ++di)
#pragma unroll
        for (int ni = 0; ni < 2; ++ni)
#pragma unroll
            for (int i = 0; i < 16; ++i) oacc[di][ni][i] = 0.f;
    float carry[2] = {0.f, 0.f};
    for (int s0 = t0 + 32; s0 >= 0; s0 -= 32) {
        bf16x8 kf[4];
#pragma unroll
        for (int kk = 0; kk < 4; ++kk) kf[kk] = *(const bf16x8*)(Kp + (tb + s0 + r) * 512 + hd * 64 + 16 * kk + 8 * h);
        bf16x8 vf[2][2];
#pragma unroll
        for (int di = 0; di < 2; ++di)
#pragma unroll
            for (int ks = 0; ks < 2; ++ks) vf[di][ks] = load_vt_frag(VT + (size_t)(hd * 64 + 32 * di + r) * T + tb + s0 + 16 * ks, h);
        const bool diag = (s0 + 31 >= t0);
        bf16x8 pf[2][2];
#pragma unroll
        for (int ni = 0; ni < 2; ++ni) {
            f32x16 sa;
#pragma unroll
            for (int i = 0; i < 16; ++i) sa[i] = 0.f;
#pragma unroll
            for (int kk = 0; kk < 4; ++kk) sa = MFMA32(kf[kk], qf[ni][kk], sa);
            float lnb[16], lb[16];
#pragma unroll
            for (int i = 0; i < 16; ++i) {
                const float z = sa[i];
                const float l = __logf(1.0f + __expf(-fabsf(z)));
                float n_ = -(fmaxf(z, 0.f) + l), b_ = n_ + z;
                if (diag) { const int key = s0 + (i & 3) + 8 * (i >> 2) + 4 * h, tq = t0 + 32 * ni + r; if (!(key < tq)) { n_ = 0.f; b_ = -1.0e30f; } }
                lnb[i] = n_; lb[i] = b_;
            }
            float Tg[4], Pg[4];
#pragma unroll
            for (int g = 0; g < 4; ++g) { const float Gs = (lnb[4 * g] + lnb[4 * g + 1]) + (lnb[4 * g + 2] + lnb[4 * g + 3]); Pg[g] = __shfl_xor(Gs, 32); Tg[g] = Gs + Pg[g]; }
            float suf[4]; suf[3] = 0.f; suf[2] = Tg[3]; suf[1] = Tg[3] + Tg[2]; suf[0] = suf[1] + Tg[1];
            const float total = suf[0] + Tg[0];
            float av[16];
#pragma unroll
            for (int g = 0; g < 4; ++g) {
                const float base = carry[ni] + suf[g] + (h == 0 ? Pg[g] : 0.f);
                const float a3 = base, a2 = a3 + lnb[4 * g + 3], a1 = a2 + lnb[4 * g + 2], a0 = a1 + lnb[4 * g + 1];
                av[4 * g + 3] = __expf(lb[4 * g + 3] + a3); av[4 * g + 2] = __expf(lb[4 * g + 2] + a2); av[4 * g + 1] = __expf(lb[4 * g + 1] + a1); av[4 * g] = __expf(lb[4 * g] + a0);
            }
            carry[ni] += total;
            pf[ni][0] = pack8(av[0], av[1], av[2], av[3], av[4], av[5], av[6], av[7]);
            pf[ni][1] = pack8(av[8], av[9], av[10], av[11], av[12], av[13], av[14], av[15]);
        }
#pragma unroll
        for (int di = 0; di < 2; ++di)
#pragma unroll
            for (int ni = 0; ni < 2; ++ni)
#pragma unroll
                for (int ks = 0; ks < 2; ++ks) oacc[di][ni] = MFMA32(vf[di][ks], pf[ni][ks], oacc[di][ni]);
        if (__all((carry[0] < SB_EXIT) && (carry[1] < SB_EXIT))) break;
    }
    LAS float* ssq = (LAS float*)lds;
    float ss[2];
#pragma unroll
    for (int ni = 0; ni < 2; ++ni) { float v = 0.f;
#pragma unroll
        for (int di = 0; di < 2; ++di)
#pragma unroll
            for (int i = 0; i < 16; ++i) v += oacc[di][ni][i] * oacc[di][ni][i];
        v += __shfl_xor(v, 32); ss[ni] = v;
        if (h == 0) ssq[(32 * ni + r) * 8 + hd] = v; }
    __syncthreads();
    bf16* cat = (bf16*)(ws + WS_CAT);
#pragma unroll
    for (int ni = 0; ni < 2; ++ni) {
        float tot = 0.f;
#pragma unroll
        for (int w = 0; w < 8; ++w) tot += ssq[(32 * ni + r) * 8 + w];
        const float rs = 1.0f / sqrtf(tot * (1.f / 512.f) + EPS);
        bf16* rowp = cat + (tb + t0 + 32 * ni + r) * 1024 + hd * 64 + 4 * h;
#pragma unroll
        for (int di = 0; di < 2; ++di)
#pragma unroll
            for (int g = 0; g < 4; ++g) { unsigned long long w = (unsigned long long)pg::cvt_pk_bf16(oacc[di][ni][4 * g] * rs, oacc[di][ni][4 * g + 1] * rs) | ((unsigned long long)pg::cvt_pk_bf16(oacc[di][ni][4 * g + 2] * rs, oacc[di][ni][4 * g + 3] * rs) << 32);
                *(unsigned long long*)(rowp + 32 * di + 8 * g) = w; }
    }
    __syncthreads();
}

__device__ __forceinline__ void mx_unit(unsigned char* ws, LAS unsigned char* lds, int unit, int wave, int lane) {
    const int b = unit >> 5, t0 = (unit & 31) * 64, hd = wave & 3, qh = wave >> 2, r = lane & 31, h = lane >> 5;
    const size_t tb = (size_t)b * S;
    const bf16* QM = (const bf16*)(ws + WS_QMX); const bf16* MK = (const bf16*)(ws + WS_MEMK); const bf16* MVT = (const bf16*)(ws + WS_MEMVT);
    bf16x8 qf[4];
#pragma unroll
    for (int kk = 0; kk < 4; ++kk) qf[kk] = *(const bf16x8*)(QM + (tb + t0 + 32 * qh + r) * 256 + hd * 64 + 16 * kk + 8 * h);
    f32x16 sa[8];
#pragma unroll
    for (int mi = 0; mi < 8; ++mi) {
#pragma unroll
        for (int i = 0; i < 16; ++i) sa[mi][i] = 0.f;
#pragma unroll
        for (int kk = 0; kk < 4; ++kk) { const bf16x8 kf = *(const bf16x8*)(MK + (size_t)(b * NMEM + 32 * mi + r) * 256 + hd * 64 + 16 * kk + 8 * h); sa[mi] = MFMA32(kf, qf[kk], sa[mi]); }
    }
    float mx = -3.0e38f;
#pragma unroll
    for (int mi = 0; mi < 8; ++mi)
#pragma unroll
        for (int i = 0; i < 16; ++i) mx = fmaxf(mx, sa[mi][i]);
    mx = fmaxf(mx, __shfl_xor(mx, 32));
    float sum = 0.f;
#pragma unroll
    for (int mi = 0; mi < 8; ++mi)
#pragma unroll
        for (int i = 0; i < 16; ++i) { const float pv = __expf(sa[mi][i] - mx); sa[mi][i] = pv; sum += pv; }
    sum += __shfl_xor(sum, 32);
    f32x16 oacc[2];
#pragma unroll
    for (int di = 0; di < 2; ++di)
#pragma unroll
        for (int i = 0; i < 16; ++i) oacc[di][i] = 0.f;
#pragma unroll
    for (int mi = 0; mi < 8; ++mi)
#pragma unroll
        for (int s2 = 0; s2 < 2; ++s2) {
            const bf16x8 pf = pack8(sa[mi][8 * s2], sa[mi][8 * s2 + 1], sa[mi][8 * s2 + 2], sa[mi][8 * s2 + 3], sa[mi][8 * s2 + 4], sa[mi][8 * s2 + 5], sa[mi][8 * s2 + 6], sa[mi][8 * s2 + 7]);
#pragma unroll
            for (int di = 0; di < 2; ++di) { const bf16x8 vf = load_vt_frag(MVT + (size_t)(hd * 64 + 32 * di + r) * TM + b * NMEM + 32 * mi + 16 * s2, h); oacc[di] = MFMA32(vf, pf, oacc[di]); }
        }
    const float inv = 1.0f / sum;
    LAS float* ssq = (LAS float*)lds;
    float v = 0.f;
#pragma unroll
    for (int di = 0; di < 2; ++di)
#pragma unroll
        for (int i = 0; i < 16; ++i) { oacc[di][i] *= inv; v += oacc[di][i] * oacc[di][i]; }
    v += __shfl_xor(v, 32);
    if (h == 0) ssq[(32 * qh + r) * 4 + hd] = v;
    __syncthreads();
    const float tot = (ssq[(32 * qh + r) * 4 + 0] + ssq[(32 * qh + r) * 4 + 1]) + (ssq[(32 * qh + r) * 4 + 2] + ssq[(32 * qh + r) * 4 + 3]);
    const float rs = 1.0f / sqrtf(tot * (1.f / 256.f) + EPS);
    bf16* rowp = (bf16*)(ws + WS_CAT) + (tb + t0 + 32 * qh + r) * 1024 + 768 + hd * 64 + 4 * h;
#pragma unroll
    for (int di = 0; di < 2; ++di)
#pragma unroll
        for (int g = 0; g < 4; ++g) { unsigned long long w = (unsigned long long)pg::cvt_pk_bf16(oacc[di][4 * g] * rs, oacc[di][4 * g + 1] * rs) | ((unsigned long long)pg::cvt_pk_bf16(oacc[di][4 * g + 2] * rs, oacc[di][4 * g + 3] * rs) << 32);
            *(unsigned long long*)(rowp + 32 * di + 8 * g) = w; }
    __syncthreads();
}

constexpr int CV_U_OFF = 0, CV_ACT_OFF = 96256, CV_ACT_PITCH = 528, CV_SSQ_OFF = 65536;
static_assert(CV_ACT_OFF + 64 * CV_ACT_PITCH <= RING_BYTES, "conv LDS");
__device__ __forceinline__ void cv_unit(const Ptrs& p, LAS unsigned char* lds, int unit, int tid, int wave, int lane) {
    unsigned char* ws = p.ws;
    const int b = unit >> 5, t0 = (unit & 31) * 64;
    const size_t tb = (size_t)b * S;
    LAS float* U = (LAS float*)(lds + CV_U_OFF);
    const bf16* GLU = (const bf16*)(ws + WS_GLU);
    for (int it = tid; it < 94 * 32; it += NWAVES * 64) {
        const int row = it >> 5, ch = (it & 31) * 8, tl = t0 - (CONVK - 1) + row;
        f32x4 u0 = (f32x4){0.f, 0.f, 0.f, 0.f}, u1 = u0;
        if (tl >= 0) {
            const v4u av = *(const v4u*)(GLU + (tb + tl) * 512 + ch), gv = *(const v4u*)(GLU + (tb + tl) * 512 + 256 + ch);
            float uu[8];
#pragma unroll
            for (int j = 0; j < 4; ++j) { const float a0 = bf2f(av[j] & 0xffffu), a1 = bf2f(av[j] >> 16), g0 = bf2f(gv[j] & 0xffffu), g1 = bf2f(gv[j] >> 16);
                uu[2 * j] = a0 / (1.0f + __expf(-g0)); uu[2 * j + 1] = a1 / (1.0f + __expf(-g1)); }
            u0 = (f32x4){uu[0], uu[1], uu[2], uu[3]}; u1 = (f32x4){uu[4], uu[5], uu[6], uu[7]};
        }
        *(LAS f32x4*)(U + row * 256 + ch) = u0; *(LAS f32x4*)(U + row * 256 + ch + 4) = u1;
    }
    __syncthreads();
    {
        const int c = tid & 255, th = tid >> 8;
        float w[CONVK], acc[32];
#pragma unroll
        for (int j = 0; j < CONVK; ++j) w[j] = p.in[5][j * CVW + c];
        const float bd = p.in[6][c];
#pragma unroll
        for (int tt = 0; tt < 32; ++tt) acc[tt] = bd;
#pragma unroll
        for (int ii = 0; ii < 62; ++ii) { const float uv = U[(32 * th + ii) * 256 + c];
#pragma unroll
            for (int tt = 0; tt < 32; ++tt) { const int j = ii - tt; if (j >= 0 && j < CONVK) acc[tt] += w[j] * uv; } }
        __syncthreads();
#pragma unroll
        for (int tt = 0; tt < 32; ++tt) U[(32 * th + tt) * 256 + c] = acc[tt];
    }
    __syncthreads();
    {
        const f32x4 gl = *(const f32x4*)(p.in[7] + 4 * lane), bl = *(const f32x4*)(p.in[8] + 4 * lane);
#pragma unroll
        for (int k = 0; k < 8; ++k) { const int tok = 8 * wave + k;
            const f32x4 x = *(const LAS f32x4*)(U + tok * 256 + 4 * lane);
            const float mu = wave_sum((x.x + x.y) + (x.z + x.w)) * (1.f / 256.f);
            const f32x4 d = x - mu;
            const float rstd = 1.0f / sqrtf(wave_sum((d.x * d.x + d.y * d.y) + (d.z * d.z + d.w * d.w)) * (1.f / 256.f) + EPS);
            f32x4 y = d * rstd * gl + bl;
            y.x = y.x / (1.0f + __expf(-y.x)); y.y = y.y / (1.0f + __expf(-y.y)); y.z = y.z / (1.0f + __expf(-y.z)); y.w = y.w / (1.0f + __expf(-y.w));
            *(LAS unsigned long long*)(lds + CV_ACT_OFF + tok * CV_ACT_PITCH + 8 * lane) = (unsigned long long)pg::cvt_pk_bf16(y.x, y.y) | ((unsigned long long)pg::cvt_pk_bf16(y.z, y.w) << 32);
        }
    }
    __syncthreads();
    {
        const int r = lane & 31, h = lane >> 5;
        const bf16* WT = (const bf16*)(ws + WS_WPW2);
        f32x16 acc[2];
#pragma unroll
        for (int ti = 0; ti < 2; ++ti)
#pragma unroll
            for (int i = 0; i < 16; ++i) acc[ti][i] = 0.f;
#pragma unroll 4
        for (int kk = 0; kk < 16; ++kk) {
            const bf16x8 af = *(const bf16x8*)(WT + (size_t)(32 * wave + r) * 256 + 16 * kk + 8 * h);
#pragma unroll
            for (int ti = 0; ti < 2; ++ti) { const bf16x8 bfr = *(const LAS bf16x8*)(lds + CV_ACT_OFF + (32 * ti + r) * CV_ACT_PITCH + (16 * kk + 8 * h) * 2); acc[ti] = MFMA32(af, bfr, acc[ti]); }
        }
        LAS float* ssq = (LAS float*)(lds + CV_SSQ_OFF);
#pragma unroll
        for (int g = 0; g < 4; ++g) { const f32x4 bb = *(const f32x4*)(p.in[10] + 32 * wave + 8 * g + 4 * h);
#pragma unroll
            for (int ti = 0; ti < 2; ++ti) { acc[ti][4 * g] += bb.x; acc[ti][4 * g + 1] += bb.y; acc[ti][4 * g + 2] += bb.z; acc[ti][4 * g + 3] += bb.w; } }
#pragma unroll
        for (int ti = 0; ti < 2; ++ti) { float v = 0.f;
#pragma unroll
            for (int i = 0; i < 16; ++i) v += acc[ti][i] * acc[ti][i];
            v += __shfl_xor(v, 32);
            if (h == 0) ssq[(32 * ti + r) * 8 + wave] = v; }
        __syncthreads();
#pragma unroll
        for (int ti = 0; ti < 2; ++ti) { float tot = 0.f;
#pragma unroll
            for (int w2 = 0; w2 < 8; ++w2) tot += ssq[(32 * ti + r) * 8 + w2];
            const float rs = 1.0f / sqrtf(tot * (1.f / 256.f) + EPS);
            bf16* rowp = (bf16*)(ws + WS_CAT) + (tb + t0 + 32 * ti + r) * 1024 + 512 + 32 * wave + 4 * h;
#pragma unroll
            for (int g = 0; g < 4; ++g) { unsigned long long wv = (unsigned long long)pg::cvt_pk_bf16(acc[ti][4 * g] * rs, acc[ti][4 * g + 1] * rs) | ((unsigned long long)pg::cvt_pk_bf16(acc[ti][4 * g + 2] * rs, acc[ti][4 * g + 3] * rs) << 32);
                *(unsigned long long*)(rowp + 8 * g) = wv; } }
    }
    __syncthreads();
}

__global__ void __launch_bounds__(NWAVES * 64, 2) mk_fwd(MKArgs a) {
    extern __shared__ __attribute__((aligned(16))) unsigned char lds_raw[];
    LAS unsigned char* lds = (LAS unsigned char*)lds_raw;
    const int tid = threadIdx.x, lane = tid & 63, wave = __builtin_amdgcn_readfirstlane(tid >> 6);
    const int G = gridDim.x; const int bx = blockIdx.x; const int vcu = (G % 8 == 0) ? (bx % 8) * (G / 8) + bx / 8 : bx;
    unsigned char* ws = a.p.ws;
    const int lo = a.ph_lo, hi = a.ph_hi;
#define IN(k) (lo <= (k) && (k) < hi)
#define BOTH(k) (IN(k) && IN((k) + 1))
    volatile LAS unsigned* misc = (volatile LAS unsigned*)(lds + MISC_OFF);
    if (tid < 4) misc[tid] = 0u;
    __syncthreads();
    XcdBarrier bar; bar.bar = (unsigned*)(ws + WS_CTL) + CW_BAR; bar.x = 0; bar.st = misc;
    if (hi - lo > 1) bar = xcd_barrier_post((unsigned*)(ws + WS_CTL) + CW_BAR, misc);
    if (IN(0)) { for (int rep = 0; rep < NREP(0); ++rep) {
        float* scr = (float*)(lds_raw + RING_OFF + wave * 16384);
        const int gw = vcu * NWAVES + wave, NGW = G * NWAVES;
        const Ptrs& p = a.p;
        constexpr int I_IN = 16 * 72, I_OUT = 16 * 32, I_MKV = 16 * 16, I_PW2 = 4 * 8, I_GU = 32 * 16 * 64, I_DN = 32 * 16 * 32;
        constexpr int NIT = I_IN + I_OUT + I_MKV + I_PW2 + I_GU + I_DN;
        for (int it = gw; it < NIT; it += NGW) {
            int r = it;
            if (r < I_IN) { const int kb = r / 72, nb = r % 72; transpose_item(p.in[3], 1024, INW, (bf16*)(ws + WS_WIN), 64 * kb, 32 * nb, 32 * nb, nullptr, scr, lane); continue; } r -= I_IN;
            if (r < I_OUT) { const int kb = r / 32, nb = r % 32; const int k0 = 64 * kb;
                const float* ks = k0 < 512 ? p.in[13] : (k0 < 768 ? p.in[14] - 512 : p.in[15] - 768);
                transpose_item(p.in[16], 1024, 1024, (bf16*)(ws + WS_WOUT), k0, 32 * nb, 32 * nb, ks, scr, lane); continue; } r -= I_OUT;
            if (r < I_MKV) { const int kb = r / 16, nb = r % 16; transpose_item(p.in[12], 1024, 512, (bf16*)(ws + WS_WMKV), 64 * kb, 32 * nb, 32 * nb, nullptr, scr, lane); continue; } r -= I_MKV;
            if (r < I_PW2) { const int kb = r / 8, nb = r % 8; transpose_item(p.in[9], 256, 256, (bf16*)(ws + WS_WPW2), 64 * kb, 32 * nb, 32 * nb, nullptr, scr, lane); continue; } r -= I_PW2;
            if (r < I_GU) { const int e = r / 1024, q = r % 1024, kb = q / 64, nb = q % 64; const int n0 = 32 * nb, isup = n0 >> 10, cc = n0 & 1023, j = cc >> 7, c = cc & 127;
                transpose_item(p.in[20] + (size_t)e * 1024 * 2048, 1024, 2048, (bf16*)(ws + WS_WGU) + (size_t)e * 2048 * 1024, 64 * kb, n0, 256 * j + 128 * isup + c, nullptr, scr, lane); continue; } r -= I_GU;
            { const int e = r / 512, q = r % 512, kb = q / 32, nb = q % 32;
                transpose_item(p.in[22] + (size_t)e * 1024 * 1024, 1024, 1024, (bf16*)(ws + WS_WDN) + (size_t)e * 1024 * 1024, 64 * kb, 32 * nb, 32 * nb, nullptr, scr, lane); }
        }
        for (int m = gw; m < T; m += NGW) rms_row_to_bf16(p.in[0] + (size_t)m * D, p.in[2], (bf16*)(ws + WS_XN) + (size_t)m * D, lane);
        for (int m = gw; m < TM; m += NGW) rms_row_to_bf16(p.in[1] + (size_t)m * D, p.in[11], (bf16*)(ws + WS_MEMN) + (size_t)m * D, lane);
        __syncthreads(); }
        if (BOTH(0)) xcd_barrier(bar);
    }
    if (IN(1)) {
        SchedP1 Sc{G, vcu, ws, a.p.in[4]}; pg::EpiBf16 E;
        for (int rep = 0; rep < NREP(1); ++rep) pg::gemm_phase<pg::EpiBf16, SchedP1, false>(lds + RING_OFF, Sc, E, nullptr);
        if (BOTH(1)) xcd_barrier(bar);
    }
    if (IN(2)) {
        constexpr int NU2 = NB * (S / 64);
        for (int u = vcu; u < NU2 * NREP(20); u += G) sb_unit(ws, lds + RING_OFF, u & (NU2 - 1), wave, lane);
        for (int u = vcu; u < NU2 * NREP(21); u += G) mx_unit(ws, lds + RING_OFF, u & (NU2 - 1), wave, lane);
        for (int u = vcu; u < NU2 * NREP(22); u += G) cv_unit(a.p, lds + RING_OFF, u & (NU2 - 1), tid, wave, lane);
        if (BOTH(2)) xcd_barrier(bar);
    }
    if (IN(3)) {
        SchedP3 Sc{G, vcu, ws, a.p.in[0], a.p.out}; pg::EpiResid E;
        for (int rep = 0; rep < NREP(3); ++rep) pg::gemm_phase<pg::EpiResid, SchedP3, false>(lds + RING_OFF, Sc, E, nullptr);
        if (BOTH(3)) xcd_barrier(bar);
    }
    if (IN(4)) {
        const Ptrs& p = a.p;
        LAS float* hq = (LAS float*)(lds + RING_OFF);
        LAS float* part = (LAS float*)(lds + RING_OFF + 65536);
        LAS int* lcnt = (LAS int*)(lds + RING_OFF + 65536 + 16384);
        LAS int* pend = (LAS int*)(lds + RING_OFF + 65536 + 16384 + 256);
        const int e = lane & 31, hf = lane >> 5;
        float wreg[64];
#pragma unroll
        for (int q = 0; q < 64; ++q) wreg[q] = p.in[18][(size_t)(128 * wave + 64 * hf + q) * NE + e];
        const float bre = p.in[19][e];
        const f32x4* gr = (const f32x4*)p.in[17] + lane;
        for (int blk = vcu; blk < T / 128; blk += G) {
        if (tid < 64) lcnt[tid] = 0;
        const int tokbase = blk * 128;
        f32x4 v[2][4];
#pragma unroll
        for (int j2 = 0; j2 < 2; ++j2)
#pragma unroll
            for (int j = 0; j < 4; ++j) v[j2][j] = ((const f32x4*)(p.out + (size_t)(tokbase + 2 * wave + j2) * D))[lane + 64 * j];
        for (int bt = 0; bt < 8; ++bt) {
#pragma unroll
            for (int j2 = 0; j2 < 2; ++j2) {
                const int tl = 2 * wave + j2, tok = tokbase + 16 * bt + tl;
                float s2 = 0.f;
#pragma unroll
                for (int j = 0; j < 4; ++j) s2 += (v[j2][j].x * v[j2][j].x + v[j2][j].y * v[j2][j].y) + (v[j2][j].z * v[j2][j].z + v[j2][j].w * v[j2][j].w);
                const float rs = 1.0f / sqrtf(wave_sum(s2) * (1.f / D) + EPS);
                unsigned long long* o8 = (unsigned long long*)((bf16*)(ws + WS_HN) + (size_t)tok * D) + lane;
#pragma unroll
                for (int j = 0; j < 4; ++j) { const f32x4 gg = gr[64 * j]; f32x4 y; y.x = v[j2][j].x * rs * gg.x; y.y = v[j2][j].y * rs * gg.y; y.z = v[j2][j].z * rs * gg.z; y.w = v[j2][j].w * rs * gg.w;
                    o8[64 * j] = (unsigned long long)pk2(y.x, y.y) | ((unsigned long long)pk2(y.z, y.w) << 32);
                    *(LAS f32x4*)(hq + tl * 1024 + 4 * lane + 256 * j) = y; }
            }
            __syncthreads();
            if (bt < 7) {
#pragma unroll
                for (int j2 = 0; j2 < 2; ++j2)
#pragma unroll
                    for (int j = 0; j < 4; ++j) v[j2][j] = ((const f32x4*)(p.out + (size_t)(tokbase + 16 * (bt + 1) + 2 * wave + j2) * D))[lane + 64 * j];
            }
#pragma unroll 2
            for (int t = 0; t < 16; ++t) {
                float acc = 0.f;
#pragma unroll
                for (int q = 0; q < 16; ++q) { const f32x4 hv = *(const LAS f32x4*)(hq + t * 1024 + 128 * wave + 64 * hf + 4 * q);
                    acc += hv.x * wreg[4 * q] + hv.y * wreg[4 * q + 1] + hv.z * wreg[4 * q + 2] + hv.w * wreg[4 * q + 3]; }
                acc += __shfl_xor(acc, 32);
                if (hf == 0) part[(wave * 16 + t) * 32 + e] = acc;
            }
            __syncthreads();
#pragma unroll
            for (int j2 = 0; j2 < 2; ++j2) {
                const int tl = 2 * wave + j2;
                float lg = bre;
#pragma unroll
                for (int w2 = 0; w2 < 8; ++w2) lg += part[(w2 * 16 + tl) * 32 + e];
                int my_e = 0; float my_v = 0.f, m0 = 0.f;
#pragma unroll
                for (int k = 0; k < 4; ++k) {
                    const float m = wave_max(lg);
                    const unsigned long long bal = __ballot(lg == m);
                    const int idx = (int)(__ffsll((long long)bal) - 1) & 31;
                    if (lane == k) { my_e = idx; my_v = m; }
                    if (k == 0) m0 = m;
                    if (e == idx) lg = -3.0e38f;
                }
                const float exv = (lane < 4) ? __expf(my_v - m0) : 0.f;
                const float es = __shfl(exv, 0) + __shfl(exv, 1) + __shfl(exv, 2) + __shfl(exv, 3);
                if (lane < 4) {
                    const int rank = atomicAdd((int*)(lcnt + my_e), 1);
                    LAS int* pe = pend + ((16 * bt + tl) * 4 + lane) * 3;
                    pe[0] = my_e; pe[1] = rank; pe[2] = __float_as_int(exv / es);
                }
            }
        }
        __syncthreads();
        if (tid < 32) { const int n = lcnt[tid]; lcnt[32 + tid] = n > 0 ? (int)atomicAdd((unsigned*)(ws + WS_CTL) + CW_CNT + tid, (unsigned)n) : 0; }
        __syncthreads();
        { const int tl = tid >> 2, k = tid & 3, tok = tokbase + tl;
            const LAS int* pe = pend + tid * 3; const int ee = pe[0], slot = lcnt[32 + ee] + pe[1];
            ((int*)(ws + WS_LIST))[(size_t)ee * T + slot] = tok;
            ((int*)(ws + WS_TOKE))[tok * 4 + k] = ee;
            ((int*)(ws + WS_TOKS))[tok * 4 + k] = slot;
            ((float*)(ws + WS_TOKG))[tok * 4 + k] = __int_as_float(pe[2]); }
        __syncthreads();
        }
        if (BOTH(4)) xcd_barrier(bar);
    }
    if (IN(5)) {
        LAS int* ut = (LAS int*)(lds + UTAB_OFF); LAS unsigned* gt = (LAS unsigned*)(lds + GTAB_OFF);
        moe_tables<8>(ut, (const unsigned*)(ws + WS_CTL) + CW_CNT, G, vcu, tid);
        for (int i = 0; i < MAXU; ++i) {
            const int e = ut[UT_UNIT + 4 * i]; if (e < 0) break;
            if (tid < 256) { const int row = ut[UT_UNIT + 4 * i + 1] * 256 + tid, c = ut[UT_CNT + e]; const int src = row < c ? row : c - 1;
                gt[i * 256 + tid] = (unsigned)((const int*)(ws + WS_LIST))[(size_t)e * T + src] * 2048u; }
        }
        __syncthreads();
        SchedGU Sc{ut, ws, a.p.in[21]}; pg::EpiSwiGLU E;
        for (int rep = 0; rep < NREP(5); ++rep) pg::gemm_phase<pg::EpiSwiGLU, SchedGU, true>(lds + RING_OFF, Sc, E, gt);
        if (BOTH(5)) xcd_barrier(bar);
    }
    if (IN(6)) {
        LAS int* ut = (LAS int*)(lds + UTAB_OFF);
        moe_tables<4>(ut, (const unsigned*)(ws + WS_CTL) + CW_CNT, G, vcu, tid);
        SchedDN Sc{ut, ws, a.p.in[23]}; pg::EpiBf16 E;
        for (int rep = 0; rep < NREP(6); ++rep) pg::gemm_phase<pg::EpiBf16, SchedDN, false>(lds + RING_OFF, Sc, E, nullptr);
        if (BOTH(6)) xcd_barrier(bar);
    }
    if (IN(7)) {
        const Ptrs& p = a.p;
        LAS int* ut = (LAS int*)(lds + UTAB_OFF);
        moe_tables<4>(ut, (const unsigned*)(ws + WS_CTL) + CW_CNT, G, vcu, tid);
        const int gw = vcu * NWAVES + wave, NGW = G * NWAVES;
        const f32x4* gr = (const f32x4*)p.in[24] + lane;
        for (int tok0 = gw * 2; tok0 < T; tok0 += NGW * 2) {
            f32x4 v[2][4]; unsigned long long yv[2][4][4]; float gts[2][4];
#pragma unroll
            for (int j2 = 0; j2 < 2; ++j2) {
                const int tok = tok0 + j2;
#pragma unroll
                for (int j = 0; j < 4; ++j) v[j2][j] = ((const f32x4*)(p.out + (size_t)tok * D))[lane + 64 * j];
                const int4 ev = *(const int4*)((const int*)(ws + WS_TOKE) + tok * 4), sv = *(const int4*)((const int*)(ws + WS_TOKS) + tok * 4); const f32x4 gv = *(const f32x4*)((const float*)(ws + WS_TOKG) + tok * 4);
                const int es[4] = {ev.x, ev.y, ev.z, ev.w}, ss[4] = {sv.x, sv.y, sv.z, sv.w};
                gts[j2][0] = gv.x; gts[j2][1] = gv.y; gts[j2][2] = gv.z; gts[j2][3] = gv.w;
#pragma unroll
                for (int k = 0; k < 4; ++k) {
                    const unsigned long long* y8 = (const unsigned long long*)((const bf16*)(ws + WS_Y) + (size_t)(ut[UT_PST + es[k]] + ss[k]) * 1024) + lane;
#pragma unroll
                    for (int j = 0; j < 4; ++j) yv[j2][k][j] = y8[64 * j];
                }
            }
#pragma unroll
            for (int j2 = 0; j2 < 2; ++j2) {
                const int tok = tok0 + j2;
#pragma unroll
                for (int k = 0; k < 4; ++k) { const float gt = gts[j2][k];
#pragma unroll
                    for (int j = 0; j < 4; ++j) { const unsigned long long w = yv[j2][k][j]; const unsigned lo_ = (unsigned)w, hi_ = (unsigned)(w >> 32);
                        v[j2][j].x += gt * bf2f(lo_ & 0xffffu); v[j2][j].y += gt * bf2f(lo_ >> 16); v[j2][j].z += gt * bf2f(hi_ & 0xffffu); v[j2][j].w += gt * bf2f(hi_ >> 16); } }
                float s2 = 0.f;
#pragma unroll
                for (int j = 0; j < 4; ++j) s2 += (v[j2][j].x * v[j2][j].x + v[j2][j].y * v[j2][j].y) + (v[j2][j].z * v[j2][j].z + v[j2][j].w * v[j2][j].w);
                const float rs = 1.0f / sqrtf(wave_sum(s2) * (1.f / D) + EPS);
#pragma unroll
                for (int j = 0; j < 4; ++j) { const f32x4 gg = gr[64 * j]; f32x4 y; y.x = v[j2][j].x * rs * gg.x; y.y = v[j2][j].y * rs * gg.y; y.z = v[j2][j].z * rs * gg.z; y.w = v[j2][j].w * rs * gg.w; ((f32x4*)(p.out + (size_t)tok * D))[lane + 64 * j] = y; }
            }
        }
    }
#undef IN
#undef BOTH
}

extern "C" void kernel_launch(void* const* d_in, const int* in_sizes, int n_in, void* d_out, int out_size, void* d_ws, size_t ws_size, hipStream_t stream) {
    if (n_in != 25 || out_size != T * D || ws_size < WS_END) { fprintf(stderr, "kernel_launch: unexpected shapes n_in %d out %d ws %zu\n", n_in, out_size, ws_size); return; }
    Ptrs p{};
    for (int i = 0; i < 25; ++i) p.in[i] = (const float*)d_in[i];
    p.out = (float*)d_out; p.ws = (unsigned char*)d_ws;
    (void)hipMemsetAsync((char*)d_ws + WS_CTL, 0, CTL_BYTES, stream);
    static int grid = 0;
    if (grid == 0) {
        int dev = 0, cus = 0;
        if (hipGetDevice(&dev) != hipSuccess || hipDeviceGetAttribute(&cus, hipDeviceAttributeMultiprocessorCount, dev) != hipSuccess) { grid = -1; return; }
        if (hipFuncSetAttribute((const void*)mk_fwd, hipFuncAttributeMaxDynamicSharedMemorySize, LDS_BYTES) != hipSuccess) { fprintf(stderr, "hipFuncSetAttribute failed\n"); grid = -1; return; }
        int per_cu = 0;
        if (hipOccupancyMaxActiveBlocksPerMultiprocessor(&per_cu, (const void*)mk_fwd, NWAVES * 64, LDS_BYTES) != hipSuccess || per_cu < 1) { fprintf(stderr, "occupancy query: %d\n", per_cu); }
        (void)hipGetLastError();
        grid = cus;
    }
    if (grid < 0) return;
#ifndef MK_PER_PHASE
    { MKArgs a{}; a.p = p; a.ph_lo = 0; a.ph_hi = 8; hipLaunchKernelGGL(mk_fwd, dim3(grid), dim3(NWAVES * 64), LDS_BYTES, stream, a); }
#else
    for (int ph = 0; ph < 8; ++ph) { MKArgs a{}; a.p = p; a.ph_lo = ph; a.ph_hi = ph + 1; hipLaunchKernelGGL(mk_fwd, dim3(grid), dim3(NWAVES * 64), LDS_BYTES, stream, a); }
#endif
}
```

```cpp
#include <hip/hip_runtime.h>
#include <cstdio>
#include <cstdint>

typedef unsigned short bf16;
typedef unsigned v4u __attribute__((ext_vector_type(4)));
typedef float f32x4 __attribute__((ext_vector_type(4)));

constexpr int NB = 16, S = 2048, T = NB * S, D = 1024;
constexpr int SBH = 8, HD = 64, SBW = 512, CVW = 256, MXH = 4, MXW = 256, INW = 2304, NMEM = 256, TM = NB * NMEM;
constexpr int NE = 32, TOPK = 4, DFF = 1024, CONVK = 31;
constexpr int PMAX = T * TOPK + NE * 256;
constexpr float EPS = 1e-6f;
constexpr float SB_EXIT = -60.0f;

constexpr size_t MiB = 1u << 20;
constexpr size_t WS_CTL = 0, CTL_BYTES = 1 * MiB;
constexpr size_t WS_WIN = 2 * MiB;
constexpr size_t WS_WOUT = 7 * MiB;
constexpr size_t WS_WMKV = 9 * MiB;
constexpr size_t WS_WPW2 = 10 * MiB;
constexpr size_t WS_WGU = 16 * MiB;
constexpr size_t WS_WDN = 144 * MiB;
constexpr size_t WS_MEMN = 208 * MiB;
constexpr size_t WS_MEMK = 216 * MiB;
constexpr size_t WS_MEMVT = 218 * MiB;
constexpr size_t WS_LIST = 220 * MiB;
constexpr size_t WS_TOKE = 224 * MiB;
constexpr size_t WS_TOKS = 224 * MiB + 512 * 1024;
constexpr size_t WS_TOKG = 225 * MiB;
constexpr size_t WS_HN = 226 * MiB;
constexpr size_t WS_XN = 290 * MiB;
constexpr size_t WS_Q = 354 * MiB;
constexpr size_t WS_K = 386 * MiB;
constexpr size_t WS_VT = 418 * MiB;
constexpr size_t WS_GLU = 450 * MiB;
constexpr size_t WS_QMX = 482 * MiB;
constexpr size_t WS_CAT = 498 * MiB;
constexpr size_t WS_HACT = 562 * MiB;
constexpr size_t WS_Y = 290 * MiB;
constexpr size_t WS_END = 834 * MiB;
constexpr size_t WS_OSB = 562 * MiB;
constexpr size_t WS_OCV = 626 * MiB;
constexpr size_t WS_OMX = 658 * MiB;
static_assert((size_t)PMAX * 1024 * 2 == 272 * MiB, "padded rows");
constexpr int CW_CNT = 64;
constexpr float W8_SCALE = 32.0f;

__device__ __forceinline__ float bf2f(unsigned v) { return __uint_as_float(v << 16); }
__device__ __forceinline__ unsigned f2bf(float f) { unsigned u = __float_as_uint(f); return (u + 0x7fffu + ((u >> 16) & 1u)) >> 16; }
__device__ __forceinline__ unsigned pk2(float lo, float hi) { return f2bf(lo) | (f2bf(hi) << 16); }
__device__ __forceinline__ float wave_sum(float v) {
#pragma unroll
    for (int o = 1; o < 64; o <<= 1) v += __shfl_xor(v, o);
    return v;
}
__device__ __forceinline__ float wave_max(float v) {
#pragma unroll
    for (int o = 1; o < 64; o <<= 1) v = fmaxf(v, __shfl_xor(v, o));
    return v;
}

__device__ __forceinline__ void transpose_item(const float* W, int K, int N, bf16* WT, int k0, int n0, int dstrow0, const float* kscale, float* scr, int lane) {
#pragma unroll 8
    for (int i = 0; i < 32; ++i) { const int kk = 2 * i + (lane >> 5); float v = W[(size_t)(k0 + kk) * N + n0 + (lane & 31)]; if (kscale) v *= kscale[k0 + kk]; scr[kk * 33 + (lane & 31)] = v; }
    asm volatile("s_waitcnt lgkmcnt(0)" ::: "memory");
    const int c = lane & 7;
#pragma unroll
    for (int j = 0; j < 4; ++j) { const int n = (lane >> 3) + 8 * j; const float* s = scr + (8 * c) * 33 + n;
        v4u o; o.x = pk2(s[0 * 33], s[1 * 33]); o.y = pk2(s[2 * 33], s[3 * 33]); o.z = pk2(s[4 * 33], s[5 * 33]); o.w = pk2(s[6 * 33], s[7 * 33]);
        *(v4u*)(WT + (size_t)(dstrow0 + n) * K + k0 + 8 * c) = o; }
    asm volatile("s_waitcnt lgkmcnt(0)" ::: "memory");
}
__device__ __forceinline__ void transpose_item_fp8(const float* W, int K, int N, unsigned char* WT, int k0, int n0, int dstrow0, float* scr, int lane) {
#pragma unroll 8
    for (int i = 0; i < 32; ++i) { const int kk = 2 * i + (lane >> 5); scr[kk * 33 + (lane & 31)] = W[(size_t)(k0 + kk) * N + n0 + (lane & 31)] * W8_SCALE; }
    asm volatile("s_waitcnt lgkmcnt(0)" ::: "memory");
    const int c = lane & 7;
#pragma unroll
    for (int j = 0; j < 4; ++j) { const int n = (lane >> 3) + 8 * j; const float* s = scr + (8 * c) * 33 + n;
        int w0 = 0, w1 = 0;
        w0 = __builtin_amdgcn_cvt_pk_fp8_f32(s[0 * 33], s[1 * 33], w0, false); w0 = __builtin_amdgcn_cvt_pk_fp8_f32(s[2 * 33], s[3 * 33], w0, true);
        w1 = __builtin_amdgcn_cvt_pk_fp8_f32(s[4 * 33], s[5 * 33], w1, false); w1 = __builtin_amdgcn_cvt_pk_fp8_f32(s[6 * 33], s[7 * 33], w1, true);
        *(unsigned long long*)(WT + (size_t)(dstrow0 + n) * K + k0 + 8 * c) = (unsigned long long)(unsigned)w0 | ((unsigned long long)(unsigned)w1 << 32); }
    asm volatile("s_waitcnt lgkmcnt(0)" ::: "memory");
}
__device__ __forceinline__ void rms_row_to_bf16(const float* xrow, const float* g, bf16* orow, int lane) {
    const f32x4* xr = (const f32x4*)xrow + lane; const f32x4* gr = (const f32x4*)g + lane;
    f32x4 v[4]; float s = 0.f;
#pragma unroll
    for (int j = 0; j < 4; ++j) { v[j] = xr[64 * j]; s += (v[j].x * v[j].x + v[j].y * v[j].y) + (v[j].z * v[j].z + v[j].w * v[j].w); }
    const float rs = 1.0f / sqrtf(wave_sum(s) * (1.f / D) + EPS);
    unsigned long long* o8 = (unsigned long long*)orow + lane;
#pragma unroll
    for (int j = 0; j < 4; ++j) { const f32x4 gg = gr[64 * j]; o8[64 * j] = (unsigned long long)pk2(v[j].x * rs * gg.x, v[j].y * rs * gg.y) | ((unsigned long long)pk2(v[j].z * rs * gg.z, v[j].w * rs * gg.w) << 32); }
}

struct Ptrs {
    const float* in[25]; float* out; unsigned char* ws;
};

__global__ void __launch_bounds__(256) k_prologue(Ptrs p) {
    __shared__ float scr_all[4][64 * 33];
    const int lane = threadIdx.x & 63, wave = threadIdx.x >> 6;
    float* scr = scr_all[wave];
    const int gw = blockIdx.x * 4 + wave, NGW = gridDim.x * 4;
    unsigned char* ws = p.ws;
    constexpr int I_IN = 16 * 72, I_OUT = 16 * 32, I_MKV = 16 * 16, I_PW2 = 4 * 8, I_GU = 32 * 16 * 64, I_DN = 32 * 16 * 32;
    constexpr int NIT = I_IN + I_OUT + I_MKV + I_PW2 + I_GU + I_DN;
    for (int it = gw; it < NIT; it += NGW) {
        int r = it;
        if (r < I_IN) { const int kb = r / 72, nb = r % 72; transpose_item(p.in[3], 1024, INW, (bf16*)(ws + WS_WIN), 64 * kb, 32 * nb, 32 * nb, nullptr, scr, lane); continue; } r -= I_IN;
        if (r < I_OUT) { const int kb = r / 32, nb = r % 32; const int k0 = 64 * kb;
            const float* ks = k0 < 512 ? p.in[13] : (k0 < 768 ? p.in[14] - 512 : p.in[15] - 768);
            transpose_item(p.in[16], 1024, 1024, (bf16*)(ws + WS_WOUT), k0, 32 * nb, 32 * nb, ks, scr, lane); continue; } r -= I_OUT;
        if (r < I_MKV) { const int kb = r / 16, nb = r % 16; transpose_item(p.in[12], 1024, 512, (bf16*)(ws + WS_WMKV), 64 * kb, 32 * nb, 32 * nb, nullptr, scr, lane); continue; } r -= I_MKV;
        if (r < I_PW2) { const int kb = r / 8, nb = r % 8; transpose_item(p.in[9], 256, 256, (bf16*)(ws + WS_WPW2), 64 * kb, 32 * nb, 32 * nb, nullptr, scr, lane); continue; } r -= I_PW2;
        if (r < I_GU) { const int e = r / 1024, q = r % 1024, kb = q / 64, nb = q % 64; const int n0 = 32 * nb, isup = n0 >> 10, cc = n0 & 1023, j = cc >> 7, c = cc & 127;
            transpose_item(p.in[20] + (size_t)e * 1024 * 2048, 1024, 2048, (bf16*)(ws + WS_WGU) + (size_t)e * 2048 * 1024, 64 * kb, n0, 256 * j + 128 * isup + c, nullptr, scr, lane); continue; } r -= I_GU;
        { const int e = r / 512, q = r % 512, kb = q / 32, nb = q % 32;
            transpose_item(p.in[22] + (size_t)e * 1024 * 1024, 1024, 1024, (bf16*)(ws + WS_WDN) + (size_t)e * 1024 * 1024, 64 * kb, 32 * nb, 32 * nb, nullptr, scr, lane); }
    }
    for (int m = gw; m < T; m += NGW) rms_row_to_bf16(p.in[0] + (size_t)m * D, p.in[2], (bf16*)(ws + WS_XN) + (size_t)m * D, lane);
    for (int m = gw; m < TM; m += NGW) rms_row_to_bf16(p.in[1] + (size_t)m * D, p.in[11], (bf16*)(ws + WS_MEMN) + (size_t)m * D, lane);
}

enum { MODE_INPROJ = 0, MODE_MEMKV = 1, MODE_OUT = 2, MODE_GU = 3, MODE_DN = 4 };
__device__ __forceinline__ void moe_prefix(const unsigned* cnt, int e, int& count, int& pstart) {
    int ps = 0, c = 0;
    for (int i = 0; i < NE; ++i) { const int ci = (int)cnt[i]; if (i < e) ps += ((ci + 255) >> 8) << 8; if (i == e) c = ci; }
    count = c; pstart = ps;
}
template <int MODE>
__global__ void __launch_bounds__(256) k_naive_gemm(Ptrs p) {
    __shared__ float sA[32][65], sB[32][65];
    unsigned char* ws = p.ws;
    const int tid = threadIdx.x, ty = tid >> 4, tx = tid & 15;
    const int rt = blockIdx.x, ct = blockIdx.y, e = blockIdx.z;
    const bf16* A; const bf16* Bt; int K = 1024;
    int count = 0, pstart = 0;
    const int* list = nullptr;
    if (MODE == MODE_INPROJ) { A = (const bf16*)(ws + WS_XN); Bt = (const bf16*)(ws + WS_WIN); }
    else if (MODE == MODE_MEMKV) { A = (const bf16*)(ws + WS_MEMN); Bt = (const bf16*)(ws + WS_WMKV); }
    else if (MODE == MODE_OUT) { A = (const bf16*)(ws + WS_CAT); Bt = (const bf16*)(ws + WS_WOUT); }
    else {
        moe_prefix((const unsigned*)(ws + WS_CTL) + CW_CNT, e, count, pstart);
        if (rt * 64 >= count) return;
        list = (const int*)(ws + WS_LIST) + (size_t)e * T;
        if (MODE == MODE_GU) { A = (const bf16*)(ws + WS_HN); Bt = (const bf16*)(ws + WS_WGU) + (size_t)e * 2048 * 1024; }
        else { A = (const bf16*)(ws + WS_HACT) + (size_t)pstart * 1024; Bt = (const bf16*)(ws + WS_WDN) + (size_t)e * 1024 * 1024; }
    }
    const int lr = tid >> 2, kc = (tid & 3) * 8;
    size_t arow;
    { const int r = rt * 64 + lr; if (MODE == MODE_GU) { const int tok = (r < count) ? list[r] : 0; arow = (size_t)tok * K; } else arow = (size_t)r * K; }
    size_t brow;
    { int n; if (MODE == MODE_GU) { const int jb = ct >> 2, c0 = (ct & 3) * 32; n = 256 * jb + 128 * (lr >> 5) + c0 + (lr & 31); } else n = ct * 64 + lr; brow = (size_t)n * K; }
    float acc[4][4];
#pragma unroll
    for (int i = 0; i < 4; ++i)
#pragma unroll
        for (int j = 0; j < 4; ++j) acc[i][j] = 0.f;
    int cl[4];
#pragma unroll
    for (int j = 0; j < 4; ++j) cl[j] = (MODE == MODE_GU) ? (j < 2 ? 2 * tx + j : 32 + 2 * tx + (j - 2)) : 4 * tx + j;
    for (int k0 = 0; k0 < K; k0 += 32) {
        const v4u av = *(const v4u*)(A + arow + k0 + kc), bv = *(const v4u*)(Bt + brow + k0 + kc);
        __syncthreads();
#pragma unroll
        for (int j = 0; j < 4; ++j) { const unsigned a = av[j], b = bv[j];
            sA[kc + 2 * j][lr] = bf2f(a & 0xffffu); sA[kc + 2 * j + 1][lr] = bf2f(a >> 16);
            sB[kc + 2 * j][lr] = bf2f(b & 0xffffu); sB[kc + 2 * j + 1][lr] = bf2f(b >> 16); }
        __syncthreads();
#pragma unroll 8
        for (int k = 0; k < 32; ++k) {
            float a[4], b[4];
#pragma unroll
            for (int i = 0; i < 4; ++i) a[i] = sA[k][ty * 4 + i];
#pragma unroll
            for (int j = 0; j < 4; ++j) b[j] = sB[k][cl[j]];
#pragma unroll
            for (int i = 0; i < 4; ++i)
#pragma unroll
                for (int j = 0; j < 4; ++j) acc[i][j] += a[i] * b[j];
        }
    }
#pragma unroll
    for (int i = 0; i < 4; ++i) {
        const int r = rt * 64 + ty * 4 + i;
        if (MODE == MODE_INPROJ) {
#pragma unroll
            for (int j = 0; j < 4; ++j) { const int n = ct * 64 + 4 * tx + j; const float v = acc[i][j];
                if (n < 512) ((bf16*)(ws + WS_Q))[(size_t)r * 512 + n] = (bf16)f2bf(v * 0.125f);
                else if (n < 1024) ((bf16*)(ws + WS_K))[(size_t)r * 512 + n - 512] = (bf16)f2bf(v);
                else if (n < 1536) ((bf16*)(ws + WS_VT))[(size_t)(n - 1024) * T + r] = (bf16)f2bf(v);
                else if (n < 2048) ((bf16*)(ws + WS_GLU))[(size_t)r * 512 + n - 1536] = (bf16)f2bf(v + p.in[4][n - 1536]);
                else ((bf16*)(ws + WS_QMX))[(size_t)r * 256 + n - 2048] = (bf16)f2bf(v * 0.125f); }
        } else if (MODE == MODE_MEMKV) {
#pragma unroll
            for (int j = 0; j < 4; ++j) { const int n = ct * 64 + 4 * tx + j; const float v = acc[i][j];
                if (n < 256) ((bf16*)(ws + WS_MEMK))[(size_t)r * 256 + n] = (bf16)f2bf(v);
                else ((bf16*)(ws + WS_MEMVT))[(size_t)(n - 256) * TM + r] = (bf16)f2bf(v); }
        } else if (MODE == MODE_OUT) {
#pragma unroll
            for (int j = 0; j < 4; ++j) { const int n = ct * 64 + 4 * tx + j; p.out[(size_t)r * D + n] = p.in[0][(size_t)r * D + n] + acc[i][j]; }
        } else if (MODE == MODE_GU) {
            const int jb = ct >> 2, c0 = (ct & 3) * 32;
#pragma unroll
            for (int j = 0; j < 2; ++j) { const int hc = 128 * jb + c0 + 2 * tx + j;
                float g = acc[i][j] + p.in[21][(size_t)e * 2048 + hc], u = acc[i][j + 2] + p.in[21][(size_t)e * 2048 + 1024 + hc];
                g = fminf(g, 7.0f); u = fminf(fmaxf(u, -7.0f), 7.0f);
                const float h = (u + 1.0f) * (g / (1.0f + __expf(-1.702f * g)));
                ((bf16*)(ws + WS_HACT))[(size_t)(pstart + r) * 1024 + hc] = (bf16)f2bf(h); }
        } else {
#pragma unroll
            for (int j = 0; j < 4; ++j) { const int n = ct * 64 + 4 * tx + j;
                ((bf16*)(ws + WS_Y))[(size_t)(pstart + r) * 1024 + n] = (bf16)f2bf(acc[i][j] + p.in[23][(size_t)e * 1024 + n]); }
        }
    }
}

__global__ void __launch_bounds__(256) k_naive_sb(Ptrs p) {
    unsigned char* ws = p.ws;
    const int gid = blockIdx.x * 256 + threadIdx.x;
    const int t = gid % S, h = (gid / S) % SBH, b = gid / (S * SBH);
    const bf16* Q = (const bf16*)(ws + WS_Q); const bf16* Kp = (const bf16*)(ws + WS_K); const bf16* VT = (const bf16*)(ws + WS_VT);
    float q[64], o[64];
    { const v4u* qp = (const v4u*)(Q + (size_t)(b * S + t) * 512 + h * 64);
#pragma unroll
        for (int c = 0; c < 8; ++c) { const v4u v = qp[c];
#pragma unroll
            for (int j = 0; j < 4; ++j) { q[c * 8 + 2 * j] = bf2f(v[j] & 0xffffu); q[c * 8 + 2 * j + 1] = bf2f(v[j] >> 16); } } }
#pragma unroll
    for (int d = 0; d < 64; ++d) o[d] = 0.f;
    float carry = 0.f;
    for (int s = t - 1; s >= 0; --s) {
        const v4u* kp = (const v4u*)(Kp + (size_t)(b * S + s) * 512 + h * 64);
        float z = 0.f;
#pragma unroll
        for (int c = 0; c < 8; ++c) { const v4u v = kp[c];
#pragma unroll
            for (int j = 0; j < 4; ++j) { z += q[c * 8 + 2 * j] * bf2f(v[j] & 0xffffu); z += q[c * 8 + 2 * j + 1] * bf2f(v[j] >> 16); } }
        const float l = __logf(1.0f + __expf(-fabsf(z)));
        const float lb = -(fmaxf(-z, 0.f) + l), lnb = -(fmaxf(z, 0.f) + l);
        const float a = __expf(lb + carry);
        carry += lnb;
        const bf16* vp = VT + (size_t)(h * 64) * T + (size_t)b * S + s;
#pragma unroll
        for (int d = 0; d < 64; ++d) o[d] += a * bf2f(vp[(size_t)d * T]);
        if (carry < SB_EXIT) break;
    }
    float* O = (float*)(ws + WS_OSB) + (size_t)(b * S + t) * 512 + h * 64;
#pragma unroll
    for (int d = 0; d < 64; ++d) O[d] = o[d];
}

__global__ void __launch_bounds__(256) k_naive_conv(Ptrs p) {
    __shared__ float act_all[4][256];
    unsigned char* ws = p.ws;
    const int lane = threadIdx.x & 63, wave = threadIdx.x >> 6;
    float* act = act_all[wave];
    const int tok = blockIdx.x * 4 + wave, t = tok % S;
    const bf16* GLU = (const bf16*)(ws + WS_GLU);
    const float* w_dw = p.in[5]; const float* b_dw = p.in[6]; const float* g_ln = p.in[7]; const float* b_ln = p.in[8]; const float* w_pw2 = p.in[9]; const float* b_pw2 = p.in[10];
    float u[4];
#pragma unroll
    for (int i = 0; i < 4; ++i) u[i] = b_dw[lane + 64 * i];
    for (int j = 0; j < CONVK; ++j) {
        const int ts = t - (CONVK - 1) + j; if (ts < 0) continue;
        const bf16* row = GLU + (size_t)(tok - (CONVK - 1) + j) * 512;
#pragma unroll
        for (int i = 0; i < 4; ++i) { const int c = lane + 64 * i; const float a = bf2f(row[c]), g = bf2f(row[256 + c]);
            u[i] += w_dw[j * CVW + c] * (a / (1.0f + __expf(-g))); }
    }
    float s = u[0] + u[1] + u[2] + u[3]; const float mu = wave_sum(s) * (1.f / 256.f);
    float q = 0.f;
#pragma unroll
    for (int i = 0; i < 4; ++i) { const float d = u[i] - mu; q += d * d; }
    const float rstd = 1.0f / sqrtf(wave_sum(q) * (1.f / 256.f) + EPS);
#pragma unroll
    for (int i = 0; i < 4; ++i) { const int c = lane + 64 * i; float y = (u[i] - mu) * rstd * g_ln[c] + b_ln[c]; y = y / (1.0f + __expf(-y)); act[c] = y; }
    __syncthreads();
    float o[4];
#pragma unroll
    for (int i = 0; i < 4; ++i) o[i] = b_pw2[lane + 64 * i];
    for (int c = 0; c < 256; ++c) { const float a = act[c];
#pragma unroll
        for (int i = 0; i < 4; ++i) o[i] += a * w_pw2[c * 256 + lane + 64 * i]; }
    float* O = (float*)(ws + WS_OCV) + (size_t)tok * 256;
#pragma unroll
    for (int i = 0; i < 4; ++i) O[lane + 64 * i] = o[i];
}

__global__ void __launch_bounds__(256) k_naive_cross(Ptrs p) {
    __shared__ float pr_all[4][256];
    __shared__ float qs_all[4][64];
    unsigned char* ws = p.ws;
    const int lane = threadIdx.x & 63, h = threadIdx.x >> 6;
    float* pr = pr_all[h]; float* qs = qs_all[h];
    const int tok = blockIdx.x, b = tok / S;
    const bf16* QM = (const bf16*)(ws + WS_QMX); const bf16* MK = (const bf16*)(ws + WS_MEMK); const bf16* MVT = (const bf16*)(ws + WS_MEMVT);
    qs[lane] = bf2f(QM[(size_t)tok * 256 + h * 64 + lane]);
    __syncthreads();
    float sc[4]; float mx = -1e30f;
#pragma unroll
    for (int i = 0; i < 4; ++i) { const int m = lane + 64 * i; const bf16* kr = MK + (size_t)(b * NMEM + m) * 256 + h * 64; float z = 0.f;
        for (int d = 0; d < 64; ++d) z += qs[d] * bf2f(kr[d]);
        sc[i] = z; mx = fmaxf(mx, z); }
    mx = wave_max(mx);
    float sum = 0.f;
#pragma unroll
    for (int i = 0; i < 4; ++i) { sc[i] = __expf(sc[i] - mx); sum += sc[i]; }
    sum = wave_sum(sum);
#pragma unroll
    for (int i = 0; i < 4; ++i) pr[lane + 64 * i] = sc[i] / sum;
    __syncthreads();
    const bf16* vr = MVT + (size_t)(h * 64 + lane) * TM + (size_t)b * NMEM;
    float o = 0.f;
    for (int m = 0; m < NMEM; ++m) o += pr[m] * bf2f(vr[m]);
    ((float*)(ws + WS_OMX))[(size_t)tok * 256 + h * 64 + lane] = o;
}

__global__ void __launch_bounds__(256) k_groupnorm(Ptrs p, size_t src_off, int W, int coloff) {
    unsigned char* ws = p.ws;
    const int lane = threadIdx.x & 63, tok = blockIdx.x * 4 + (threadIdx.x >> 6);
    const float* src = (const float*)(ws + src_off) + (size_t)tok * W;
    float v[8]; float s = 0.f; const int n = W / 64;
#pragma unroll
    for (int i = 0; i < 8; ++i) if (i < n) { v[i] = src[lane + 64 * i]; s += v[i] * v[i]; }
    const float rs = 1.0f / sqrtf(wave_sum(s) / (float)W + EPS);
    bf16* o = (bf16*)(ws + WS_CAT) + (size_t)tok * D + coloff;
#pragma unroll
    for (int i = 0; i < 8; ++i) if (i < n) o[lane + 64 * i] = (bf16)f2bf(v[i] * rs);
}

__global__ void __launch_bounds__(256) k_router(Ptrs p) {
    __shared__ float hrow_all[4][1024];
    unsigned char* ws = p.ws;
    const int lane = threadIdx.x & 63, wave = threadIdx.x >> 6, tok = blockIdx.x * 4 + wave;
    float* hrow = hrow_all[wave];
    const float* h = p.out + (size_t)tok * D; const float* g = p.in[17];
    const f32x4* xr = (const f32x4*)h + lane; const f32x4* gr = (const f32x4*)g + lane;
    f32x4 v[4]; float s = 0.f;
#pragma unroll
    for (int j = 0; j < 4; ++j) { v[j] = xr[64 * j]; s += (v[j].x * v[j].x + v[j].y * v[j].y) + (v[j].z * v[j].z + v[j].w * v[j].w); }
    const float rs = 1.0f / sqrtf(wave_sum(s) * (1.f / D) + EPS);
    unsigned long long* o8 = (unsigned long long*)((bf16*)(ws + WS_HN) + (size_t)tok * D) + lane;
#pragma unroll
    for (int j = 0; j < 4; ++j) { const f32x4 gg = gr[64 * j]; f32x4 y; y.x = v[j].x * rs * gg.x; y.y = v[j].y * rs * gg.y; y.z = v[j].z * rs * gg.z; y.w = v[j].w * rs * gg.w;
        o8[64 * j] = (unsigned long long)pk2(y.x, y.y) | ((unsigned long long)pk2(y.z, y.w) << 32);
        *(f32x4*)(hrow + 4 * lane + 256 * j) = y; }
    __syncthreads();
    const int e = lane & 31, hf = lane >> 5; const float* wr = p.in[18];
    float acc = 0.f;
    for (int k = hf * 512; k < hf * 512 + 512; ++k) acc += hrow[k] * wr[k * NE + e];
    acc += __shfl_xor(acc, 32);
    float logit = acc + p.in[19][e];
    int my_e = 0; float my_v = 0.f, m0 = 0.f;
#pragma unroll
    for (int k = 0; k < 4; ++k) {
        const float m = wave_max(logit);
        const unsigned long long bal = __ballot(logit == m);
        const int idx = (int)(__ffsll((long long)bal) - 1) & 31;
        if (lane == k) { my_e = idx; my_v = m; }
        if (k == 0) m0 = m;
        if (e == idx) logit = -3.0e38f;
    }
    const float exv = (lane < 4) ? __expf(my_v - m0) : 0.f;
    const float es = __shfl(exv, 0) + __shfl(exv, 1) + __shfl(exv, 2) + __shfl(exv, 3);
    if (lane < 4) {
        const int ee = my_e; const float gv = exv;
        const unsigned slot = atomicAdd((unsigned*)(ws + WS_CTL) + CW_CNT + ee, 1u);
        ((int*)(ws + WS_LIST))[(size_t)ee * T + slot] = tok;
        ((int*)(ws + WS_TOKE))[tok * 4 + lane] = ee;
        ((int*)(ws + WS_TOKS))[tok * 4 + lane] = (int)slot;
        ((float*)(ws + WS_TOKG))[tok * 4 + lane] = gv / es;
    }
}

__global__ void __launch_bounds__(256) k_final(Ptrs p) {
    unsigned char* ws = p.ws;
    const int lane = threadIdx.x & 63, tok = blockIdx.x * 4 + (threadIdx.x >> 6);
    const unsigned* cnt = (const unsigned*)(ws + WS_CTL) + CW_CNT;
    float* h = p.out + (size_t)tok * D;
    f32x4 v[4];
#pragma unroll
    for (int j = 0; j < 4; ++j) v[j] = ((const f32x4*)h)[lane + 64 * j];
    for (int k = 0; k < 4; ++k) {
        const int e = ((const int*)(ws + WS_TOKE))[tok * 4 + k], slot = ((const int*)(ws + WS_TOKS))[tok * 4 + k]; const float gt = ((const float*)(ws + WS_TOKG))[tok * 4 + k];
        int c, ps; moe_prefix(cnt, e, c, ps);
        const unsigned long long* y8 = (const unsigned long long*)((const bf16*)(ws + WS_Y) + (size_t)(ps + slot) * 1024) + lane;
#pragma unroll
        for (int j = 0; j < 4; ++j) { const unsigned long long w = y8[64 * j]; const unsigned lo = (unsigned)w, hi = (unsigned)(w >> 32);
            v[j].x += gt * bf2f(lo & 0xffffu); v[j].y += gt * bf2f(lo >> 16); v[j].z += gt * bf2f(hi & 0xffffu); v[j].w += gt * bf2f(hi >> 16); }
    }
    float s = 0.f;
#pragma unroll
    for (int j = 0; j < 4; ++j) s += (v[j].x * v[j].x + v[j].y * v[j].y) + (v[j].z * v[j].z + v[j].w * v[j].w);
    const float rs = 1.0f / sqrtf(wave_sum(s) * (1.f / D) + EPS);
    const f32x4* gr = (const f32x4*)p.in[24] + lane;
#pragma unroll
    for (int j = 0; j < 4; ++j) { const f32x4 gg = gr[64 * j]; f32x4 y; y.x = v[j].x * rs * gg.x; y.y = v[j].y * rs * gg.y; y.z = v[j].z * rs * gg.z; y.w = v[j].w * rs * gg.w; ((f32x4*)h)[lane + 64 * j] = y; }
}


#define LAS __attribute__((address_space(3)))
typedef short bf16x8 __attribute__((ext_vector_type(8)));
typedef unsigned u32x4 __attribute__((ext_vector_type(4)));
typedef int v4i __attribute__((ext_vector_type(4)));
typedef int v8i __attribute__((ext_vector_type(8)));
namespace pg {
constexpr int BM = 256, BK = 64, HALF = 128, HTB = HALF * BK * 2, STAGE_BYTES = 8 * HTB, GK = 1024;
__host__ __device__ __forceinline__ int lds_byte(int r, int c) { const int st = (r >> 4) * 2 + (c >> 5), rr = r & 15, cc = c & 31, ob = rr * 64 + cc * 2; return st * 1024 + (ob ^ (((ob >> 9) & 1) << 5)); }
__host__ __device__ __forceinline__ void stage_rc(int b, int& R, int& C) { const int st = b / 1024, sb = b % 1024, swz = sb ^ (((sb >> 9) & 1) << 5); R = (st >> 1) * 16 + swz / 64; C = (st & 1) * 32 + (swz % 64) / 2; }
__host__ __device__ __forceinline__ int perm32(int rho) { const int n = rho >> 4, i = rho & 15; return 8 * (i >> 2) + 4 * n + (i & 3); }
__device__ __forceinline__ unsigned cvt_pk_bf16(float lo, float hi) { unsigned r; asm volatile("v_cvt_pk_bf16_f32 %0, %1, %2" : "=v"(r) : "v"(lo), "v"(hi)); return r; }

struct GU {
    const char* A;
    const char* B;
    char* O;
    const float* bias;
    int ldc; float scale; int gslot; int pad;
};

struct EpiBf16 {
    static constexpr bool PERM = true;
    __device__ __forceinline__ void operator()(const f32x4 (&acc)[2][2][4][2], const GU& u, int wr, int wc, int fr, int fq) const {
        bf16* base = (bf16*)u.O + (size_t)(wr * 64 + fr) * u.ldc + wc * 32 + 8 * fq; const float sc = u.scale;
        f32x4 bv[2][2];
#pragma unroll
        for (int bj = 0; bj < 2; ++bj)
#pragma unroll
            for (int n = 0; n < 2; ++n) bv[bj][n] = u.bias ? *(const f32x4*)(u.bias + bj * HALF + wc * 32 + 8 * fq + 4 * n) : (f32x4){0.f, 0.f, 0.f, 0.f};
#pragma unroll
        for (int ai = 0; ai < 2; ++ai)
#pragma unroll
            for (int m = 0; m < 4; ++m) { bf16* rowp = base + (size_t)(ai * HALF + m * 16) * u.ldc;
#pragma unroll
                for (int bj = 0; bj < 2; ++bj) { const f32x4 v0 = acc[ai][bj][m][0] * sc + bv[bj][0], v1 = acc[ai][bj][m][1] * sc + bv[bj][1];
                    u32x4 w; w.x = cvt_pk_bf16(v0[0], v0[1]); w.y = cvt_pk_bf16(v0[2], v0[3]); w.z = cvt_pk_bf16(v1[0], v1[1]); w.w = cvt_pk_bf16(v1[2], v1[3]);
                    *(u32x4*)(rowp + bj * HALF) = w; } }
    }
};
struct EpiResid {
    static constexpr bool PERM = false;
    __device__ __forceinline__ void operator()(const f32x4 (&acc)[2][2][4][2], const GU& u, int wr, int wc, int fr, int fq) const {
        const size_t o0 = (size_t)(wr * 64 + fr) * u.ldc + wc * 32 + 4 * fq;
#pragma unroll
        for (int ai = 0; ai < 2; ++ai)
#pragma unroll
            for (int m = 0; m < 4; ++m) { const size_t o = o0 + (size_t)(ai * HALF + m * 16) * u.ldc;
#pragma unroll
                for (int bj = 0; bj < 2; ++bj)
#pragma unroll
                    for (int n = 0; n < 2; ++n) *(f32x4*)((float*)u.O + o + bj * HALF + n * 16) = *(const f32x4*)(u.bias + o + bj * HALF + n * 16) + acc[ai][bj][m][n]; }
    }
};
struct EpiSwiGLU {
    static constexpr bool PERM = true;
    __device__ __forceinline__ void operator()(const f32x4 (&acc)[2][2][4][2], const GU& u, int wr, int wc, int fr, int fq) const {
        unsigned char* base = (unsigned char*)u.O + (size_t)(wr * 64 + fr) * u.ldc + wc * 32 + 8 * fq; const float sc = u.scale;
        f32x4 bg[2], bu[2];
#pragma unroll
        for (int n = 0; n < 2; ++n) { bg[n] = *(const f32x4*)(u.bias + wc * 32 + 8 * fq + 4 * n); bu[n] = *(const f32x4*)(u.bias + 1024 + wc * 32 + 8 * fq + 4 * n); }
#pragma unroll
        for (int ai = 0; ai < 2; ++ai)
#pragma unroll
            for (int m = 0; m < 4; ++m) { unsigned char* rowp = base + (size_t)(ai * HALF + m * 16) * u.ldc; float h[8];
#pragma unroll
                for (int n = 0; n < 2; ++n)
#pragma unroll
                    for (int j = 0; j < 4; ++j) { float g = acc[ai][0][m][n][j] * sc + bg[n][j], up = acc[ai][1][m][n][j] * sc + bu[n][j];
                        g = fminf(g, 7.0f); up = fminf(fmaxf(up, -7.0f), 7.0f);
                        h[4 * n + j] = (up + 1.0f) * (g * __builtin_amdgcn_rcpf(1.0f + __builtin_amdgcn_exp2f(-1.702f * 1.44269504f * g))); }
                int w0 = 0, w1 = 0;
                w0 = __builtin_amdgcn_cvt_pk_fp8_f32(h[0], h[1], w0, false); w0 = __builtin_amdgcn_cvt_pk_fp8_f32(h[2], h[3], w0, true);
                w1 = __builtin_amdgcn_cvt_pk_fp8_f32(h[4], h[5], w1, false); w1 = __builtin_amdgcn_cvt_pk_fp8_f32(h[6], h[7], w1, true);
                *(unsigned long long*)rowp = (unsigned long long)(unsigned)w0 | ((unsigned long long)(unsigned)w1 << 32); }
    }
};

template <class Epi, class Sched, bool GATHER, bool FP8>
__device__ __forceinline__ void gemm_phase(LAS unsigned char* lds, const Sched& S, const Epi& E, const LAS unsigned* gtab) {
    const int tid = threadIdx.x, wid = __builtin_amdgcn_readfirstlane(tid >> 6), lane = tid & 63, wr = wid >> 2, wc = wid & 3, fr = lane & 15, fq = lane >> 4;
    constexpr int PITCH = FP8 ? GK : GK * 2, nt = FP8 ? GK / 128 : GK / BK;
    unsigned voffB[2]; int Rr[2], Cc2[2];
#pragma unroll
    for (int i = 0; i < 2; ++i) { int R, C; stage_rc(tid * 16 + i * 8192, R, C); const int Rb = Epi::PERM ? ((R & ~31) + perm32(R & 31)) : R;
        voffB[i] = (unsigned)(Rb * PITCH + C * 2); Rr[i] = R; Cc2[i] = C * 2; }
    constexpr size_t kstep = (size_t)(BK * 2);
    constexpr size_t hstep = (size_t)HALF * PITCH;
    const unsigned ldsw = (unsigned)wid * 1024u;
    const int aoff = lds_byte(wr * 64 + fr, fq * 8);
    unsigned boffv = (unsigned)(size_t)lds + 4 * HTB + lds_byte(wc * 32 + fr, fq * 8);
    asm volatile("" : "+v"(boffv));
#define PG_SA(b, h) (((b) * 2 + (h)) * HTB)
#define PG_SB(b, h) ((4 + (b) * 2 + (h)) * HTB)
#define PG_STAGE(bufoff, gbase, voff) do { _Pragma("unroll") for (int _i = 0; _i < 2; ++_i) \
        __builtin_amdgcn_global_load_lds((const unsigned*)((const char*)(gbase) + (voff)[_i]), (LAS unsigned*)(lds + (bufoff) + ldsw + _i * 8192), 16, 0, 0); } while (0)
#define PG_RD16(off) (*(const LAS v4i*)(lds + (off)))
#define PG_LDA(dst, b, h) do { _Pragma("unroll") for (int m = 0; m < 4; ++m) dst[m] = __builtin_shufflevector(PG_RD16(PG_SA(b, h) + aoff + m * 2048), PG_RD16(PG_SA(b, h) + aoff + m * 2048 + 1024), 0, 1, 2, 3, 4, 5, 6, 7); } while (0)
#define PG_RDB16(off) (*(const LAS v4i*)((LAS unsigned char*)(size_t)boffv + (off)))
#define PG_LDB(dst, b, h) do { _Pragma("unroll") for (int n = 0; n < 2; ++n) dst[n] = __builtin_shufflevector(PG_RDB16(((b) * 2 + (h)) * HTB + n * 2048), PG_RDB16(((b) * 2 + (h)) * HTB + n * 2048 + 1024), 0, 1, 2, 3, 4, 5, 6, 7); } while (0)
#define PG_LO(x) __builtin_bit_cast(bf16x8, __builtin_shufflevector((x), (x), 0, 1, 2, 3))
#define PG_HI(x) __builtin_bit_cast(bf16x8, __builtin_shufflevector((x), (x), 4, 5, 6, 7))
#define PG_MMA(ai, bj, At, Bt) do { __builtin_amdgcn_s_setprio(1); _Pragma("unroll") for (int m = 0; m < 4; ++m) _Pragma("unroll") for (int n = 0; n < 2; ++n) { \
        if constexpr (FP8) { asm volatile("v_mfma_scale_f32_16x16x128_f8f6f4 %0, %1, %2, %0, %3, %3 op_sel_hi:[0,0,0]" : "+v"(acc[ai][bj][m][n]) : "v"(Bt[n]), "v"(At[m]), "v"(sc1)); } \
        else { acc[ai][bj][m][n] = __builtin_amdgcn_mfma_f32_16x16x32_bf16(PG_LO(Bt[n]), PG_LO(At[m]), acc[ai][bj][m][n], 0, 0, 0); \
               acc[ai][bj][m][n] = __builtin_amdgcn_mfma_f32_16x16x32_bf16(PG_HI(Bt[n]), PG_HI(At[m]), acc[ai][bj][m][n], 0, 0, 0); } } \
        __builtin_amdgcn_s_setprio(0); } while (0)
#define PG_WAIT_V(n) asm volatile("s_waitcnt vmcnt(" #n ")" ::: "memory")
#define PG_WAIT_L(n) asm volatile("s_waitcnt lgkmcnt(" #n ")" ::: "memory")
#define PG_BAR __builtin_amdgcn_s_barrier()
#define PG_SCHED __builtin_amdgcn_sched_barrier(0)
#define PG_LOADVO(vo, u) do { _Pragma("unroll") for (int _h = 0; _h < 2; ++_h) _Pragma("unroll") for (int _i = 0; _i < 2; ++_i) \
        vo[_h][_i] = GATHER ? (gtab[(u).gslot * 256 + _h * HALF + Rr[_i]] + (unsigned)Cc2[_i]) : (unsigned)((_h * HALF + Rr[_i]) * PITCH + Cc2[_i]); } while (0)
    int sc1 = 0x7f7f7f7f; asm volatile("" : "+v"(sc1));
    GU cur, nxt; int ui = 0;
    if (!S.next(0, cur)) return;
    f32x4 acc[2][2][4][2];
#pragma unroll
    for (int a = 0; a < 2; ++a)
#pragma unroll
        for (int b = 0; b < 2; ++b)
#pragma unroll
            for (int m = 0; m < 4; ++m)
#pragma unroll
                for (int n = 0; n < 2; ++n) acc[a][b][m][n] = (f32x4){0.f, 0.f, 0.f, 0.f};
    v8i At[4], B0[2], B1[2];
    unsigned cvo[2][2], nvo[2][2];
    PG_LOADVO(cvo, cur);
    const char* cA = cur.A; const char* cB = cur.B;
    PG_STAGE(PG_SB(0, 0), cB, voffB); PG_STAGE(PG_SB(0, 1), cB + hstep, voffB); PG_STAGE(PG_SA(0, 0), cA, cvo[0]); PG_STAGE(PG_SA(0, 1), cA, cvo[1]);
    if (wr == 1) PG_BAR;
    PG_WAIT_V(2); PG_BAR;
    PG_STAGE(PG_SB(1, 0), cB + kstep, voffB); PG_STAGE(PG_SA(1, 0), cA + kstep, cvo[0]); PG_STAGE(PG_SB(1, 1), cB + hstep + kstep, voffB);
    PG_WAIT_V(6); PG_BAR;
    for (;;) {
        const bool has_next = S.next(ui + 1, nxt);
        const char* nA = has_next ? nxt.A : cA; const char* nB = has_next ? nxt.B : cB;
        if (GATHER) { if (has_next) { PG_LOADVO(nvo, nxt); } else {
#pragma unroll
            for (int h = 0; h < 2; ++h)
#pragma unroll
                for (int i = 0; i < 2; ++i) nvo[h][i] = cvo[h][i]; } }
#pragma unroll 1
        for (int t = 0; t < nt; t += 2) {
            const bool last = (t == nt - 2);
            const char* a1 = cA + (size_t)(t + 1) * kstep;
            const char* a2 = last ? nA : cA + (size_t)(t + 2) * kstep; const char* b2 = last ? nB : cB + (size_t)(t + 2) * kstep;
            const char* a3 = a2 + kstep; const char* b3 = b2 + kstep;
            unsigned vo2[2][2];
#pragma unroll
            for (int h = 0; h < 2; ++h)
#pragma unroll
                for (int i = 0; i < 2; ++i) vo2[h][i] = (GATHER && last) ? nvo[h][i] : cvo[h][i];
            PG_LDB(B0, 0, 0); PG_LDB(B1, 0, 1); PG_SCHED; PG_LDA(At, 0, 0); PG_STAGE(PG_SA(1, 1), a1, cvo[1]);
            PG_WAIT_V(8); PG_WAIT_L(0); PG_BAR; PG_MMA(0, 0, At, B0); PG_MMA(0, 1, At, B1); PG_BAR; PG_SCHED;
            PG_LDA(At, 0, 1); PG_STAGE(PG_SB(0, 0), b2, voffB); PG_STAGE(PG_SB(0, 1), b2 + hstep, voffB); PG_STAGE(PG_SA(0, 0), a2, vo2[0]);
            PG_WAIT_V(8); PG_WAIT_L(0); PG_BAR; PG_MMA(1, 0, At, B0); PG_MMA(1, 1, At, B1); PG_BAR; PG_SCHED;
            PG_LDB(B0, 1, 0); PG_LDB(B1, 1, 1); PG_SCHED; PG_LDA(At, 1, 0); PG_STAGE(PG_SA(0, 1), a2, vo2[1]);
            PG_WAIT_V(8); PG_WAIT_L(0); PG_BAR; PG_MMA(0, 0, At, B0); PG_MMA(0, 1, At, B1); PG_BAR; PG_SCHED;
            PG_LDA(At, 1, 1); PG_STAGE(PG_SB(1, 0), b3, voffB); PG_STAGE(PG_SB(1, 1), b3 + hstep, voffB); PG_STAGE(PG_SA(1, 0), a3, vo2[0]);
            PG_WAIT_V(8); PG_WAIT_L(0); PG_BAR; PG_MMA(1, 0, At, B0); PG_MMA(1, 1, At, B1); PG_BAR; PG_SCHED;
        }
        if (wr == 0) PG_BAR;
        if constexpr (FP8) { asm volatile("s_nop 15\n\ts_nop 15" ::: "memory"); }
        E(acc, cur, wr, wc, fr, fq);
        if (!has_next) break;
#pragma unroll
        for (int a = 0; a < 2; ++a)
#pragma unroll
            for (int b = 0; b < 2; ++b)
#pragma unroll
                for (int m = 0; m < 4; ++m)
#pragma unroll
                    for (int n = 0; n < 2; ++n) acc[a][b][m][n] = (f32x4){0.f, 0.f, 0.f, 0.f};
        cur = nxt; cA = nA; cB = nB; ++ui;
        if (GATHER) {
#pragma unroll
            for (int h = 0; h < 2; ++h)
#pragma unroll
                for (int i = 0; i < 2; ++i) cvo[h][i] = nvo[h][i]; }
        if (wr == 1) PG_BAR;
    }
    PG_WAIT_V(0);
    PG_BAR;
#undef PG_SA
#undef PG_SB
#undef PG_STAGE
#undef PG_LDA
#undef PG_RD16
#undef PG_RDB16
#undef PG_LO
#undef PG_HI
#undef PG_LDB
#undef PG_MMA
#undef PG_WAIT_V
#undef PG_WAIT_L
#undef PG_BAR
#undef PG_SCHED
#undef PG_LOADVO
}
}

constexpr int NWAVES = 8;
constexpr int RING_OFF = 0, RING_BYTES = 131072;
constexpr int GTAB_OFF = RING_BYTES, GTAB_BYTES = 18 * 1024;
constexpr int UTAB_OFF = GTAB_OFF + GTAB_BYTES, UTAB_BYTES = 1024;
constexpr int MISC_OFF = UTAB_OFF + UTAB_BYTES;
constexpr int LDS_BYTES = MISC_OFF + 512;
static_assert(LDS_BYTES <= 160 * 1024, "LDS");

#ifndef REP_PHASE
#define REP_PHASE -1
#endif
#define NREP(k) ((REP_PHASE) == (k) ? 2 : 1)
struct MKArgs { Ptrs p; int ph_lo, ph_hi, li, pad; };

#define XB_TMO      128
#define XB_XCNT(j)  (256  + 64 * (j))
#define XB_XSUB(j)  (1280 + 64 * (j))
#define XB_XGEN(j)  (2304 + 64 * (j))
#define XB_TOP      3328
#define XB_TOPGEN   3392
#define XCD_BAR_WORDS 3456
#define XB_SPIN_CAP (1u << 18)
__device__ __forceinline__ unsigned xb_ld(unsigned* p)              { return __hip_atomic_load(p, __ATOMIC_RELAXED, __HIP_MEMORY_SCOPE_AGENT); }
__device__ __forceinline__ unsigned xb_add(unsigned* p, unsigned v) { return __hip_atomic_fetch_add(p, v, __ATOMIC_RELAXED, __HIP_MEMORY_SCOPE_AGENT); }
__device__ __forceinline__ unsigned xb_xcc_id() { return (unsigned)__builtin_amdgcn_s_getreg((3 << 11) | 20) & 0xFu; }
#define XB_SPIN(cond, bar) do { unsigned _sp = 0; while (cond) { __builtin_amdgcn_s_sleep(1); \
    if ((++_sp & 255u) == 0u) { if (xb_ld(&(bar)[XB_TMO])) break; if (_sp > XB_SPIN_CAP) { atomicAdd(&(bar)[XB_TMO], 1u); break; } } } } while (0)
struct XcdBarrier { unsigned* bar; unsigned x; volatile LAS unsigned* st; };
__device__ __forceinline__ XcdBarrier xcd_barrier_post(unsigned* bar, volatile LAS unsigned* st) {
    XcdBarrier b; b.bar = bar; b.x = xb_xcc_id(); b.st = st;
    if (threadIdx.x == 0) (void)xb_add(&bar[XB_XCNT(b.x)], 1u);
    return b;
}
__device__ __forceinline__ void xcd_barrier_complete(unsigned* bar, unsigned x, unsigned& nloc, unsigned& nx) {
    const unsigned G = gridDim.x * gridDim.y * gridDim.z;
    unsigned sum, cnt, mine, sp = 0u;
    for (;;) {
        sum = 0u; cnt = 0u; mine = 0u;
#pragma unroll
        for (unsigned j = 0; j < 16; ++j) { const unsigned c = xb_ld(&bar[XB_XCNT(j)]); sum += c; cnt += (c > 0u) ? 1u : 0u; mine = (j == x) ? c : mine; }
        if (sum == G) break;
        __builtin_amdgcn_s_sleep(1);
        if ((++sp & 255u) == 0u) { if (xb_ld(&bar[XB_TMO])) break; if (sp > XB_SPIN_CAP) { atomicAdd(&bar[XB_TMO], 1u); break; } }
    }
    nloc = mine > 0u ? mine : 1u; nx = cnt > 0u ? cnt : 1u;
}
__device__ __forceinline__ void xcd_barrier(const XcdBarrier& b) {
    asm volatile("s_waitcnt vmcnt(0)" ::: "memory");
    __syncthreads();
    if (threadIdx.x == 0) {
        unsigned* bar = b.bar;
        __builtin_amdgcn_s_waitcnt(0);
        unsigned nloc = b.st[0], nx = b.st[1];
        if (nloc == 0u) { xcd_barrier_complete(bar, b.x, nloc, nx); b.st[0] = nloc; b.st[1] = nx; }
        const unsigned old = xb_add(&bar[XB_XSUB(b.x)], 1u);
        const unsigned gen = old / nloc;
        if (old + 1u == (gen + 1u) * nloc) {
            __builtin_amdgcn_fence(__ATOMIC_RELEASE, "agent");
            asm volatile("s_waitcnt vmcnt(0)" ::: "memory");
            const unsigned og = xb_add(&bar[XB_TOP], 1u);
            const unsigned tg = og / nx;
            if (og + 1u == (tg + 1u) * nx) xb_add(&bar[XB_TOPGEN], 1u);
            else XB_SPIN(xb_ld(&bar[XB_TOPGEN]) == tg, bar);
            __builtin_amdgcn_fence(__ATOMIC_ACQUIRE, "agent");
            xb_add(&bar[XB_XGEN(b.x)], 1u);
            asm volatile("s_waitcnt vmcnt(0)" ::: "memory");
        } else {
            XB_SPIN(xb_ld(&bar[XB_XGEN(b.x)]) == gen, bar);
            __builtin_amdgcn_fence(__ATOMIC_ACQUIRE, "agent");
            asm volatile("s_waitcnt vmcnt(0)" ::: "memory");
        }
    }
    __syncthreads();
}
constexpr int CW_BAR = 4096;

struct SchedP1 {
    int G, c; unsigned char* ws; const float* b_glu;
    static constexpr int N_A = 128 * 7, N_B = 256, N_C = 32, NU = N_A + N_B + N_C;
    __device__ __forceinline__ bool next(int i, pg::GU& u) const {
        const int L = i * G + c; if (L >= NU) return false;
        u.bias = nullptr; u.scale = 1.0f; u.gslot = 0; u.pad = 0;
        if (L < N_A) { const int pm = L / 7, pn = L % 7;
            u.A = (const char*)(ws + WS_XN) + (size_t)pm * 256 * 2048;
            const int brow = pn < 4 ? 256 * pn : 256 * (pn + 2); u.B = (const char*)(ws + WS_WIN) + (size_t)brow * 2048;
            if (pn < 2) { u.O = (char*)(ws + WS_Q) + ((size_t)pm * 256 * 512 + pn * 256) * 2; u.ldc = 512; u.scale = 0.125f; }
            else if (pn < 4) { u.O = (char*)(ws + WS_K) + ((size_t)pm * 256 * 512 + (pn - 2) * 256) * 2; u.ldc = 512; }
            else if (pn < 6) { u.O = (char*)(ws + WS_GLU) + ((size_t)pm * 256 * 512 + (pn - 4) * 256) * 2; u.ldc = 512; u.bias = b_glu + (pn - 4) * 256; }
            else { u.O = (char*)(ws + WS_QMX) + ((size_t)pm * 256 * 256) * 2; u.ldc = 256; u.scale = 0.125f; }
        } else if (L < N_A + N_B) { const int q = L - N_A, pn = q >> 1, pm = q & 1;
            u.A = (const char*)(ws + WS_WIN) + (size_t)(1024 + 256 * pm) * 2048; u.B = (const char*)(ws + WS_XN) + (size_t)pn * 256 * 2048;
            u.O = (char*)(ws + WS_VT) + ((size_t)(256 * pm) * T + 256 * pn) * 2; u.ldc = T;
        } else { int q = L - N_A - N_B;
            if (q < 16) { u.A = (const char*)(ws + WS_MEMN) + (size_t)q * 256 * 2048; u.B = (const char*)(ws + WS_WMKV); u.O = (char*)(ws + WS_MEMK) + (size_t)q * 256 * 256 * 2; u.ldc = 256; }
            else { q -= 16; u.A = (const char*)(ws + WS_WMKV) + (size_t)256 * 2048; u.B = (const char*)(ws + WS_MEMN) + (size_t)q * 256 * 2048; u.O = (char*)(ws + WS_MEMVT) + (size_t)q * 256 * 2; u.ldc = TM; }
        }
        return true;
    }
};

struct SchedP3 {
    int G, c; unsigned char* ws; const float* x; float* out;
    __device__ __forceinline__ bool next(int i, pg::GU& u) const {
        const int L = i * G + c; if (L >= 512) return false;
        const int pm = L >> 2, pn = L & 3;
        u.A = (const char*)(ws + WS_CAT) + (size_t)pm * 256 * 2048; u.B = (const char*)(ws + WS_WOUT) + (size_t)pn * 256 * 2048;
        const size_t o = (size_t)pm * 256 * 1024 + pn * 256; u.O = (char*)(out + o); u.bias = x + o; u.ldc = 1024; u.scale = 1.0f; u.gslot = 0; u.pad = 0;
        return true;
    }
};
constexpr int UT_CNT = 0, UT_PST = 32, UT_UST = 64, UT_TOT = 96, UT_UNIT = 128, MAXU = 18;
template <int NPN>
__device__ __forceinline__ void moe_tables(LAS int* ut, const unsigned* cnt, int G, int vcu, int tid) {
    if (tid < 64) {
        const int c = tid < 32 ? (int)cnt[tid] : 0; const int np = (c + 255) >> 8;
        int incl = np;
#pragma unroll
        for (int o = 1; o < 32; o <<= 1) { const int v = __shfl_up(incl, o); if ((tid & 63) >= o) incl += v; }
        const int excl = incl - np;
        if (tid < 32) { ut[UT_CNT + tid] = c; ut[UT_PST + tid] = excl * 256; ut[UT_UST + tid] = excl * NPN; }
        if (tid == 31) ut[UT_TOT] = incl * NPN;
    }
    __syncthreads();
    if (tid < MAXU) {
        const int L = tid * G + vcu, U = ut[UT_TOT];
        int e = -1;
        if (L < U) { e = 0; for (int j = 1; j < 32; ++j) if (ut[UT_UST + j] <= L) e = j; }
        const int q = e >= 0 ? L - ut[UT_UST + e] : 0;
        ut[UT_UNIT + 4 * tid + 0] = e; ut[UT_UNIT + 4 * tid + 1] = q / NPN; ut[UT_UNIT + 4 * tid + 2] = q % NPN; ut[UT_UNIT + 4 * tid + 3] = e >= 0 ? ut[UT_PST + e] : 0;
    }
    __syncthreads();
}
struct SchedGU {
    const LAS int* ut; unsigned char* ws; const float* b_gu;
    __device__ __forceinline__ bool next(int i, pg::GU& u) const {
        if (i >= MAXU) return false;
        const int e = __builtin_amdgcn_readfirstlane(ut[UT_UNIT + 4 * i]); if (e < 0) return false;
        const int panel = __builtin_amdgcn_readfirstlane(ut[UT_UNIT + 4 * i + 1]), pn = __builtin_amdgcn_readfirstlane(ut[UT_UNIT + 4 * i + 2]), pst = __builtin_amdgcn_readfirstlane(ut[UT_UNIT + 4 * i + 3]);
        u.A = (const char*)(ws + WS_HN); u.B = (const char*)(ws + WS_WGU) + ((size_t)e * 2048 + pn * 256) * 1024;
        u.O = (char*)(ws + WS_HACT) + ((size_t)(pst + panel * 256) * 1024 + pn * 128); u.bias = b_gu + (size_t)e * 2048 + pn * 128; u.ldc = 1024; u.scale = 1.0f / W8_SCALE; u.gslot = i; u.pad = 0;
        return true;
    }
};
struct SchedDN {
    const LAS int* ut; unsigned char* ws; const float* b_dn;
    __device__ __forceinline__ bool next(int i, pg::GU& u) const {
        if (i >= MAXU) return false;
        const int e = __builtin_amdgcn_readfirstlane(ut[UT_UNIT + 4 * i]); if (e < 0) return false;
        const int panel = __builtin_amdgcn_readfirstlane(ut[UT_UNIT + 4 * i + 1]), pn = __builtin_amdgcn_readfirstlane(ut[UT_UNIT + 4 * i + 2]), pst = __builtin_amdgcn_readfirstlane(ut[UT_UNIT + 4 * i + 3]);
        u.A = (const char*)(ws + WS_HACT) + (size_t)(pst + panel * 256) * 1024; u.B = (const char*)(ws + WS_WDN) + ((size_t)e * 1024 + pn * 256) * 1024;
        u.O = (char*)(ws + WS_Y) + ((size_t)(pst + panel * 256) * 1024 + pn * 256) * 2; u.bias = b_dn + (size_t)e * 1024 + pn * 256; u.ldc = 1024; u.scale = 1.0f / W8_SCALE; u.gslot = 0; u.pad = 0;
        return true;
    }
};

typedef float f32x16 __attribute__((ext_vector_type(16)));
typedef short s16x4 __attribute__((ext_vector_type(4)));
#define MFMA32(a, b, c) __builtin_amdgcn_mfma_f32_32x32x16_bf16((a), (b), (c), 0, 0, 0)
__device__ __forceinline__ bf16x8 pack8(float a0, float a1, float a2, float a3, float a4, float a5, float a6, float a7) {
    u32x4 p; p.x = pg::cvt_pk_bf16(a0, a1); p.y = pg::cvt_pk_bf16(a2, a3); p.z = pg::cvt_pk_bf16(a4, a5); p.w = pg::cvt_pk_bf16(a6, a7);
    return __builtin_bit_cast(bf16x8, p);
}
__device__ __forceinline__ bf16x8 load_vt_frag(const bf16* rowp, int h) {
    const s16x4 lo = *(const s16x4*)(rowp + 4 * h), hi = *(const s16x4*)(rowp + 8 + 4 * h);
    return __builtin_shufflevector(lo, hi, 0, 1, 2, 3, 4, 5, 6, 7);
}
__device__ __forceinline__ void sb_unit(unsigned char* ws, LAS unsigned char* lds, int unit, int wave, int lane) {
    const int b = unit >> 5, t0 = (unit & 31) * 64, hd = wave, r = lane & 31, h = lane >> 5;
    const size_t tb = (size_t)b * S;
    const bf16* Q = (const bf16*)(ws + WS_Q); const bf16* Kp = (const bf16*)(ws + WS_K); const bf16* VT = (const bf16*)(ws + WS_VT);
    bf16x8 qf[2][4];
#pragma unroll
    for (int ni = 0; ni < 2; ++ni)
#pragma unroll
        for (int kk = 0; kk < 4; ++kk) qf[ni][kk] = *(const bf16x8*)(Q + (tb + t0 + 32 * ni + r) * 512 + hd * 64 + 16 * kk + 8 * h);
    f32x16 oacc[2][2];
#pragma unroll
    for (int di = 0; di < 2; ++di)
#pragma unroll
        for (int ni = 0; ni < 2; ++ni)
#pragma unroll
            for (int i = 0; i < 16; ++i) oacc[di][ni][i] = 0.f;
    float carry[2] = {0.f, 0.f};
    for (int s0 = t0 + 32; s0 >= 0; s0 -= 32) {
        bf16x8 kf[4];
#pragma unroll
        for (int kk = 0; kk < 4; ++kk) kf[kk] = *(const bf16x8*)(Kp + (tb + s0 + r) * 512 + hd * 64 + 16 * kk + 8 * h);
        bf16x8 vf[2][2];
#pragma unroll
        for (int di = 0; di < 2; ++di)
#pragma unroll
            for (int ks = 0; ks < 2; ++ks) vf[di][ks] = load_vt_frag(VT + (size_t)(hd * 64 + 32 * di + r) * T + tb + s0 + 16 * ks, h);
        const bool diag = (s0 + 31 >= t0);
        bf16x8 pf[2][2];
#pragma unroll
        for (int ni = 0; ni < 2; ++ni) {
            f32x16 sa;
#pragma unroll
            for (int i = 0; i < 16; ++i) sa[i] = 0.f;
#pragma unroll
            for (int kk = 0; kk < 4; ++kk) sa = MFMA32(kf[kk], qf[ni][kk], sa);
            float lnb[16], lb[16];
#pragma unroll
            for (int i = 0; i < 16; ++i) {
                const float z = sa[i];
                const float l = __logf(1.0f + __expf(-fabsf(z)));
                float n_ = -(fmaxf(z, 0.f) + l), b_ = n_ + z;
                if (diag) { const int key = s0 + (i & 3) + 8 * (i >> 2) + 4 * h, tq = t0 + 32 * ni + r; if (!(key < tq)) { n_ = 0.f; b_ = -1.0e30f; } }
                lnb[i] = n_; lb[i] = b_;
            }
            float Tg[4], Pg[4];
#pragma unroll
            for (int g = 0; g < 4; ++g) { const float Gs = (lnb[4 * g] + lnb[4 * g + 1]) + (lnb[4 * g + 2] + lnb[4 * g + 3]); Pg[g] = __shfl_xor(Gs, 32); Tg[g] = Gs + Pg[g]; }
            float suf[4]; suf[3] = 0.f; suf[2] = Tg[3]; suf[1] = Tg[3] + Tg[2]; suf[0] = suf[1] + Tg[1];
            const float total = suf[0] + Tg[0];
            float av[16];
#pragma unroll
            for (int g = 0; g < 4; ++g) {
                const float base = carry[ni] + suf[g] + (h == 0 ? Pg[g] : 0.f);
                const float a3 = base, a2 = a3 + lnb[4 * g + 3], a1 = a2 + lnb[4 * g + 2], a0 = a1 + lnb[4 * g + 1];
                av[4 * g + 3] = __expf(lb[4 * g + 3] + a3); av[4 * g + 2] = __expf(lb[4 * g + 2] + a2); av[4 * g + 1] = __expf(lb[4 * g + 1] + a1); av[4 * g] = __expf(lb[4 * g] + a0);
            }
            carry[ni] += total;
            pf[ni][0] = pack8(av[0], av[1], av[2], av[3], av[4], av[5], av[6], av[7]);
            pf[ni][1] = pack8(av[8], av[9], av[10], av[11], av[12], av[13], av[14], av[15]);
        }
#pragma unroll
        for (int di = 0; di < 2; ++di)
#pragma unroll
            for (int ni = 0; ni < 2; ++ni)
#pragma unroll
                for (int ks = 0; ks < 2; ++ks) oacc[di][ni] = MFMA32(vf[di][ks], pf[ni][ks], oacc[di][ni]);
        if (__all((carry[0] < SB_EXIT) && (carry[1] < SB_EXIT))) break;
    }
    LAS float* ssq = (LAS float*)lds;
    float ss[2];
#pragma unroll
    for (int ni = 0; ni < 2; ++ni) { float v = 0.f;
#pragma unroll
        for (int di = 0; di < 2; ++di)
#pragma unroll
            for (int i = 0; i < 16; ++i) v += oacc[di][ni][i] * oacc[di][ni][i];
        v += __shfl_xor(v, 32); ss[ni] = v;
        if (h == 0) ssq[(32 * ni + r) * 8 + hd] = v; }
    __syncthreads();
    bf16* cat = (bf16*)(ws + WS_CAT);
#pragma unroll
    for (int ni = 0; ni < 2; ++ni) {
        float tot = 0.f;
#pragma unroll
        for (int w = 0; w < 8; ++w) tot += ssq[(32 * ni + r) * 8 + w];
        const float rs = 1.0f / sqrtf(tot * (1.f / 512.f) + EPS);
        bf16* rowp = cat + (tb + t0 + 32 * ni + r) * 1024 + hd * 64 + 4 * h;
#pragma unroll
        for (int di = 0; di < 2; ++di)
#pragma unroll
            for (int g = 0; g < 4; ++g) { unsigned long long w = (unsigned long long)pg::cvt_pk_bf16(oacc[di][ni][4 * g] * rs, oacc[di][ni][4 * g + 1] * rs) | ((unsigned long long)pg::cvt_pk_bf16(oacc[di][ni][4 * g + 2] * rs, oacc[di][ni][4 * g + 3] * rs) << 32);
                *(unsigned long long*)(rowp + 32 * di + 8 * g) = w; }
    }
    __syncthreads();
}

__device__ __forceinline__ void mx_unit(unsigned char* ws, LAS unsigned char* lds, int unit, int wave, int lane) {
    const int b = unit >> 5, t0 = (unit & 31) * 64, hd = wave & 3, qh = wave >> 2, r = lane & 31, h = lane >> 5;
    const size_t tb = (size_t)b * S;
    const bf16* QM = (const bf16*)(ws + WS_QMX); const bf16* MK = (const bf16*)(ws + WS_MEMK); const bf16* MVT = (const bf16*)(ws + WS_MEMVT);
    bf16x8 qf[4];
#pragma unroll
    for (int kk = 0; kk < 4; ++kk) qf[kk] = *(const bf16x8*)(QM + (tb + t0 + 32 * qh + r) * 256 + hd * 64 + 16 * kk + 8 * h);
    f32x16 sa[8];
#pragma unroll
    for (int mi = 0; mi < 8; ++mi) {
#pragma unroll
        for (int i = 0; i < 16; ++i) sa[mi][i] = 0.f;
#pragma unroll
        for (int kk = 0; kk < 4; ++kk) { const bf16x8 kf = *(const bf16x8*)(MK + (size_t)(b * NMEM + 32 * mi + r) * 256 + hd * 64 + 16 * kk + 8 * h); sa[mi] = MFMA32(kf, qf[kk], sa[mi]); }
    }
    float mx = -3.0e38f;
#pragma unroll
    for (int mi = 0; mi < 8; ++mi)
#pragma unroll
        for (int i = 0; i < 16; ++i) mx = fmaxf(mx, sa[mi][i]);
    mx = fmaxf(mx, __shfl_xor(mx, 32));
    float sum = 0.f;
#pragma unroll
    for (int mi = 0; mi < 8; ++mi)
#pragma unroll
        for (int i = 0; i < 16; ++i) { const float pv = __expf(sa[mi][i] - mx); sa[mi][i] = pv; sum += pv; }
    sum += __shfl_xor(sum, 32);
    f32x16 oacc[2];
#pragma unroll
    for (int di = 0; di < 2; ++di)
#pragma unroll
        for (int i = 0; i < 16; ++i) oacc[di][i] = 0.f;
#pragma unroll
    for (int mi = 0; mi < 8; ++mi)
#pragma unroll
        for (int s2 = 0; s2 < 2; ++s2) {
            const bf16x8 pf = pack8(sa[mi][8 * s2], sa[mi][8 * s2 + 1], sa[mi][8 * s2 + 2], sa[mi][8 * s2 + 3], sa[mi][8 * s2 + 4], sa[mi][8 * s2 + 5], sa[mi][8 * s2 + 6], sa[mi][8 * s2 + 7]);
#pragma unroll
            for (int di = 0; di < 2; ++di) { const bf16x8 vf = load_vt_frag(MVT + (size_t)(hd * 64 + 32 * di + r) * TM + b * NMEM + 32 * mi + 16 * s2, h); oacc[di] = MFMA32(vf, pf, oacc[di]); }
        }
    const float inv = 1.0f / sum;
    LAS float* ssq = (LAS float*)lds;
    float v = 0.f;
#pragma unroll
    for (int di = 0; di < 2; ++di)
#pragma unroll
        for (int i = 0; i < 16; ++i) { oacc[di][i] *= inv; v += oacc[di][i] * oacc[di][i]; }
    v += __shfl_xor(v, 32);
    if (h == 0) ssq[(32 * qh + r) * 4 + hd] = v;
    __syncthreads();
    const float tot = (ssq[(32 * qh + r) * 4 + 0] + ssq[(32 * qh + r) * 4 + 1]) + (ssq[(32 * qh + r) * 4 + 2] + ssq[(32 * qh + r) * 4 + 3]);
    const float rs = 1.0f / sqrtf(tot * (1.f / 256.f) + EPS);
    bf16* rowp = (bf16*)(ws + WS_CAT) + (tb + t0 + 32 * qh + r) * 1024 + 768 + hd * 64 + 4 * h;
#pragma unroll
    for (int di = 0; di < 2; ++di)
#pragma unroll
        for (int g = 0; g < 4; ++g) { unsigned long long w = (unsigned long long)pg::cvt_pk_bf16(oacc[di][4 * g] * rs, oacc[di][4 * g + 1] * rs) | ((unsigned long long)pg::cvt_pk_bf16(oacc[di][4 * g + 2] * rs, oacc[di][4 * g + 3] * rs) << 32);
            *(unsigned long long*)(rowp + 32 * di + 8 * g) = w; }
    __syncthreads();
}

constexpr int CV_U_OFF = 0, CV_ACT_OFF = 96256, CV_ACT_PITCH = 528, CV_SSQ_OFF = 65536;
static_assert(CV_ACT_OFF + 64 * CV_ACT_PITCH <= RING_BYTES, "conv LDS");
__device__ __forceinline__ void cv_unit(const Ptrs& p, LAS unsigned char* lds, int unit, int tid, int wave, int lane) {
    unsigned char* ws = p.ws;
    const int b = unit >> 5, t0 = (unit & 31) * 64;
    const size_t tb = (size_t)b * S;
    LAS float* U = (LAS float*)(lds + CV_U_OFF);
    const bf16* GLU = (const bf16*)(ws + WS_GLU);
    for (int it = tid; it < 94 * 32; it += NWAVES * 64) {
        const int row = it >> 5, ch = (it & 31) * 8, tl = t0 - (CONVK - 1) + row;
        f32x4 u0 = (f32x4){0.f, 0.f, 0.f, 0.f}, u1 = u0;
        if (tl >= 0) {
            const v4u av = *(const v4u*)(GLU + (tb + tl) * 512 + ch), gv = *(const v4u*)(GLU + (tb + tl) * 512 + 256 + ch);
            float uu[8];
#pragma unroll
            for (int j = 0; j < 4; ++j) { const float a0 = bf2f(av[j] & 0xffffu), a1 = bf2f(av[j] >> 16), g0 = bf2f(gv[j] & 0xffffu), g1 = bf2f(gv[j] >> 16);
                uu[2 * j] = a0 / (1.0f + __expf(-g0)); uu[2 * j + 1] = a1 / (1.0f + __expf(-g1)); }
            u0 = (f32x4){uu[0], uu[1], uu[2], uu[3]}; u1 = (f32x4){uu[4], uu[5], uu[6], uu[7]};
        }
        *(LAS f32x4*)(U + row * 256 + ch) = u0; *(LAS f32x4*)(U + row * 256 + ch + 4) = u1;
    }
    __syncthreads();
    {
        const int c = tid & 255, th = tid >> 8;
        float w[CONVK], acc[32];
#pragma unroll
        for (int j = 0; j < CONVK; ++j) w[j] = p.in[5][j * CVW + c];
        const float bd = p.in[6][c];
#pragma unroll
        for (int tt = 0; tt < 32; ++tt) acc[tt] = bd;
#pragma unroll
        for (int ii = 0; ii < 62; ++ii) { const float uv = U[(32 * th + ii) * 256 + c];
#pragma unroll
            for (int tt = 0; tt < 32; ++tt) { const int j = ii - tt; if (j >= 0 && j < CONVK) acc[tt] += w[j] * uv; } }
        __syncthreads();
#pragma unroll
        for (int tt = 0; tt < 32; ++tt) U[(32 * th + tt) * 256 + c] = acc[tt];
    }
    __syncthreads();
    {
        const f32x4 gl = *(const f32x4*)(p.in[7] + 4 * lane), bl = *(const f32x4*)(p.in[8] + 4 * lane);
#pragma unroll
        for (int k = 0; k < 8; ++k) { const int tok = 8 * wave + k;
            const f32x4 x = *(const LAS f32x4*)(U + tok * 256 + 4 * lane);
            const float mu = wave_sum((x.x + x.y) + (x.z + x.w)) * (1.f / 256.f);
            const f32x4 d = x - mu;
            const float rstd = 1.0f / sqrtf(wave_sum((d.x * d.x + d.y * d.y) + (d.z * d.z + d.w * d.w)) * (1.f / 256.f) + EPS);
            f32x4 y = d * rstd * gl + bl;
            y.x = y.x / (1.0f + __expf(-y.x)); y.y = y.y / (1.0f + __expf(-y.y)); y.z = y.z / (1.0f + __expf(-y.z)); y.w = y.w / (1.0f + __expf(-y.w));
            *(LAS unsigned long long*)(lds + CV_ACT_OFF + tok * CV_ACT_PITCH + 8 * lane) = (unsigned long long)pg::cvt_pk_bf16(y.x, y.y) | ((unsigned long long)pg::cvt_pk_bf16(y.z, y.w) << 32);
        }
    }
    __syncthreads();
    {
        const int r = lane & 31, h = lane >> 5;
        const bf16* WT = (const bf16*)(ws + WS_WPW2);
        f32x16 acc[2];
#pragma unroll
        for (int ti = 0; ti < 2; ++ti)
#pragma unroll
            for (int i = 0; i < 16; ++i) acc[ti][i] = 0.f;
#pragma unroll 4
        for (int kk = 0; kk < 16; ++kk) {
            const bf16x8 af = *(const bf16x8*)(WT + (size_t)(32 * wave + r) * 256 + 16 * kk + 8 * h);
#pragma unroll
            for (int ti = 0; ti < 2; ++ti) { const bf16x8 bfr = *(const LAS bf16x8*)(lds + CV_ACT_OFF + (32 * ti + r) * CV_ACT_PITCH + (16 * kk + 8 * h) * 2); acc[ti] = MFMA32(af, bfr, acc[ti]); }
        }
        LAS float* ssq = (LAS float*)(lds + CV_SSQ_OFF);
#pragma unroll
        for (int g = 0; g < 4; ++g) { const f32x4 bb = *(const f32x4*)(p.in[10] + 32 * wave + 8 * g + 4 * h);
#pragma unroll
            for (int ti = 0; ti < 2; ++ti) { acc[ti][4 * g] += bb.x; acc[ti][4 * g + 1] += bb.y; acc[ti][4 * g + 2] += bb.z; acc[ti][4 * g + 3] += bb.w; } }
#pragma unroll
        for (int ti = 0; ti < 2; ++ti) { float v = 0.f;
#pragma unroll
            for (int i = 0; i < 16; ++i) v += acc[ti][i] * acc[ti][i];
            v += __shfl_xor(v, 32);
            if (h == 0) ssq[(32 * ti + r) * 8 + wave] = v; }
        __syncthreads();
#pragma unroll
        for (int ti = 0; ti < 2; ++ti) { float tot = 0.f;
#pragma unroll
            for (int w2 = 0; w2 < 8; ++w2) tot += ssq[(32 * ti + r) * 8 + w2];
            const float rs = 1.0f / sqrtf(tot * (1.f / 256.f) + EPS);
            bf16* rowp = (bf16*)(ws + WS_CAT) + (tb + t0 + 32 * ti + r) * 1024 + 512 + 32 * wave + 4 * h;
#pragma unroll
            for (int g = 0; g < 4; ++g) { unsigned long long wv = (unsigned long long)pg::cvt_pk_bf16(acc[ti][4 * g] * rs, acc[ti][4 * g + 1] * rs) | ((unsigned long long)pg::cvt_pk_bf16(acc[ti][4 * g + 2] * rs, acc[ti][4 * g + 3] * rs) << 32);
                *(unsigned long long*)(rowp + 8 * g) = wv; } }
    }
    __syncthreads();
}

__global__ void __launch_bounds__(NWAVES * 64, 2) mk_fwd(MKArgs a) {
    extern __shared__ __attribute__((aligned(16))) unsigned char lds_raw[];
    LAS unsigned char* lds = (LAS unsigned char*)lds_raw;
    const int tid = threadIdx.x, lane = tid & 63, wave = __builtin_amdgcn_readfirstlane(tid >> 6);
    const int G = gridDim.x; const int bx = blockIdx.x; const int vcu = (G % 8 == 0) ? (bx % 8) * (G / 8) + bx / 8 : bx;
    unsigned char* ws = a.p.ws;
    const int lo = a.ph_lo, hi = a.ph_hi;
#define IN(k) (lo <= (k) && (k) < hi)
#define BOTH(k) (IN(k) && IN((k) + 1))
    volatile LAS unsigned* misc = (volatile LAS unsigned*)(lds + MISC_OFF);
    if (tid < 4) misc[tid] = 0u;
    __syncthreads();
    XcdBarrier bar; bar.bar = (unsigned*)(ws + WS_CTL) + CW_BAR + a.li * 4096; bar.x = 0; bar.st = misc;
    if (hi - lo > 1) bar = xcd_barrier_post((unsigned*)(ws + WS_CTL) + CW_BAR + a.li * 4096, misc);
    if (IN(0)) { for (int rep = 0; rep < NREP(0); ++rep) {
        float* scr = (float*)(lds_raw + RING_OFF + wave * 16384);
        const int gw = vcu * NWAVES + wave, NGW = G * NWAVES;
        const Ptrs& p = a.p;
        constexpr int I_IN = 16 * 72, I_OUT = 16 * 32, I_MKV = 16 * 16, I_PW2 = 4 * 8, I_GU = 32 * 16 * 64, I_DN = 32 * 16 * 32;
        constexpr int NIT = I_IN + I_OUT + I_MKV + I_PW2 + I_GU + I_DN;
        for (int it = gw; it < NIT; it += NGW) {
            int r = it;
            if (r < I_IN) { const int kb = r / 72, nb = r % 72; transpose_item(p.in[3], 1024, INW, (bf16*)(ws + WS_WIN), 64 * kb, 32 * nb, 32 * nb, nullptr, scr, lane); continue; } r -= I_IN;
            if (r < I_OUT) { const int kb = r / 32, nb = r % 32; const int k0 = 64 * kb;
                const float* ks = k0 < 512 ? p.in[13] : (k0 < 768 ? p.in[14] - 512 : p.in[15] - 768);
                transpose_item(p.in[16], 1024, 1024, (bf16*)(ws + WS_WOUT), k0, 32 * nb, 32 * nb, ks, scr, lane); continue; } r -= I_OUT;
            if (r < I_MKV) { const int kb = r / 16, nb = r % 16; transpose_item(p.in[12], 1024, 512, (bf16*)(ws + WS_WMKV), 64 * kb, 32 * nb, 32 * nb, nullptr, scr, lane); continue; } r -= I_MKV;
            if (r < I_PW2) { const int kb = r / 8, nb = r % 8; transpose_item(p.in[9], 256, 256, (bf16*)(ws + WS_WPW2), 64 * kb, 32 * nb, 32 * nb, nullptr, scr, lane); continue; } r -= I_PW2;
            if (r < I_GU) { const int e = r / 1024, q = r % 1024, kb = q / 64, nb = q % 64; const int n0 = 32 * nb, isup = n0 >> 10, cc = n0 & 1023, j = cc >> 7, c = cc & 127;
                transpose_item_fp8(p.in[20] + (size_t)e * 1024 * 2048, 1024, 2048, (unsigned char*)(ws + WS_WGU) + (size_t)e * 2048 * 1024, 64 * kb, n0, 256 * j + 128 * isup + c, scr, lane); continue; } r -= I_GU;
            { const int e = r / 512, q = r % 512, kb = q / 32, nb = q % 32;
                transpose_item_fp8(p.in[22] + (size_t)e * 1024 * 1024, 1024, 1024, (unsigned char*)(ws + WS_WDN) + (size_t)e * 1024 * 1024, 64 * kb, 32 * nb, 32 * nb, scr, lane); }
        }
        for (int m = gw; m < T; m += NGW) rms_row_to_bf16(p.in[0] + (size_t)m * D, p.in[2], (bf16*)(ws + WS_XN) + (size_t)m * D, lane);
        for (int m = gw; m < TM; m += NGW) rms_row_to_bf16(p.in[1] + (size_t)m * D, p.in[11], (bf16*)(ws + WS_MEMN) + (size_t)m * D, lane);
        __syncthreads(); }
        if (BOTH(0)) xcd_barrier(bar);
    }
    if (IN(1)) {
        SchedP1 Sc{G, vcu, ws, a.p.in[4]}; pg::EpiBf16 E;
        for (int rep = 0; rep < NREP(1); ++rep) pg::gemm_phase<pg::EpiBf16, SchedP1, false, false>(lds + RING_OFF, Sc, E, nullptr);
        if (BOTH(1)) xcd_barrier(bar);
    }
    if (IN(2)) {
        constexpr int NU2 = NB * (S / 64);
        for (int u = vcu; u < NU2 * NREP(20); u += G) sb_unit(ws, lds + RING_OFF, u & (NU2 - 1), wave, lane);
        for (int u = vcu; u < NU2 * NREP(21); u += G) mx_unit(ws, lds + RING_OFF, u & (NU2 - 1), wave, lane);
        for (int u = vcu; u < NU2 * NREP(22); u += G) cv_unit(a.p, lds + RING_OFF, u & (NU2 - 1), tid, wave, lane);
        if (BOTH(2)) xcd_barrier(bar);
    }
    if (IN(3)) {
        SchedP3 Sc{G, vcu, ws, a.p.in[0], a.p.out}; pg::EpiResid E;
        for (int rep = 0; rep < NREP(3); ++rep) pg::gemm_phase<pg::EpiResid, SchedP3, false, false>(lds + RING_OFF, Sc, E, nullptr);
        if (BOTH(3)) xcd_barrier(bar);
    }
    if (IN(4)) {
#if REP_PHASE == 4
      for (int rep4 = 0; rep4 < 2; ++rep4) {
        if (rep4 == 1) { xcd_barrier(bar); if (blockIdx.x == 0 && tid < 32) __hip_atomic_store((unsigned*)(ws + WS_CTL) + CW_CNT + tid, 0u, __ATOMIC_RELAXED, __HIP_MEMORY_SCOPE_AGENT); xcd_barrier(bar); }
#else
      {
#endif
        const Ptrs& p = a.p;
        LAS float* hq = (LAS float*)(lds + RING_OFF);
        LAS float* part = (LAS float*)(lds + RING_OFF + 65536);
        LAS int* lcnt = (LAS int*)(lds + RING_OFF + 65536 + 16384);
        LAS int* pend = (LAS int*)(lds + RING_OFF + 65536 + 16384 + 256);
        const int e = lane & 31, hf = lane >> 5;
        float wreg[64];
#pragma unroll
        for (int q = 0; q < 64; ++q) wreg[q] = p.in[18][(size_t)(128 * wave + 64 * hf + q) * NE + e];
        const float bre = p.in[19][e];
        const f32x4* gr = (const f32x4*)p.in[17] + lane;
        for (int blk = vcu; blk < T / 128; blk += G) {
        if (tid < 64) lcnt[tid] = 0;
        const int tokbase = blk * 128;
        f32x4 v[2][4];
#pragma unroll
        for (int j2 = 0; j2 < 2; ++j2)
#pragma unroll
            for (int j = 0; j < 4; ++j) v[j2][j] = ((const f32x4*)(p.out + (size_t)(tokbase + 2 * wave + j2) * D))[lane + 64 * j];
        for (int bt = 0; bt < 8; ++bt) {
#pragma unroll
            for (int j2 = 0; j2 < 2; ++j2) {
                const int tl = 2 * wave + j2, tok = tokbase + 16 * bt + tl;
                float s2 = 0.f;
#pragma unroll
                for (int j = 0; j < 4; ++j) s2 += (v[j2][j].x * v[j2][j].x + v[j2][j].y * v[j2][j].y) + (v[j2][j].z * v[j2][j].z + v[j2][j].w * v[j2][j].w);
                const float rs = 1.0f / sqrtf(wave_sum(s2) * (1.f / D) + EPS);
                int* o4 = (int*)((unsigned char*)(ws + WS_HN) + (size_t)tok * D) + lane;
#pragma unroll
                for (int j = 0; j < 4; ++j) { const f32x4 gg = gr[64 * j]; f32x4 y; y.x = v[j2][j].x * rs * gg.x; y.y = v[j2][j].y * rs * gg.y; y.z = v[j2][j].z * rs * gg.z; y.w = v[j2][j].w * rs * gg.w;
                    { int w8 = 0; w8 = __builtin_amdgcn_cvt_pk_fp8_f32(y.x, y.y, w8, false); w8 = __builtin_amdgcn_cvt_pk_fp8_f32(y.z, y.w, w8, true); o4[64 * j] = w8; }
                    *(LAS f32x4*)(hq + tl * 1024 + 4 * lane + 256 * j) = y; }
            }
            __syncthreads();
            if (bt < 7) {
#pragma unroll
                for (int j2 = 0; j2 < 2; ++j2)
#pragma unroll
                    for (int j = 0; j < 4; ++j) v[j2][j] = ((const f32x4*)(p.out + (size_t)(tokbase + 16 * (bt + 1) + 2 * wave + j2) * D))[lane + 64 * j];
            }
#pragma unroll 2
            for (int t = 0; t < 16; ++t) {
                float acc = 0.f;
#pragma unroll
                for (int q = 0; q < 16; ++q) { const f32x4 hv = *(const LAS f32x4*)(hq + t * 1024 + 128 * wave + 64 * hf + 4 * q);
                    acc += hv.x * wreg[4 * q] + hv.y * wreg[4 * q + 1] + hv.z * wreg[4 * q + 2] + hv.w * wreg[4 * q + 3]; }
                acc += __shfl_xor(acc, 32);
                if (hf == 0) part[(wave * 16 + t) * 32 + e] = acc;
            }
            __syncthreads();
#pragma unroll
            for (int j2 = 0; j2 < 2; ++j2) {
                const int tl = 2 * wave + j2;
                float lg = bre;
#pragma unroll
                for (int w2 = 0; w2 < 8; ++w2) lg += part[(w2 * 16 + tl) * 32 + e];
                int my_e = 0; float my_v = 0.f, m0 = 0.f;
#pragma unroll
                for (int k = 0; k < 4; ++k) {
                    const float m = wave_max(lg);
                    const unsigned long long bal = __ballot(lg == m);
                    const int idx = (int)(__ffsll((long long)bal) - 1) & 31;
                    if (lane == k) { my_e = idx; my_v = m; }
                    if (k == 0) m0 = m;
                    if (e == idx) lg = -3.0e38f;
                }
                const float exv = (lane < 4) ? __expf(my_v - m0) : 0.f;
                const float es = __shfl(exv, 0) + __shfl(exv, 1) + __shfl(exv, 2) + __shfl(exv, 3);
                if (lane < 4) {
                    const int rank = atomicAdd((int*)(lcnt + my_e), 1);
                    LAS int* pe = pend + ((16 * bt + tl) * 4 + lane) * 3;
                    pe[0] = my_e; pe[1] = rank; pe[2] = __float_as_int(exv / es);
                }
            }
        }
        __syncthreads();
        if (tid < 32) { const int n = lcnt[tid]; lcnt[32 + tid] = n > 0 ? (int)atomicAdd((unsigned*)(ws + WS_CTL) + CW_CNT + tid, (unsigned)n) : 0; }
        __syncthreads();
        { const int tl = tid >> 2, k = tid & 3, tok = tokbase + tl;
            const LAS int* pe = pend + tid * 3; const int ee = pe[0], slot = lcnt[32 + ee] + pe[1];
            ((int*)(ws + WS_LIST))[(size_t)ee * T + slot] = tok;
            ((int*)(ws + WS_TOKE))[tok * 4 + k] = ee;
            ((int*)(ws + WS_TOKS))[tok * 4 + k] = slot;
            ((float*)(ws + WS_TOKG))[tok * 4 + k] = __int_as_float(pe[2]); }
        __syncthreads();
        }
      }
        if (BOTH(4)) xcd_barrier(bar);
    }
    if (IN(5)) {
        LAS int* ut = (LAS int*)(lds + UTAB_OFF); LAS unsigned* gt = (LAS unsigned*)(lds + GTAB_OFF);
        moe_tables<8>(ut, (const unsigned*)(ws + WS_CTL) + CW_CNT, G, vcu, tid);
        for (int i = 0; i < MAXU; ++i) {
            const int e = ut[UT_UNIT + 4 * i]; if (e < 0) break;
            if (tid < 256) { const int row = ut[UT_UNIT + 4 * i + 1] * 256 + tid, c = ut[UT_CNT + e]; const int src = row < c ? row : c - 1;
                gt[i * 256 + tid] = (unsigned)((const int*)(ws + WS_LIST))[(size_t)e * T + src] * 1024u; }
        }
        __syncthreads();
        SchedGU Sc{ut, ws, a.p.in[21]}; pg::EpiSwiGLU E;
        for (int rep = 0; rep < NREP(5); ++rep) pg::gemm_phase<pg::EpiSwiGLU, SchedGU, true, true>(lds + RING_OFF, Sc, E, gt);
        if (BOTH(5)) xcd_barrier(bar);
    }
    if (IN(6)) {
        LAS int* ut = (LAS int*)(lds + UTAB_OFF);
        moe_tables<4>(ut, (const unsigned*)(ws + WS_CTL) + CW_CNT, G, vcu, tid);
        SchedDN Sc{ut, ws, a.p.in[23]}; pg::EpiBf16 E;
        for (int rep = 0; rep < NREP(6); ++rep) pg::gemm_phase<pg::EpiBf16, SchedDN, false, true>(lds + RING_OFF, Sc, E, nullptr);
        if (BOTH(6)) xcd_barrier(bar);
    }
    if (IN(7)) {
        const Ptrs& p = a.p;
        LAS int* ut = (LAS int*)(lds + UTAB_OFF);
        moe_tables<4>(ut, (const unsigned*)(ws + WS_CTL) + CW_CNT, G, vcu, tid);
        const int gw = vcu * NWAVES + wave, NGW = G * NWAVES;
        const f32x4* gr = (const f32x4*)p.in[24] + lane;
        for (int rep7 = 0; rep7 < NREP(7); ++rep7)
        for (int tok0 = gw * 2; tok0 < T; tok0 += NGW * 2) {
            float* const dst = (rep7 == NREP(7) - 1) ? p.out : (float*)(ws + WS_HACT);
            f32x4 v[2][4]; unsigned long long yv[2][4][4]; float gts[2][4];
#pragma unroll
            for (int j2 = 0; j2 < 2; ++j2) {
                const int tok = tok0 + j2;
#pragma unroll
                for (int j = 0; j < 4; ++j) v[j2][j] = ((const f32x4*)(p.out + (size_t)tok * D))[lane + 64 * j];
                const int4 ev = *(const int4*)((const int*)(ws + WS_TOKE) + tok * 4), sv = *(const int4*)((const int*)(ws + WS_TOKS) + tok * 4); const f32x4 gv = *(const f32x4*)((const float*)(ws + WS_TOKG) + tok * 4);
                const int es[4] = {ev.x, ev.y, ev.z, ev.w}, ss[4] = {sv.x, sv.y, sv.z, sv.w};
                gts[j2][0] = gv.x; gts[j2][1] = gv.y; gts[j2][2] = gv.z; gts[j2][3] = gv.w;
#pragma unroll
                for (int k = 0; k < 4; ++k) {
                    const unsigned long long* y8 = (const unsigned long long*)((const bf16*)(ws + WS_Y) + (size_t)(ut[UT_PST + es[k]] + ss[k]) * 1024) + lane;
#pragma unroll
                    for (int j = 0; j < 4; ++j) yv[j2][k][j] = y8[64 * j];
                }
            }
#pragma unroll
            for (int j2 = 0; j2 < 2; ++j2) {
                const int tok = tok0 + j2;
#pragma unroll
                for (int k = 0; k < 4; ++k) { const float gt = gts[j2][k];
#pragma unroll
                    for (int j = 0; j < 4; ++j) { const unsigned long long w = yv[j2][k][j]; const unsigned lo_ = (unsigned)w, hi_ = (unsigned)(w >> 32);
                        v[j2][j].x += gt * bf2f(lo_ & 0xffffu); v[j2][j].y += gt * bf2f(lo_ >> 16); v[j2][j].z += gt * bf2f(hi_ & 0xffffu); v[j2][j].w += gt * bf2f(hi_ >> 16); } }
                float s2 = 0.f;
#pragma unroll
                for (int j = 0; j < 4; ++j) s2 += (v[j2][j].x * v[j2][j].x + v[j2][j].y * v[j2][j].y) + (v[j2][j].z * v[j2][j].z + v[j2][j].w * v[j2][j].w);
                const float rs = 1.0f / sqrtf(wave_sum(s2) * (1.f / D) + EPS);
#pragma unroll
                for (int j = 0; j < 4; ++j) { const f32x4 gg = gr[64 * j]; f32x4 y; y.x = v[j2][j].x * rs * gg.x; y.y = v[j2][j].y * rs * gg.y; y.z = v[j2][j].z * rs * gg.z; y.w = v[j2][j].w * rs * gg.w; ((f32x4*)(dst + (size_t)tok * D))[lane + 64 * j] = y; }
            }
        }
    }
#undef IN
#undef BOTH
}

extern "C" void kernel_launch(void* const* d_in, const int* in_sizes, int n_in, void* d_out, int out_size, void* d_ws, size_t ws_size, hipStream_t stream) {
    if (n_in != 25 || out_size != T * D || ws_size < WS_END) { fprintf(stderr, "kernel_launch: unexpected shapes n_in %d out %d ws %zu\n", n_in, out_size, ws_size); return; }
    Ptrs p{};
    for (int i = 0; i < 25; ++i) p.in[i] = (const float*)d_in[i];
    p.out = (float*)d_out; p.ws = (unsigned char*)d_ws;
    (void)hipMemsetAsync((char*)d_ws + WS_CTL, 0, CTL_BYTES, stream);
    static int grid = 0;
    if (grid == 0) {
        int dev = 0, cus = 0;
        if (hipGetDevice(&dev) != hipSuccess || hipDeviceGetAttribute(&cus, hipDeviceAttributeMultiprocessorCount, dev) != hipSuccess) { grid = -1; return; }
        if (hipFuncSetAttribute((const void*)mk_fwd, hipFuncAttributeMaxDynamicSharedMemorySize, LDS_BYTES) != hipSuccess) { fprintf(stderr, "hipFuncSetAttribute failed\n"); grid = -1; return; }
        int per_cu = 0;
        if (hipOccupancyMaxActiveBlocksPerMultiprocessor(&per_cu, (const void*)mk_fwd, NWAVES * 64, LDS_BYTES) != hipSuccess || per_cu < 1) { fprintf(stderr, "occupancy query: %d\n", per_cu); }
        (void)hipGetLastError();
        grid = cus;
    }
    if (grid < 0) return;
#if defined(PROBE_SPLIT)
    { const int k = PROBE_SPLIT; const int reps = PROBE_REPS;
      MKArgs a{}; a.p = p; a.ph_lo = 0; a.ph_hi = k + 1; a.li = 0; hipLaunchKernelGGL(mk_fwd, dim3(grid), dim3(NWAVES * 64), LDS_BYTES, stream, a);
      for (int r = 0; r < reps; ++r) { if (k == 4) (void)hipMemsetAsync((char*)d_ws + WS_CTL + CW_CNT * 4, 0, 128, stream);
          a.ph_lo = k; a.ph_hi = k + 1; hipLaunchKernelGGL(mk_fwd, dim3(grid), dim3(NWAVES * 64), LDS_BYTES, stream, a); }
      a.ph_lo = k + 1; a.ph_hi = 8; a.li = 1; hipLaunchKernelGGL(mk_fwd, dim3(grid), dim3(NWAVES * 64), LDS_BYTES, stream, a); }
#elif !defined(MK_PER_PHASE)
    { MKArgs a{}; a.p = p; a.ph_lo = 0; a.ph_hi = 8; hipLaunchKernelGGL(mk_fwd, dim3(grid), dim3(NWAVES * 64), LDS_BYTES, stream, a); }
#else
    for (int ph = 0; ph < 8; ++ph) { MKArgs a{}; a.p = p; a.ph_lo = ph; a.ph_hi = ph + 1; hipLaunchKernelGGL(mk_fwd, dim3(grid), dim3(NWAVES * 64), LDS_BYTES, stream, a); }
#endif
}
```

```cpp
#include <hip/hip_runtime.h>
#include <cstdio>
#include <cstdint>

typedef unsigned short bf16;
typedef unsigned v4u __attribute__((ext_vector_type(4)));
typedef float f32x4 __attribute__((ext_vector_type(4)));

constexpr int NB = 16, S = 2048, T = NB * S, D = 1024;
constexpr int SBH = 8, HD = 64, SBW = 512, CVW = 256, MXH = 4, MXW = 256, INW = 2304, NMEM = 256, TM = NB * NMEM;
constexpr int NE = 32, TOPK = 4, DFF = 1024, CONVK = 31;
constexpr int PMAX = T * TOPK + NE * 256;
constexpr float EPS = 1e-6f;
constexpr float SB_EXIT_LIN = 4.2483543e-18f;

constexpr size_t MiB = 1u << 20;
constexpr size_t WS_CTL = 0, CTL_BYTES = 64 * 1024;
constexpr size_t WS_WIN = 2 * MiB;
constexpr size_t WS_WOUT = 7 * MiB;
constexpr size_t WS_WMKV = 9 * MiB;
constexpr size_t WS_WPW2 = 10 * MiB;
constexpr size_t WS_WGU = 16 * MiB;
constexpr size_t WS_WDN = 144 * MiB;
constexpr size_t WS_MEMN = 208 * MiB;
constexpr size_t WS_MEMK = 216 * MiB;
constexpr size_t WS_MEMVT = 218 * MiB;
constexpr size_t WS_LIST = 220 * MiB;
constexpr size_t WS_TOKE = 224 * MiB;
constexpr size_t WS_TOKS = 224 * MiB + 512 * 1024;
constexpr size_t WS_TOKG = 225 * MiB;
constexpr size_t WS_HN = 226 * MiB;
constexpr size_t WS_XN = 290 * MiB;
constexpr size_t WS_Q = 354 * MiB;
constexpr size_t WS_K = 386 * MiB;
constexpr size_t WS_VT = 418 * MiB;
constexpr size_t WS_GLU = 450 * MiB;
constexpr size_t WS_QMX = 482 * MiB;
constexpr size_t WS_CAT = 498 * MiB;
constexpr size_t WS_HACT = 562 * MiB;
constexpr size_t WS_Y = 290 * MiB;
constexpr size_t WS_MIX = 700 * MiB;
constexpr size_t WS_HB = 764 * MiB;
constexpr size_t WS_END = 834 * MiB;
constexpr size_t WS_OSB = 562 * MiB;
constexpr size_t WS_OCV = 626 * MiB;
constexpr size_t WS_OMX = 658 * MiB;
static_assert((size_t)PMAX * 1024 * 2 == 272 * MiB, "padded rows");
constexpr int CW_CNT = 64;
constexpr float W8_SCALE = 32.0f;

__device__ __forceinline__ float bf2f(unsigned v) { return __uint_as_float(v << 16); }
__device__ __forceinline__ unsigned f2bf(float f) { unsigned u = __float_as_uint(f); return (u + 0x7fffu + ((u >> 16) & 1u)) >> 16; }
__device__ __forceinline__ unsigned pk2(float lo, float hi) { return f2bf(lo) | (f2bf(hi) << 16); }
__device__ __forceinline__ float wave_sum(float v) {
    v += __int_as_float(__builtin_amdgcn_mov_dpp(__float_as_int(v), 0xB1, 0xf, 0xf, true));
    v += __int_as_float(__builtin_amdgcn_mov_dpp(__float_as_int(v), 0x4E, 0xf, 0xf, true));
    v += __int_as_float(__builtin_amdgcn_mov_dpp(__float_as_int(v), 0x141, 0xf, 0xf, true));
    v += __int_as_float(__builtin_amdgcn_mov_dpp(__float_as_int(v), 0x140, 0xf, 0xf, true));
    const int iv = __float_as_int(v);
    return (__int_as_float(__builtin_amdgcn_readlane(iv, 0)) + __int_as_float(__builtin_amdgcn_readlane(iv, 16))) + (__int_as_float(__builtin_amdgcn_readlane(iv, 32)) + __int_as_float(__builtin_amdgcn_readlane(iv, 48)));
}
__device__ __forceinline__ float wave_max(float v) {
    v = fmaxf(v, __int_as_float(__builtin_amdgcn_mov_dpp(__float_as_int(v), 0xB1, 0xf, 0xf, true)));
    v = fmaxf(v, __int_as_float(__builtin_amdgcn_mov_dpp(__float_as_int(v), 0x4E, 0xf, 0xf, true)));
    v = fmaxf(v, __int_as_float(__builtin_amdgcn_mov_dpp(__float_as_int(v), 0x141, 0xf, 0xf, true)));
    v = fmaxf(v, __int_as_float(__builtin_amdgcn_mov_dpp(__float_as_int(v), 0x140, 0xf, 0xf, true)));
    const int iv = __float_as_int(v);
    return fmaxf(fmaxf(__int_as_float(__builtin_amdgcn_readlane(iv, 0)), __int_as_float(__builtin_amdgcn_readlane(iv, 16))), fmaxf(__int_as_float(__builtin_amdgcn_readlane(iv, 32)), __int_as_float(__builtin_amdgcn_readlane(iv, 48))));
}

__device__ __forceinline__ float xhalf(float v) {
    const auto r = __builtin_amdgcn_permlane32_swap(__float_as_uint(v), __float_as_uint(v), false, false);
    return __uint_as_float((threadIdx.x & 32) ? r[0] : r[1]);
}
__device__ __forceinline__ void transpose_item(const float* W, int K, int N, bf16* WT, int k0, int n0, int dstrow0, const float* kscale, float* scr, int lane) {
    float vv[32];
#pragma unroll
    for (int i = 0; i < 32; ++i) { const int kk = 2 * i + (lane >> 5); vv[i] = W[(size_t)(k0 + kk) * N + n0 + (lane & 31)]; }
#pragma unroll
    for (int i = 0; i < 32; ++i) { const int kk = 2 * i + (lane >> 5); float v = vv[i]; if (kscale) v *= kscale[k0 + kk]; scr[kk * 33 + (lane & 31)] = v; }
    asm volatile("s_waitcnt lgkmcnt(0)" ::: "memory");
    const int c = lane & 7;
#pragma unroll
    for (int j = 0; j < 4; ++j) { const int n = (lane >> 3) + 8 * j; const float* s = scr + (8 * c) * 33 + n;
        v4u o; o.x = pk2(s[0 * 33], s[1 * 33]); o.y = pk2(s[2 * 33], s[3 * 33]); o.z = pk2(s[4 * 33], s[5 * 33]); o.w = pk2(s[6 * 33], s[7 * 33]);
        *(v4u*)(WT + (size_t)(dstrow0 + n) * K + k0 + 8 * c) = o; }
    asm volatile("s_waitcnt lgkmcnt(0)" ::: "memory");
}
__device__ __forceinline__ void transpose_item_fp8(const float* W, int K, int N, unsigned char* WT, int k0, int n0, int dstrow0, float* scr, int lane) {
    float vv[64];
#pragma unroll
    for (int i = 0; i < 64; ++i) { const int kk = 2 * i + (lane >> 5); vv[i] = W[(size_t)(k0 + kk) * N + n0 + (lane & 31)]; }
#pragma unroll
    for (int i = 0; i < 64; ++i) { const int kk = 2 * i + (lane >> 5); scr[kk * 33 + (lane & 31)] = vv[i] * W8_SCALE; }
    asm volatile("s_waitcnt lgkmcnt(0)" ::: "memory");
    const int c = lane & 15;
#pragma unroll
    for (int j = 0; j < 8; ++j) { const int n = (lane >> 4) + 4 * j; const float* s = scr + (8 * c) * 33 + n;
        int w0 = 0, w1 = 0;
        w0 = __builtin_amdgcn_cvt_pk_fp8_f32(s[0 * 33], s[1 * 33], w0, false); w0 = __builtin_amdgcn_cvt_pk_fp8_f32(s[2 * 33], s[3 * 33], w0, true);
        w1 = __builtin_amdgcn_cvt_pk_fp8_f32(s[4 * 33], s[5 * 33], w1, false); w1 = __builtin_amdgcn_cvt_pk_fp8_f32(s[6 * 33], s[7 * 33], w1, true);
        *(unsigned long long*)(WT + (size_t)(dstrow0 + n) * K + k0 + 8 * c) = (unsigned long long)(unsigned)w0 | ((unsigned long long)(unsigned)w1 << 32); }
    asm volatile("s_waitcnt lgkmcnt(0)" ::: "memory");
}
__device__ __forceinline__ void rms_row_to_bf16(const float* xrow, const f32x4 (&gg)[4], bf16* orow, int lane) {
    const f32x4* xr = (const f32x4*)xrow + lane;
    f32x4 v[4]; float s = 0.f;
#pragma unroll
    for (int j = 0; j < 4; ++j) { v[j] = xr[64 * j]; s += (v[j].x * v[j].x + v[j].y * v[j].y) + (v[j].z * v[j].z + v[j].w * v[j].w); }
    const float rs = 1.0f / sqrtf(wave_sum(s) * (1.f / D) + EPS);
    unsigned long long* o8 = (unsigned long long*)orow + lane;
#pragma unroll
    for (int j = 0; j < 4; ++j) o8[64 * j] = (unsigned long long)pk2(v[j].x * rs * gg[j].x, v[j].y * rs * gg[j].y) | ((unsigned long long)pk2(v[j].z * rs * gg[j].z, v[j].w * rs * gg[j].w) << 32);
}

struct Ptrs {
    const float* in[25]; float* out; unsigned char* ws;
};

#define LAS __attribute__((address_space(3)))
typedef short bf16x8 __attribute__((ext_vector_type(8)));
typedef unsigned u32x4 __attribute__((ext_vector_type(4)));
typedef int v4i __attribute__((ext_vector_type(4)));
typedef int v8i __attribute__((ext_vector_type(8)));
namespace pg {
constexpr int BM = 256, BK = 64, HALF = 128, HTB = HALF * BK * 2, STAGE_BYTES = 8 * HTB, GK = 1024;
__host__ __device__ __forceinline__ int lds_byte(int r, int c) { const int st = (r >> 4) * 2 + (c >> 5), rr = r & 15, cc = c & 31, ob = rr * 64 + cc * 2; return st * 1024 + (ob ^ (((ob >> 9) & 1) << 5)); }
__host__ __device__ __forceinline__ void stage_rc(int b, int& R, int& C) { const int st = b / 1024, sb = b % 1024, swz = sb ^ (((sb >> 9) & 1) << 5); R = (st >> 1) * 16 + swz / 64; C = (st & 1) * 32 + (swz % 64) / 2; }
__host__ __device__ __forceinline__ int perm32(int rho) { const int n = rho >> 4, i = rho & 15; return 8 * (i >> 2) + 4 * n + (i & 3); }
__host__ __device__ __forceinline__ int chi4(int fq) { return ((fq & 1) << 1) | (fq >> 1); }
__host__ __device__ __forceinline__ int perm32x(int rho) { const int n = rho >> 4, i = rho & 15; return 8 * chi4(i >> 2) + 4 * n + (i & 3); }
__device__ __forceinline__ unsigned cvt_pk_bf16(float lo, float hi) { unsigned r; asm volatile("v_cvt_pk_bf16_f32 %0, %1, %2" : "=v"(r) : "v"(lo), "v"(hi)); return r; }

struct GU {
    const char* A;
    const char* B;
    char* O;
    const float* bias;
    int ldc; float scale; int gslot; int kind;
    int row0, col0;
};

struct EpiBf16 {
    static constexpr int PERM = 1; bool nostore = false;
    __device__ __forceinline__ void operator()(const f32x4 (&acc)[2][2][4][2], const GU& u, int wr, int wc, int fr, int fq) const {
        bf16* base = (bf16*)u.O + (size_t)(wr * 64 + fr) * u.ldc + wc * 32 + 8 * fq; const float sc = u.scale;
        f32x4 bv[2][2];
#pragma unroll
        for (int bj = 0; bj < 2; ++bj)
#pragma unroll
            for (int n = 0; n < 2; ++n) bv[bj][n] = u.bias ? *(const f32x4*)(u.bias + bj * HALF + wc * 32 + 8 * fq + 4 * n) : (f32x4){0.f, 0.f, 0.f, 0.f};
#pragma unroll
        for (int ai = 0; ai < 2; ++ai)
#pragma unroll
            for (int m = 0; m < 4; ++m) { bf16* rowp = base + (size_t)(ai * HALF + m * 16) * u.ldc;
#pragma unroll
                for (int bj = 0; bj < 2; ++bj) { const f32x4 v0 = acc[ai][bj][m][0] * sc + bv[bj][0], v1 = acc[ai][bj][m][1] * sc + bv[bj][1];
                    u32x4 w; w.x = cvt_pk_bf16(v0[0], v0[1]); w.y = cvt_pk_bf16(v0[2], v0[3]); w.z = cvt_pk_bf16(v1[0], v1[1]); w.w = cvt_pk_bf16(v1[2], v1[3]);
                    if (!nostore) *(u32x4*)(rowp + bj * HALF) = w; } }
    }
};
__device__ __forceinline__ v4i pair16(int a0, int a1, int b0, int b1) {
    const auto s0 = __builtin_amdgcn_permlane32_swap((unsigned)a0, (unsigned)b0, false, false);
    const auto s1 = __builtin_amdgcn_permlane32_swap((unsigned)a1, (unsigned)b1, false, false);
    return (v4i){(int)s0[0], (int)s1[0], (int)s0[1], (int)s1[1]};
}
struct EpiFp8 {
    static constexpr int PERM = 2; bool nostore = false;
    __device__ __forceinline__ void operator()(const f32x4 (&acc)[2][2][4][2], const GU& u, int wr, int wc, int fr, int fq) const {
        const int cx = 8 * chi4(fq);
        unsigned char* base = (unsigned char*)u.O + (size_t)(wr * 64 + fr + (fq >> 1) * 16) * u.ldc + wc * 32 + 16 * (fq & 1); const float sc = u.scale;
        f32x4 bv[2][2];
#pragma unroll
        for (int bj = 0; bj < 2; ++bj)
#pragma unroll
            for (int n = 0; n < 2; ++n) bv[bj][n] = *(const f32x4*)(u.bias + bj * HALF + wc * 32 + cx + 4 * n);
#pragma unroll
        for (int ai = 0; ai < 2; ++ai)
#pragma unroll
            for (int mp = 0; mp < 2; ++mp)
#pragma unroll
                for (int bj = 0; bj < 2; ++bj) { int w[2][2];
#pragma unroll
                    for (int q = 0; q < 2; ++q) { const int m = 2 * mp + q; const f32x4 v0 = acc[ai][bj][m][0] * sc + bv[bj][0], v1 = acc[ai][bj][m][1] * sc + bv[bj][1];
                        int w0 = 0, w1 = 0;
                        w0 = __builtin_amdgcn_cvt_pk_fp8_f32(v0[0], v0[1], w0, false); w0 = __builtin_amdgcn_cvt_pk_fp8_f32(v0[2], v0[3], w0, true);
                        w1 = __builtin_amdgcn_cvt_pk_fp8_f32(v1[0], v1[1], w1, false); w1 = __builtin_amdgcn_cvt_pk_fp8_f32(v1[2], v1[3], w1, true);
                        w[q][0] = w0; w[q][1] = w1; }
                    const v4i o = pair16(w[0][0], w[0][1], w[1][0], w[1][1]);
                    if (!nostore) *(v4i*)(base + (size_t)(ai * HALF + mp * 32) * u.ldc + bj * HALF) = o; }
    }
};
struct EpiP1 {
    static constexpr int PERM = 1;
    __device__ __forceinline__ void operator()(const f32x4 (&acc)[2][2][4][2], const GU& u, int wr, int wc, int fr, int fq) const {
        const float sc = u.scale; const int H = u.ldc;
        f32x4 bv[2][2];
#pragma unroll
        for (int bj = 0; bj < 2; ++bj)
#pragma unroll
            for (int n = 0; n < 2; ++n) bv[bj][n] = u.bias ? *(const f32x4*)(u.bias + bj * HALF + wc * 32 + 8 * fq + 4 * n) : (f32x4){0.f, 0.f, 0.f, 0.f};
#pragma unroll
        for (int ai = 0; ai < 2; ++ai)
#pragma unroll
            for (int m = 0; m < 4; ++m) { const int rr = ai * HALF + wr * 64 + m * 16 + fr;
#pragma unroll
                for (int bj = 0; bj < 2; ++bj) { const int cc = bj * HALF + wc * 32 + 8 * fq;
                    const f32x4 v0 = acc[ai][bj][m][0] * sc + bv[bj][0], v1 = acc[ai][bj][m][1] * sc + bv[bj][1];
                    const unsigned w0 = cvt_pk_bf16(v0[0], v0[1]), w1 = cvt_pk_bf16(v0[2], v0[3]), w2 = cvt_pk_bf16(v1[0], v1[1]), w3 = cvt_pk_bf16(v1[2], v1[3]);
                    if (u.kind == 0) { u32x4 w; w.x = w0; w.y = w1; w.z = w2; w.w = w3; *(u32x4*)((bf16*)u.O + (size_t)rr * u.ldc + cc) = w; }
                    else if (u.kind == 1) { const int row = u.row0 + rr, col = u.col0 + cc, hd = col >> 6, d = col & 63;
                        const size_t off = ((((size_t)(row >> 5) * H + hd) * 4 + (d >> 4)) * 64 + ((d >> 3) & 1) * 32 + (row & 31)) * 8;
                        u32x4 w; w.x = w0; w.y = w1; w.z = w2; w.w = w3; *(u32x4*)((bf16*)u.O + off) = w; }
                    else { const int f = u.row0 + rr, key = u.col0 + cc, hd = f >> 6, d = f & 63;
                        const size_t off = ((((size_t)(key >> 4) * H + hd) * 2 + (d >> 5)) * 64 + (d & 31)) * 8 + ((key >> 3) & 1) * 4;
                        *(unsigned long long*)((bf16*)u.O + off) = (unsigned long long)w0 | ((unsigned long long)w1 << 32);
                        *(unsigned long long*)((bf16*)u.O + off + 32 * 8) = (unsigned long long)w2 | ((unsigned long long)w3 << 32); }
                } }
    }
};
struct EpiSwiGLU {
    static constexpr int PERM = 2;
    __device__ __forceinline__ void operator()(const f32x4 (&acc)[2][2][4][2], const GU& u, int wr, int wc, int fr, int fq) const {
        typedef float f2 __attribute__((ext_vector_type(2)));
        const int cx = 8 * chi4(fq);
        unsigned char* base = (unsigned char*)u.O + (size_t)(wr * 64 + fr + (fq >> 1) * 16) * u.ldc + wc * 32 + 16 * (fq & 1); const float sc = u.scale;
        constexpr float C = -1.702f * 1.44269504f;
        f2 bg[4], bt[4], bu[4];
#pragma unroll
        for (int n = 0; n < 2; ++n) { const f32x4 g4 = *(const f32x4*)(u.bias + wc * 32 + cx + 4 * n), u4 = *(const f32x4*)(u.bias + 1024 + wc * 32 + cx + 4 * n);
            bg[2 * n] = (f2){g4[0], g4[1]}; bg[2 * n + 1] = (f2){g4[2], g4[3]}; bt[2 * n] = bg[2 * n] * C; bt[2 * n + 1] = bg[2 * n + 1] * C;
            bu[2 * n] = (f2){u4[0] + 1.0f, u4[1] + 1.0f}; bu[2 * n + 1] = (f2){u4[2] + 1.0f, u4[3] + 1.0f}; }
        const f2 sc2 = (f2){sc, sc}, sct = (f2){sc * C, sc * C};
#pragma unroll
        for (int ai = 0; ai < 2; ++ai)
#pragma unroll
            for (int mp = 0; mp < 2; ++mp) { int w[2][2];
#pragma unroll
                for (int qq = 0; qq < 2; ++qq) { const int m = 2 * mp + qq; f2 h[4];
#pragma unroll
                    for (int q = 0; q < 4; ++q) { const int n = q >> 1, j = (q & 1) * 2;
                        const f2 ag = (f2){acc[ai][0][m][n][j], acc[ai][0][m][n][j + 1]}, au = (f2){acc[ai][1][m][n][j], acc[ai][1][m][n][j + 1]};
                        f2 g = __builtin_elementwise_fma(ag, sc2, bg[q]), t = __builtin_elementwise_fma(ag, sct, bt[q]), up = __builtin_elementwise_fma(au, sc2, bu[q]);
                        g.x = fminf(g.x, 7.0f); g.y = fminf(g.y, 7.0f); t.x = fmaxf(t.x, 7.0f * C); t.y = fmaxf(t.y, 7.0f * C);
                        up.x = __builtin_amdgcn_fmed3f(up.x, -6.0f, 8.0f); up.y = __builtin_amdgcn_fmed3f(up.y, -6.0f, 8.0f);
                        f2 d; d.x = __builtin_amdgcn_exp2f(t.x); d.y = __builtin_amdgcn_exp2f(t.y); d = d + 1.0f;
                        f2 r; r.x = __builtin_amdgcn_rcpf(d.x); r.y = __builtin_amdgcn_rcpf(d.y);
                        h[q] = (up * g) * r; }
                    int w0 = 0, w1 = 0;
                    w0 = __builtin_amdgcn_cvt_pk_fp8_f32(h[0].x, h[0].y, w0, false); w0 = __builtin_amdgcn_cvt_pk_fp8_f32(h[1].x, h[1].y, w0, true);
                    w1 = __builtin_amdgcn_cvt_pk_fp8_f32(h[2].x, h[2].y, w1, false); w1 = __builtin_amdgcn_cvt_pk_fp8_f32(h[3].x, h[3].y, w1, true);
                    w[qq][0] = w0; w[qq][1] = w1; }
                *(v4i*)(base + (size_t)(ai * HALF + mp * 32) * u.ldc) = pair16(w[0][0], w[0][1], w[1][0], w[1][1]); }
    }
};

#ifndef STAGGER_TICKS
#define STAGGER_TICKS 0
#endif
template <class Epi, class Sched, bool GATHER, bool FP8>
__device__ __forceinline__ void gemm_phase(LAS unsigned char* lds, const Sched& S, const Epi& E, const LAS unsigned* gtab) {
    const int tid = threadIdx.x, wid = __builtin_amdgcn_readfirstlane(tid >> 6), lane = tid & 63, wr = wid >> 2, wc = wid & 3, fr = lane & 15, fq = lane >> 4;
    constexpr int PITCH = FP8 ? GK : GK * 2, nt = FP8 ? GK / 128 : GK / BK;
    unsigned voffB[2]; int Rr[2], Cc2[2];
#pragma unroll
    for (int i = 0; i < 2; ++i) { int R, C; stage_rc(tid * 16 + i * 8192, R, C); const int Rb = (Epi::PERM == 2) ? ((R & ~31) + perm32x(R & 31)) : (Epi::PERM ? ((R & ~31) + perm32(R & 31)) : R);
        voffB[i] = (unsigned)(Rb * PITCH + C * 2); Rr[i] = R; Cc2[i] = C * 2; }
    constexpr size_t kstep = (size_t)(BK * 2);
    constexpr size_t hstep = (size_t)HALF * PITCH;
    const unsigned ldsw = (unsigned)wid * 1024u;
    const int aoff = lds_byte(wr * 64 + fr, fq * 8);
    unsigned boffv = (unsigned)(size_t)lds + 4 * HTB + lds_byte(wc * 32 + fr, fq * 8);
    asm volatile("" : "+v"(boffv));
#define PG_SA(b, h) (((b) * 2 + (h)) * HTB)
#define PG_SB(b, h) ((4 + (b) * 2 + (h)) * HTB)
#define PG_STAGE(bufoff, gbase, voff) do { _Pragma("unroll") for (int _i = 0; _i < 2; ++_i) \
        __builtin_amdgcn_global_load_lds((const unsigned*)((const char*)(gbase) + (voff)[_i]), (LAS unsigned*)(lds + (bufoff) + ldsw + _i * 8192), 16, 0, 0); } while (0)
#define PG_RD16(off) (*(const LAS v4i*)(lds + (off)))
#define PG_LDA(dst, b, h) do { _Pragma("unroll") for (int m = 0; m < 4; ++m) dst[m] = __builtin_shufflevector(PG_RD16(PG_SA(b, h) + aoff + m * 2048), PG_RD16(PG_SA(b, h) + aoff + m * 2048 + 1024), 0, 1, 2, 3, 4, 5, 6, 7); } while (0)
#define PG_RDB16(off) (*(const LAS v4i*)((LAS unsigned char*)(size_t)boffv + (off)))
#define PG_LDB(dst, b, h) do { _Pragma("unroll") for (int n = 0; n < 2; ++n) dst[n] = __builtin_shufflevector(PG_RDB16(((b) * 2 + (h)) * HTB + n * 2048), PG_RDB16(((b) * 2 + (h)) * HTB + n * 2048 + 1024), 0, 1, 2, 3, 4, 5, 6, 7); } while (0)
#define PG_LO(x) __builtin_bit_cast(bf16x8, __builtin_shufflevector((x), (x), 0, 1, 2, 3))
#define PG_HI(x) __builtin_bit_cast(bf16x8, __builtin_shufflevector((x), (x), 4, 5, 6, 7))
#define PG_MMA(ai, bj, At, Bt) do { __builtin_amdgcn_s_setprio(1); _Pragma("unroll") for (int m = 0; m < 4; ++m) _Pragma("unroll") for (int n = 0; n < 2; ++n) { \
        if constexpr (FP8) { asm volatile("v_mfma_scale_f32_16x16x128_f8f6f4 %0, %1, %2, %0, %3, %3 op_sel_hi:[0,0,0]" : "+v"(acc[ai][bj][m][n]) : "v"(Bt[n]), "v"(At[m]), "v"(sc1)); } \
        else { acc[ai][bj][m][n] = __builtin_amdgcn_mfma_f32_16x16x32_bf16(PG_LO(Bt[n]), PG_LO(At[m]), acc[ai][bj][m][n], 0, 0, 0); \
               acc[ai][bj][m][n] = __builtin_amdgcn_mfma_f32_16x16x32_bf16(PG_HI(Bt[n]), PG_HI(At[m]), acc[ai][bj][m][n], 0, 0, 0); } } \
        __builtin_amdgcn_s_setprio(0); } while (0)
#define PG_WAIT_V(n) asm volatile("s_waitcnt vmcnt(" #n ")" ::: "memory")
#define PG_WAIT_L(n) asm volatile("s_waitcnt lgkmcnt(" #n ")" ::: "memory")
#define PG_BAR __builtin_amdgcn_s_barrier()
#define PG_SCHED __builtin_amdgcn_sched_barrier(0)
#define PG_LOADVO(vo, u) do { _Pragma("unroll") for (int _h = 0; _h < 2; ++_h) _Pragma("unroll") for (int _i = 0; _i < 2; ++_i) \
        vo[_h][_i] = GATHER ? (gtab[(u).gslot * 256 + _h * HALF + Rr[_i]] + (unsigned)Cc2[_i]) : (unsigned)((_h * HALF + Rr[_i]) * PITCH + Cc2[_i]); } while (0)
    int sc1 = 0x7f7f7f7f; asm volatile("" : "+v"(sc1));
    GU cur, nxt; int ui = 0;
    if (!S.next(0, cur)) return;
    if (STAGGER_TICKS > 0) {
        const unsigned long long t0 = __builtin_amdgcn_s_memrealtime(); const unsigned long long dl = (unsigned long long)((blockIdx.x * 5u) & 15u) * STAGGER_TICKS;
        while (__builtin_amdgcn_s_memrealtime() - t0 < dl) __builtin_amdgcn_s_sleep(8);
    }
    f32x4 acc[2][2][4][2];
#pragma unroll
    for (int a = 0; a < 2; ++a)
#pragma unroll
        for (int b = 0; b < 2; ++b)
#pragma unroll
            for (int m = 0; m < 4; ++m)
#pragma unroll
                for (int n = 0; n < 2; ++n) acc[a][b][m][n] = (f32x4){0.f, 0.f, 0.f, 0.f};
    v8i At[4], B0[2], B1[2];
    unsigned cvo[2][2], nvo[2][2];
    PG_LOADVO(cvo, cur);
    const char* cA = cur.A; const char* cB = cur.B;
    PG_STAGE(PG_SB(0, 0), cB, voffB); PG_STAGE(PG_SB(0, 1), cB + hstep, voffB); PG_STAGE(PG_SA(0, 0), cA, cvo[0]); PG_STAGE(PG_SA(0, 1), cA, cvo[1]);
    if (wr == 1) PG_BAR;
    PG_WAIT_V(2); PG_BAR;
    PG_STAGE(PG_SB(1, 0), cB + kstep, voffB); PG_STAGE(PG_SA(1, 0), cA + kstep, cvo[0]); PG_STAGE(PG_SB(1, 1), cB + hstep + kstep, voffB);
    PG_WAIT_V(6); PG_BAR;
    for (;;) {
        const bool has_next = S.next(ui + 1, nxt);
        const char* nA = has_next ? nxt.A : cA; const char* nB = has_next ? nxt.B : cB;
        if (GATHER) { if (has_next) { PG_LOADVO(nvo, nxt); } else {
#pragma unroll
            for (int h = 0; h < 2; ++h)
#pragma unroll
                for (int i = 0; i < 2; ++i) nvo[h][i] = cvo[h][i]; } }
#pragma unroll 1
        for (int t = 0; t < nt; t += 2) {
            const bool last = (t == nt - 2);
            const char* a1 = cA + (size_t)(t + 1) * kstep;
            const char* a2 = last ? nA : cA + (size_t)(t + 2) * kstep; const char* b2 = last ? nB : cB + (size_t)(t + 2) * kstep;
            const char* a3 = a2 + kstep; const char* b3 = b2 + kstep;
            unsigned vo2[2][2];
#pragma unroll
            for (int h = 0; h < 2; ++h)
#pragma unroll
                for (int i = 0; i < 2; ++i) vo2[h][i] = (GATHER && last) ? nvo[h][i] : cvo[h][i];
            PG_LDB(B0, 0, 0); PG_LDB(B1, 0, 1); PG_SCHED; PG_LDA(At, 0, 0); PG_STAGE(PG_SA(1, 1), a1, cvo[1]);
            PG_WAIT_V(8); PG_WAIT_L(0); PG_BAR; PG_MMA(0, 0, At, B0); PG_MMA(0, 1, At, B1); PG_BAR; PG_SCHED;
            PG_LDA(At, 0, 1); PG_STAGE(PG_SB(0, 0), b2, voffB); PG_STAGE(PG_SB(0, 1), b2 + hstep, voffB); PG_STAGE(PG_SA(0, 0), a2, vo2[0]);
            PG_WAIT_V(8); PG_WAIT_L(0); PG_BAR; PG_MMA(1, 0, At, B0); PG_MMA(1, 1, At, B1); PG_BAR; PG_SCHED;
            PG_LDB(B0, 1, 0); PG_LDB(B1, 1, 1); PG_SCHED; PG_LDA(At, 1, 0); PG_STAGE(PG_SA(0, 1), a2, vo2[1]);
            PG_WAIT_V(8); PG_WAIT_L(0); PG_BAR; PG_MMA(0, 0, At, B0); PG_MMA(0, 1, At, B1); PG_BAR; PG_SCHED;
            PG_LDA(At, 1, 1); PG_STAGE(PG_SB(1, 0), b3, voffB); PG_STAGE(PG_SB(1, 1), b3 + hstep, voffB); PG_STAGE(PG_SA(1, 0), a3, vo2[0]);
            PG_WAIT_V(8); PG_WAIT_L(0); PG_BAR; PG_MMA(1, 0, At, B0); PG_MMA(1, 1, At, B1); PG_BAR; PG_SCHED;
        }
        if (wr == 0) PG_BAR;
        if constexpr (FP8) { asm volatile("s_nop 15\n\ts_nop 15" ::: "memory"); }
        E(acc, cur, wr, wc, fr, fq);
        if (!has_next) break;
#pragma unroll
        for (int a = 0; a < 2; ++a)
#pragma unroll
            for (int b = 0; b < 2; ++b)
#pragma unroll
                for (int m = 0; m < 4; ++m)
#pragma unroll
                    for (int n = 0; n < 2; ++n) acc[a][b][m][n] = (f32x4){0.f, 0.f, 0.f, 0.f};
        cur = nxt; cA = nA; cB = nB; ++ui;
        if (GATHER) {
#pragma unroll
            for (int h = 0; h < 2; ++h)
#pragma unroll
                for (int i = 0; i < 2; ++i) cvo[h][i] = nvo[h][i]; }
        if (wr == 1) PG_BAR;
    }
    PG_WAIT_V(0);
    PG_BAR;
#undef PG_SA
#undef PG_SB
#undef PG_STAGE
#undef PG_LDA
#undef PG_RD16
#undef PG_RDB16
#undef PG_LO
#undef PG_HI
#undef PG_LDB
#undef PG_MMA
#undef PG_WAIT_V
#undef PG_WAIT_L
#undef PG_BAR
#undef PG_SCHED
#undef PG_LOADVO
}
}

constexpr int NWAVES = 8;
constexpr int RING_OFF = 0, RING_BYTES = 131072;
constexpr int GTAB_OFF = RING_BYTES, GTAB_BYTES = 18 * 1024;
constexpr int UTAB_OFF = GTAB_OFF + GTAB_BYTES, UTAB_BYTES = 1024;
constexpr int MISC_OFF = UTAB_OFF + UTAB_BYTES;
constexpr int LDS_BYTES = MISC_OFF + 512;
static_assert(LDS_BYTES <= 160 * 1024, "LDS");

#ifndef REP_PHASE
#define REP_PHASE -1
#endif
#define NREP(k) ((REP_PHASE) == (k) ? 2 : 1)
struct MKArgs { Ptrs p; int ph_lo, ph_hi, li, pad; };

#define XB_TMO      128
#define XB_XCNT(j)  (256  + 64 * (j))
#define XB_XSUB(j)  (1280 + 64 * (j))
#define XB_XGEN(j)  (2304 + 64 * (j))
#define XB_TOP      3328
#define XB_TOPGEN   3392
#define XCD_BAR_WORDS 3456
#define XB_SPIN_CAP (1u << 18)
__device__ __forceinline__ unsigned xb_ld(unsigned* p)              { return __hip_atomic_load(p, __ATOMIC_RELAXED, __HIP_MEMORY_SCOPE_AGENT); }
__device__ __forceinline__ unsigned xb_add(unsigned* p, unsigned v) { return __hip_atomic_fetch_add(p, v, __ATOMIC_RELAXED, __HIP_MEMORY_SCOPE_AGENT); }
__device__ __forceinline__ unsigned xb_xcc_id() { return (unsigned)__builtin_amdgcn_s_getreg((3 << 11) | 20) & 0xFu; }
#define XB_SPIN(cond, bar) do { unsigned _sp = 0; while (cond) { __builtin_amdgcn_s_sleep(1); \
    if ((++_sp & 255u) == 0u) { if (xb_ld(&(bar)[XB_TMO])) break; if (_sp > XB_SPIN_CAP) { atomicAdd(&(bar)[XB_TMO], 1u); break; } } } } while (0)
struct XcdBarrier { unsigned* bar; unsigned x; volatile LAS unsigned* st; };
__device__ __forceinline__ XcdBarrier xcd_barrier_post(unsigned* bar, volatile LAS unsigned* st) {
    XcdBarrier b; b.bar = bar; b.x = xb_xcc_id(); b.st = st;
    if (threadIdx.x == 0) (void)xb_add(&bar[XB_XCNT(b.x)], 1u);
    return b;
}
__device__ __forceinline__ void xcd_barrier_complete(unsigned* bar, unsigned x, unsigned& nloc, unsigned& nx) {
    const unsigned G = gridDim.x * gridDim.y * gridDim.z;
    unsigned sum, cnt, mine, sp = 0u;
    for (;;) {
        sum = 0u; cnt = 0u; mine = 0u;
#pragma unroll
        for (unsigned j = 0; j < 16; ++j) { const unsigned c = xb_ld(&bar[XB_XCNT(j)]); sum += c; cnt += (c > 0u) ? 1u : 0u; mine = (j == x) ? c : mine; }
        if (sum == G) break;
        __builtin_amdgcn_s_sleep(1);
        if ((++sp & 255u) == 0u) { if (xb_ld(&bar[XB_TMO])) break; if (sp > XB_SPIN_CAP) { atomicAdd(&bar[XB_TMO], 1u); break; } }
    }
    nloc = mine > 0u ? mine : 1u; nx = cnt > 0u ? cnt : 1u;
}
__device__ __forceinline__ void xcd_barrier(const XcdBarrier& b) {
    asm volatile("s_waitcnt vmcnt(0)" ::: "memory");
    __syncthreads();
    if (threadIdx.x == 0) {
        unsigned* bar = b.bar;
        __builtin_amdgcn_s_waitcnt(0);
        unsigned nloc = b.st[0], nx = b.st[1];
        if (nloc == 0u) { xcd_barrier_complete(bar, b.x, nloc, nx); b.st[0] = nloc; b.st[1] = nx; }
        const unsigned old = xb_add(&bar[XB_XSUB(b.x)], 1u);
        const unsigned gen = old / nloc;
        if (old + 1u == (gen + 1u) * nloc) {
            __builtin_amdgcn_fence(__ATOMIC_RELEASE, "agent");
            asm volatile("s_waitcnt vmcnt(0)" ::: "memory");
            const unsigned og = xb_add(&bar[XB_TOP], 1u);
            const unsigned tg = og / nx;
            if (og + 1u == (tg + 1u) * nx) xb_add(&bar[XB_TOPGEN], 1u);
            else XB_SPIN(xb_ld(&bar[XB_TOPGEN]) == tg, bar);
            __builtin_amdgcn_fence(__ATOMIC_ACQUIRE, "agent");
            xb_add(&bar[XB_XGEN(b.x)], 1u);
            asm volatile("s_waitcnt vmcnt(0)" ::: "memory");
        } else {
            XB_SPIN(xb_ld(&bar[XB_XGEN(b.x)]) == gen, bar);
            __builtin_amdgcn_fence(__ATOMIC_ACQUIRE, "agent");
            asm volatile("s_waitcnt vmcnt(0)" ::: "memory");
        }
    }
    __syncthreads();
}
constexpr int CW_BAR = 4096;

struct SchedP1 {
    int G, c; unsigned char* ws; const float* b_glu;
    static constexpr int N_A = 128 * 7, N_B = 256, N_C = 32, NU = N_A + N_B + N_C;
    __device__ __forceinline__ bool next(int i, pg::GU& u) const {
        const int L = i * G + c; if (L >= NU) return false;
        u.bias = nullptr; u.scale = 1.0f; u.gslot = 0; u.kind = 1; u.row0 = 0; u.col0 = 0; u.ldc = 8;
        if (L < N_A) { const int pm = L / 7, pn = L % 7;
            u.A = (const char*)(ws + WS_XN) + (size_t)pm * 256 * 2048; u.row0 = pm * 256;
            const int brow = pn < 4 ? 256 * pn : 256 * (pn + 2); u.B = (const char*)(ws + WS_WIN) + (size_t)brow * 2048;
            if (pn < 2) { u.O = (char*)(ws + WS_Q); u.col0 = pn * 256; u.scale = 0.125f * 1.44269504f; }
            else if (pn < 4) { u.O = (char*)(ws + WS_K); u.col0 = (pn - 2) * 256; }
            else if (pn < 6) { u.kind = 0; u.O = (char*)(ws + WS_GLU) + ((size_t)pm * 256 * 512 + (pn - 4) * 256) * 2; u.ldc = 512; u.bias = b_glu + (pn - 4) * 256; }
            else { u.O = (char*)(ws + WS_QMX); u.ldc = 4; u.scale = 0.125f * 1.44269504f; }
        } else if (L < N_A + N_B) { const int q = L - N_A, pn = q >> 1, pm = q & 1;
            u.A = (const char*)(ws + WS_WIN) + (size_t)(1024 + 256 * pm) * 2048; u.B = (const char*)(ws + WS_XN) + (size_t)pn * 256 * 2048;
            u.kind = 2; u.O = (char*)(ws + WS_VT); u.row0 = 256 * pm; u.col0 = 256 * pn;
        } else { int q = L - N_A - N_B; u.ldc = 4;
            if (q < 16) { u.A = (const char*)(ws + WS_MEMN) + (size_t)q * 256 * 2048; u.B = (const char*)(ws + WS_WMKV); u.O = (char*)(ws + WS_MEMK); u.row0 = q * 256; }
            else { q -= 16; u.A = (const char*)(ws + WS_WMKV) + (size_t)256 * 2048; u.B = (const char*)(ws + WS_MEMN) + (size_t)q * 256 * 2048; u.kind = 2; u.O = (char*)(ws + WS_MEMVT); u.col0 = q * 256; }
        }
        return true;
    }
};
struct SchedP3 {
    int G, c; unsigned char* ws;
    __device__ __forceinline__ bool next(int i, pg::GU& u) const {
        const int L = i * G + c; if (L >= 512) return false;
        const int pm = L >> 2, pn = L & 3;
        u.A = (const char*)(ws + WS_CAT) + (size_t)pm * 256 * 2048; u.B = (const char*)(ws + WS_WOUT) + (size_t)pn * 256 * 2048;
        u.O = (char*)(ws + WS_MIX) + ((size_t)pm * 256 * 1024 + pn * 256) * 2; u.bias = nullptr; u.ldc = 1024; u.scale = 1.0f; u.gslot = 0; u.kind = 0; u.row0 = 0; u.col0 = 0;
        return true;
    }
};
constexpr int UT_CNT = 0, UT_PST = 32, UT_UST = 64, UT_TOT = 96, UT_UNIT = 128, MAXU = 18;
template <int NPN>
__device__ __forceinline__ void moe_tables(LAS int* ut, const unsigned* cnt, int G, int vcu, int tid) {
    if (tid < 64) {
        const int c = tid < 32 ? (int)cnt[tid] : 0; const int np = (c + 255) >> 8;
        int incl = np;
#pragma unroll
        for (int o = 1; o < 32; o <<= 1) { const int v = __shfl_up(incl, o); if ((tid & 63) >= o) incl += v; }
        const int excl = incl - np;
        if (tid < 32) { ut[UT_CNT + tid] = c; ut[UT_PST + tid] = excl * 256; ut[UT_UST + tid] = excl * NPN; }
        if (tid == 31) ut[UT_TOT] = incl * NPN;
    }
    __syncthreads();
    if (tid < MAXU) {
        const int L = tid * G + vcu, U = ut[UT_TOT];
        int e = -1;
        if (L < U) { e = 0; for (int j = 1; j < 32; ++j) if (ut[UT_UST + j] <= L) e = j; }
        const int q = e >= 0 ? L - ut[UT_UST + e] : 0;
        ut[UT_UNIT + 4 * tid + 0] = e; ut[UT_UNIT + 4 * tid + 1] = q / NPN; ut[UT_UNIT + 4 * tid + 2] = q % NPN; ut[UT_UNIT + 4 * tid + 3] = e >= 0 ? ut[UT_PST + e] : 0;
    }
    __syncthreads();
}
struct SchedGU {
    const LAS int* ut; unsigned char* ws; const float* b_gu;
    __device__ __forceinline__ bool next(int i, pg::GU& u) const {
        if (i >= MAXU) return false;
        const int e = __builtin_amdgcn_readfirstlane(ut[UT_UNIT + 4 * i]); if (e < 0) return false;
        const int panel = __builtin_amdgcn_readfirstlane(ut[UT_UNIT + 4 * i + 1]), pn = __builtin_amdgcn_readfirstlane(ut[UT_UNIT + 4 * i + 2]), pst = __builtin_amdgcn_readfirstlane(ut[UT_UNIT + 4 * i + 3]);
        u.A = (const char*)(ws + WS_HN); u.B = (const char*)(ws + WS_WGU) + ((size_t)e * 2048 + pn * 256) * 1024;
        u.O = (char*)(ws + WS_HACT) + ((size_t)(pst + panel * 256) * 1024 + pn * 128); u.bias = b_gu + (size_t)e * 2048 + pn * 128; u.ldc = 1024; u.scale = 1.0f / W8_SCALE; u.gslot = i; u.kind = 0; u.row0 = 0; u.col0 = 0;
        return true;
    }
};
struct SchedDN {
    const LAS int* ut; unsigned char* ws; const float* b_dn;
    __device__ __forceinline__ bool next(int i, pg::GU& u) const {
        if (i >= MAXU) return false;
        const int e = __builtin_amdgcn_readfirstlane(ut[UT_UNIT + 4 * i]); if (e < 0) return false;
        const int panel = __builtin_amdgcn_readfirstlane(ut[UT_UNIT + 4 * i + 1]), pn = __builtin_amdgcn_readfirstlane(ut[UT_UNIT + 4 * i + 2]), pst = __builtin_amdgcn_readfirstlane(ut[UT_UNIT + 4 * i + 3]);
        u.A = (const char*)(ws + WS_HACT) + (size_t)(pst + panel * 256) * 1024; u.B = (const char*)(ws + WS_WDN) + ((size_t)e * 1024 + pn * 256) * 1024;
        u.O = (char*)(ws + WS_Y) + ((size_t)(pst + panel * 256) * 1024 + pn * 256); u.bias = b_dn + (size_t)e * 1024 + pn * 256; u.ldc = 1024; u.scale = 1.0f / W8_SCALE; u.gslot = 0; u.kind = 0; u.row0 = 0; u.col0 = 0;
        return true;
    }
};

#define LDS_BARRIER() do { asm volatile("s_waitcnt lgkmcnt(0)" ::: "memory"); __builtin_amdgcn_s_barrier(); asm volatile("" ::: "memory"); } while (0)
typedef float f32x16 __attribute__((ext_vector_type(16)));
typedef short s16x4 __attribute__((ext_vector_type(4)));
#define MFMA32(a, b, c) __builtin_amdgcn_mfma_f32_32x32x16_bf16((a), (b), (c), 0, 0, 0)
__device__ __forceinline__ bf16x8 pack8(float a0, float a1, float a2, float a3, float a4, float a5, float a6, float a7) {
    u32x4 p; p.x = pg::cvt_pk_bf16(a0, a1); p.y = pg::cvt_pk_bf16(a2, a3); p.z = pg::cvt_pk_bf16(a4, a5); p.w = pg::cvt_pk_bf16(a6, a7);
    return __builtin_bit_cast(bf16x8, p);
}
__device__ __forceinline__ bf16x8 load_vt_frag(const bf16* rowp, int h) {
    const s16x4 lo = *(const s16x4*)(rowp + 4 * h), hi = *(const s16x4*)(rowp + 8 + 4 * h);
    return __builtin_shufflevector(lo, hi, 0, 1, 2, 3, 4, 5, 6, 7);
}
__device__ __forceinline__ void sb_unit(unsigned char* ws, LAS unsigned char* lds, int unit, int wave, int lane) {
    const int b = unit >> 5, t0 = (unit & 31) * 64, hd = wave, r = lane & 31, h = lane >> 5;
    const size_t tb = (size_t)b * S;
    const bf16* Q = (const bf16*)(ws + WS_Q); const bf16* Kp = (const bf16*)(ws + WS_K); const bf16* VT = (const bf16*)(ws + WS_VT);
    bf16x8 qf[2][4];
#pragma unroll
    for (int ni = 0; ni < 2; ++ni)
#pragma unroll
        for (int kk = 0; kk < 4; ++kk) qf[ni][kk] = *(const bf16x8*)(Q + (((((tb + t0) >> 5) + ni) * 8 + hd) * 4 + kk) * 512 + lane * 8);
    f32x16 oacc[2][2];
#pragma unroll
    for (int di = 0; di < 2; ++di)
#pragma unroll
        for (int ni = 0; ni < 2; ++ni)
#pragma unroll
            for (int i = 0; i < 16; ++i) oacc[di][ni][i] = 0.f;
    float carry[2] = {1.0f, 1.0f};
    for (int s0 = t0 + 32; s0 >= 0; s0 -= 32) {
        bf16x8 kf[4];
#pragma unroll
        for (int kk = 0; kk < 4; ++kk) kf[kk] = *(const bf16x8*)(Kp + ((((tb + s0) >> 5) * 8 + hd) * 4 + kk) * 512 + lane * 8);
        bf16x8 vf[2][2];
#pragma unroll
        for (int di = 0; di < 2; ++di)
#pragma unroll
            for (int ks = 0; ks < 2; ++ks) vf[di][ks] = *(const bf16x8*)(VT + (((((tb + s0) >> 4) + ks) * 8 + hd) * 2 + di) * 512 + lane * 8);
        const bool diag = (s0 + 31 >= t0);
        bf16x8 pf[2][2];
#pragma unroll
        for (int ni = 0; ni < 2; ++ni) {
            f32x16 sa;
#pragma unroll
            for (int i = 0; i < 16; ++i) sa[i] = 0.f;
#pragma unroll
            for (int kk = 0; kk < 4; ++kk) sa = MFMA32(kf[kk], qf[ni][kk], sa);
            f32x16 zc = sa;
            if (diag) {
#pragma unroll
                for (int i = 0; i < 16; ++i) { const int key = s0 + (i & 3) + 8 * (i >> 2) + 4 * h, tq = t0 + 32 * ni + r; zc[i] = (key < tq) ? zc[i] : -1.0e30f; }
            }
            f32x16 E;
#pragma unroll
            for (int i = 0; i < 16; ++i) E[i] = __builtin_amdgcn_exp2f(__builtin_amdgcn_fmed3f(zc[i], -1.0e30f, 30.0f));
            const f32x16 dd = E + 1.0f;
            float P1[4], P2[4], P3[4], rg[4], Tg[4], Pg[4];
#pragma unroll
            for (int g = 0; g < 4; ++g) { P1[g] = dd[4 * g]; P2[g] = P1[g] * dd[4 * g + 1]; P3[g] = P2[g] * dd[4 * g + 2];
                rg[g] = __builtin_amdgcn_rcpf(P3[g] * dd[4 * g + 3]);
                Pg[g] = xhalf(rg[g]); Tg[g] = rg[g] * Pg[g]; }
            float suf[4]; suf[3] = 1.0f; suf[2] = Tg[3]; suf[1] = Tg[3] * Tg[2]; suf[0] = suf[1] * Tg[1];
            const float total = suf[0] * Tg[0];
            float av[16];
#pragma unroll
            for (int g = 0; g < 4; ++g) {
                const float br = carry[ni] * suf[g] * (h == 0 ? Pg[g] : 1.0f) * rg[g];
                av[4 * g] = E[4 * g] * br; av[4 * g + 1] = E[4 * g + 1] * (br * P1[g]); av[4 * g + 2] = E[4 * g + 2] * (br * P2[g]); av[4 * g + 3] = E[4 * g + 3] * (br * P3[g]);
            }
            carry[ni] *= total;
            pf[ni][0] = pack8(av[0], av[1], av[2], av[3], av[4], av[5], av[6], av[7]);
            pf[ni][1] = pack8(av[8], av[9], av[10], av[11], av[12], av[13], av[14], av[15]);
        }
#pragma unroll
        for (int di = 0; di < 2; ++di)
#pragma unroll
            for (int ni = 0; ni < 2; ++ni)
#pragma unroll
                for (int ks = 0; ks < 2; ++ks) oacc[di][ni] = MFMA32(vf[di][ks], pf[ni][ks], oacc[di][ni]);
        if (__all((carry[0] < SB_EXIT_LIN) && (carry[1] < SB_EXIT_LIN))) break;
    }
    LAS float* ssq = (LAS float*)lds;
    float ss[2];
#pragma unroll
    for (int ni = 0; ni < 2; ++ni) { float v = 0.f;
#pragma unroll
        for (int di = 0; di < 2; ++di)
#pragma unroll
            for (int i = 0; i < 16; ++i) v += oacc[di][ni][i] * oacc[di][ni][i];
        v += xhalf(v); ss[ni] = v;
        if (h == 0) ssq[(32 * ni + r) * 8 + hd] = v; }
    LDS_BARRIER();
    bf16* cat = (bf16*)(ws + WS_CAT);
#pragma unroll
    for (int ni = 0; ni < 2; ++ni) {
        float tot = 0.f;
#pragma unroll
        for (int w = 0; w < 8; ++w) tot += ssq[(32 * ni + r) * 8 + w];
        const float rs = 1.0f / sqrtf(tot * (1.f / 512.f) + EPS);
        bf16* rowp = cat + (tb + t0 + 32 * ni + r) * 1024 + hd * 64 + 8 * h;
#pragma unroll
        for (int di = 0; di < 2; ++di)
#pragma unroll
            for (int gp = 0; gp < 2; ++gp) { const int g0 = 2 * gp, g1 = 2 * gp + 1;
                const v4i o = pg::pair16((int)pg::cvt_pk_bf16(oacc[di][ni][4 * g0] * rs, oacc[di][ni][4 * g0 + 1] * rs), (int)pg::cvt_pk_bf16(oacc[di][ni][4 * g0 + 2] * rs, oacc[di][ni][4 * g0 + 3] * rs),
                                          (int)pg::cvt_pk_bf16(oacc[di][ni][4 * g1] * rs, oacc[di][ni][4 * g1 + 1] * rs), (int)pg::cvt_pk_bf16(oacc[di][ni][4 * g1 + 2] * rs, oacc[di][ni][4 * g1 + 3] * rs));
                *(v4i*)(rowp + 32 * di + 16 * gp) = o; }
    }
    LDS_BARRIER();
}

__device__ __forceinline__ void mx_unit(unsigned char* ws, LAS unsigned char* lds, int unit, int wave, int lane) {
    const int b = unit >> 5, t0 = (unit & 31) * 64, hd = wave & 3, qh = wave >> 2, r = lane & 31, h = lane >> 5;
    const size_t tb = (size_t)b * S;
    const bf16* QM = (const bf16*)(ws + WS_QMX); const bf16* MK = (const bf16*)(ws + WS_MEMK); const bf16* MVT = (const bf16*)(ws + WS_MEMVT);
    bf16x8 qf[4];
#pragma unroll
    for (int kk = 0; kk < 4; ++kk) qf[kk] = *(const bf16x8*)(QM + (((((tb + t0) >> 5) + qh) * 4 + hd) * 4 + kk) * 512 + lane * 8);
    f32x16 sa[8];
#pragma unroll
    for (int mi = 0; mi < 8; ++mi) {
#pragma unroll
        for (int i = 0; i < 16; ++i) sa[mi][i] = 0.f;
#pragma unroll
        for (int kk = 0; kk < 4; ++kk) { const bf16x8 kf = *(const bf16x8*)(MK + (size_t)(((b * 8 + mi) * 4 + hd) * 4 + kk) * 512 + lane * 8); sa[mi] = MFMA32(kf, qf[kk], sa[mi]); }
    }
    float mx = -3.0e38f;
#pragma unroll
    for (int mi = 0; mi < 8; ++mi)
#pragma unroll
        for (int i = 0; i < 16; ++i) mx = fmaxf(mx, sa[mi][i]);
    mx = fmaxf(mx, xhalf(mx));
    float sum = 0.f;
#pragma unroll
    for (int mi = 0; mi < 8; ++mi)
#pragma unroll
        for (int i = 0; i < 16; ++i) { const float pv = __builtin_amdgcn_exp2f(sa[mi][i] - mx); sa[mi][i] = pv; sum += pv; }
    sum += xhalf(sum);
    f32x16 oacc[2];
#pragma unroll
    for (int di = 0; di < 2; ++di)
#pragma unroll
        for (int i = 0; i < 16; ++i) oacc[di][i] = 0.f;
#pragma unroll
    for (int mi = 0; mi < 8; ++mi)
#pragma unroll
        for (int s2 = 0; s2 < 2; ++s2) {
            const bf16x8 pf = pack8(sa[mi][8 * s2], sa[mi][8 * s2 + 1], sa[mi][8 * s2 + 2], sa[mi][8 * s2 + 3], sa[mi][8 * s2 + 4], sa[mi][8 * s2 + 5], sa[mi][8 * s2 + 6], sa[mi][8 * s2 + 7]);
#pragma unroll
            for (int di = 0; di < 2; ++di) { const bf16x8 vf = *(const bf16x8*)(MVT + (size_t)(((b * 16 + 2 * mi + s2) * 4 + hd) * 2 + di) * 512 + lane * 8); oacc[di] = MFMA32(vf, pf, oacc[di]); }
        }
    const float inv = 1.0f / sum;
    LAS float* ssq = (LAS float*)lds;
    float v = 0.f;
#pragma unroll
    for (int di = 0; di < 2; ++di)
#pragma unroll
        for (int i = 0; i < 16; ++i) { oacc[di][i] *= inv; v += oacc[di][i] * oacc[di][i]; }
    v += xhalf(v);
    if (h == 0) ssq[(32 * qh + r) * 4 + hd] = v;
    LDS_BARRIER();
    const float tot = (ssq[(32 * qh + r) * 4 + 0] + ssq[(32 * qh + r) * 4 + 1]) + (ssq[(32 * qh + r) * 4 + 2] + ssq[(32 * qh + r) * 4 + 3]);
    const float rs = 1.0f / sqrtf(tot * (1.f / 256.f) + EPS);
    bf16* rowp = (bf16*)(ws + WS_CAT) + (tb + t0 + 32 * qh + r) * 1024 + 768 + hd * 64 + 8 * h;
#pragma unroll
    for (int di = 0; di < 2; ++di)
#pragma unroll
        for (int gp = 0; gp < 2; ++gp) { const int g0 = 2 * gp, g1 = 2 * gp + 1;
            const v4i o = pg::pair16((int)pg::cvt_pk_bf16(oacc[di][4 * g0] * rs, oacc[di][4 * g0 + 1] * rs), (int)pg::cvt_pk_bf16(oacc[di][4 * g0 + 2] * rs, oacc[di][4 * g0 + 3] * rs),
                                      (int)pg::cvt_pk_bf16(oacc[di][4 * g1] * rs, oacc[di][4 * g1 + 1] * rs), (int)pg::cvt_pk_bf16(oacc[di][4 * g1 + 2] * rs, oacc[di][4 * g1 + 3] * rs));
            *(v4i*)(rowp + 32 * di + 16 * gp) = o; }
    LDS_BARRIER();
}

constexpr int CV_U_OFF = 0, CV_ACT_OFF = 96256, CV_ACT_PITCH = 528, CV_SSQ_OFF = 65536;
static_assert(CV_ACT_OFF + 64 * CV_ACT_PITCH <= RING_BYTES, "conv LDS");
__device__ __forceinline__ void cv_unit(const Ptrs& p, LAS unsigned char* lds, int unit, int tid, int wave, int lane) {
    unsigned char* ws = p.ws;
    const int b = unit >> 5, t0 = (unit & 31) * 64;
    const size_t tb = (size_t)b * S;
    LAS float* U = (LAS float*)(lds + CV_U_OFF);
    const bf16* GLU = (const bf16*)(ws + WS_GLU);
    {
        v4u av[6], gv[6];
#pragma unroll
        for (int i = 0; i < 6; ++i) { const int it = tid + i * NWAVES * 64, row = it >> 5, ch = (it & 31) * 8, tl = t0 - (CONVK - 1) + row;
            if (it < 94 * 32 && tl >= 0) { av[i] = *(const v4u*)(GLU + (tb + tl) * 512 + ch); gv[i] = *(const v4u*)(GLU + (tb + tl) * 512 + 256 + ch); }
            else { av[i] = (v4u){0u, 0u, 0u, 0u}; gv[i] = (v4u){0u, 0u, 0u, 0u}; } }
#pragma unroll
        for (int i = 0; i < 6; ++i) { const int it = tid + i * NWAVES * 64, row = it >> 5, ch = (it & 31) * 8;
            if (it < 94 * 32) { float uu[8];
#pragma unroll
                for (int j = 0; j < 4; ++j) { const float a0 = bf2f(av[i][j] & 0xffffu), a1 = bf2f(av[i][j] >> 16), g0 = bf2f(gv[i][j] & 0xffffu), g1 = bf2f(gv[i][j] >> 16);
                    uu[2 * j] = a0 * __builtin_amdgcn_rcpf(1.0f + __builtin_amdgcn_exp2f(-1.44269504f * g0)); uu[2 * j + 1] = a1 * __builtin_amdgcn_rcpf(1.0f + __builtin_amdgcn_exp2f(-1.44269504f * g1)); }
                *(LAS f32x4*)(U + row * 256 + ch) = (f32x4){uu[0], uu[1], uu[2], uu[3]}; *(LAS f32x4*)(U + row * 256 + ch + 4) = (f32x4){uu[4], uu[5], uu[6], uu[7]}; } }
    }
    LDS_BARRIER();
    {
        const int c = tid & 255, th = tid >> 8;
        typedef float f2 __attribute__((ext_vector_type(2)));
        f2 wp[CONVK + 1], acc2[16];
        { float wprev = 0.f;
#pragma unroll
          for (int j = 0; j < CONVK; ++j) { const float wj = p.in[5][j * CVW + c]; wp[j] = (f2){wj, wprev}; wprev = wj; }
          wp[CONVK] = (f2){0.f, wprev}; }
        const float bd = p.in[6][c];
#pragma unroll
        for (int m = 0; m < 16; ++m) acc2[m] = (f2){bd, bd};
#pragma unroll
        for (int ii = 0; ii < 62; ++ii) { const float uv = U[(32 * th + ii) * 256 + c]; const f2 uv2 = (f2){uv, uv};
#pragma unroll
            for (int m = 0; m < 16; ++m) { const int j = ii - 2 * m; if (j >= 0 && j <= CONVK) acc2[m] = __builtin_elementwise_fma(wp[j], uv2, acc2[m]); } }
        float acc[32];
#pragma unroll
        for (int m = 0; m < 16; ++m) { acc[2 * m] = acc2[m].x; acc[2 * m + 1] = acc2[m].y; }
        LDS_BARRIER();
#pragma unroll
        for (int tt = 0; tt < 32; ++tt) U[(32 * th + tt) * 256 + c] = acc[tt];
    }
    LDS_BARRIER();
    {
        const f32x4 gl = *(const f32x4*)(p.in[7] + 4 * lane), bl = *(const f32x4*)(p.in[8] + 4 * lane);
#pragma unroll
        for (int k = 0; k < 8; ++k) { const int tok = 8 * wave + k;
            const f32x4 x = *(const LAS f32x4*)(U + tok * 256 + 4 * lane);
            const float mu = wave_sum((x.x + x.y) + (x.z + x.w)) * (1.f / 256.f);
            const f32x4 d = x - mu;
            const float rstd = 1.0f / sqrtf(wave_sum((d.x * d.x + d.y * d.y) + (d.z * d.z + d.w * d.w)) * (1.f / 256.f) + EPS);
            f32x4 y = d * rstd * gl + bl;
            y.x = y.x * __builtin_amdgcn_rcpf(1.0f + __builtin_amdgcn_exp2f(-1.44269504f * y.x)); y.y = y.y * __builtin_amdgcn_rcpf(1.0f + __builtin_amdgcn_exp2f(-1.44269504f * y.y)); y.z = y.z * __builtin_amdgcn_rcpf(1.0f + __builtin_amdgcn_exp2f(-1.44269504f * y.z)); y.w = y.w * __builtin_amdgcn_rcpf(1.0f + __builtin_amdgcn_exp2f(-1.44269504f * y.w));
            *(LAS unsigned long long*)(lds + CV_ACT_OFF + tok * CV_ACT_PITCH + 8 * lane) = (unsigned long long)pg::cvt_pk_bf16(y.x, y.y) | ((unsigned long long)pg::cvt_pk_bf16(y.z, y.w) << 32);
        }
    }
    LDS_BARRIER();
    {
        const int r = lane & 31, h = lane >> 5;
        const bf16* WT = (const bf16*)(ws + WS_WPW2);
        f32x16 acc[2];
#pragma unroll
        for (int ti = 0; ti < 2; ++ti)
#pragma unroll
            for (int i = 0; i < 16; ++i) acc[ti][i] = 0.f;
#pragma unroll 4
        for (int kk = 0; kk < 16; ++kk) {
            const bf16x8 af = *(const bf16x8*)(WT + (size_t)(32 * wave + r) * 256 + 16 * kk + 8 * h);
#pragma unroll
            for (int ti = 0; ti < 2; ++ti) { const bf16x8 bfr = *(const LAS bf16x8*)(lds + CV_ACT_OFF + (32 * ti + r) * CV_ACT_PITCH + (16 * kk + 8 * h) * 2); acc[ti] = MFMA32(af, bfr, acc[ti]); }
        }
        LAS float* ssq = (LAS float*)(lds + CV_SSQ_OFF);
#pragma unroll
        for (int g = 0; g < 4; ++g) { const f32x4 bb = *(const f32x4*)(p.in[10] + 32 * wave + 8 * g + 4 * h);
#pragma unroll
            for (int ti = 0; ti < 2; ++ti) { acc[ti][4 * g] += bb.x; acc[ti][4 * g + 1] += bb.y; acc[ti][4 * g + 2] += bb.z; acc[ti][4 * g + 3] += bb.w; } }
#pragma unroll
        for (int ti = 0; ti < 2; ++ti) { float v = 0.f;
#pragma unroll
            for (int i = 0; i < 16; ++i) v += acc[ti][i] * acc[ti][i];
            v += xhalf(v);
            if (h == 0) ssq[(32 * ti + r) * 8 + wave] = v; }
        LDS_BARRIER();
#pragma unroll
        for (int ti = 0; ti < 2; ++ti) { float tot = 0.f;
#pragma unroll
            for (int w2 = 0; w2 < 8; ++w2) tot += ssq[(32 * ti + r) * 8 + w2];
            const float rs = 1.0f / sqrtf(tot * (1.f / 256.f) + EPS);
            bf16* rowp = (bf16*)(ws + WS_CAT) + (tb + t0 + 32 * ti + r) * 1024 + 512 + 32 * wave + 8 * h;
#pragma unroll
            for (int gp = 0; gp < 2; ++gp) { const int g0 = 2 * gp, g1 = 2 * gp + 1;
                const v4i o = pg::pair16((int)pg::cvt_pk_bf16(acc[ti][4 * g0] * rs, acc[ti][4 * g0 + 1] * rs), (int)pg::cvt_pk_bf16(acc[ti][4 * g0 + 2] * rs, acc[ti][4 * g0 + 3] * rs),
                                          (int)pg::cvt_pk_bf16(acc[ti][4 * g1] * rs, acc[ti][4 * g1 + 1] * rs), (int)pg::cvt_pk_bf16(acc[ti][4 * g1 + 2] * rs, acc[ti][4 * g1 + 3] * rs));
                *(v4i*)(rowp + 16 * gp) = o; } }
    }
    LDS_BARRIER();
}

__global__ void __launch_bounds__(NWAVES * 64, 2) mk_fwd(MKArgs a) {
    extern __shared__ __attribute__((aligned(16))) unsigned char lds_raw[];
    LAS unsigned char* lds = (LAS unsigned char*)lds_raw;
    const int tid = threadIdx.x, lane = tid & 63, wave = __builtin_amdgcn_readfirstlane(tid >> 6);
    const int G = gridDim.x; const int bx = blockIdx.x; const int vcu = (G % 8 == 0) ? (bx % 8) * (G / 8) + bx / 8 : bx;
    unsigned char* ws = a.p.ws;
    const int lo = a.ph_lo, hi = a.ph_hi;
#define IN(k) (lo <= (k) && (k) < hi)
#define BOTH(k) (IN(k) && IN((k) + 1))
    volatile LAS unsigned* misc = (volatile LAS unsigned*)(lds + MISC_OFF);
    if (tid < 4) misc[tid] = 0u;
    __syncthreads();
    XcdBarrier bar; bar.bar = (unsigned*)(ws + WS_CTL) + CW_BAR + a.li * 4096; bar.x = 0; bar.st = misc;
    if (hi - lo > 1) bar = xcd_barrier_post((unsigned*)(ws + WS_CTL) + CW_BAR + a.li * 4096, misc);
    if (IN(0)) { for (int rep = 0; rep < NREP(0); ++rep) {
        float* scr = (float*)(lds_raw + RING_OFF + wave * 17408);
        const int gw = vcu * NWAVES + wave, NGW = G * NWAVES;
        const Ptrs& p = a.p;
        constexpr int I_IN = 16 * 72, I_OUT = 16 * 32, I_MKV = 16 * 16, I_PW2 = 4 * 8, I_GU = 32 * 8 * 64, I_DN = 32 * 8 * 32;
        constexpr int NIT = I_IN + I_OUT + I_MKV + I_PW2 + I_GU + I_DN;
        for (int it = gw; it < NIT; it += NGW) {
            int r = it;
            if (r < I_IN) { const int kb = r / 72, nb = r % 72; transpose_item(p.in[3], 1024, INW, (bf16*)(ws + WS_WIN), 64 * kb, 32 * nb, 32 * nb, nullptr, scr, lane); continue; } r -= I_IN;
            if (r < I_OUT) { const int kb = r / 32, nb = r % 32; const int k0 = 64 * kb;
                const float* ks = k0 < 512 ? p.in[13] : (k0 < 768 ? p.in[14] - 512 : p.in[15] - 768);
                transpose_item(p.in[16], 1024, 1024, (bf16*)(ws + WS_WOUT), k0, 32 * nb, 32 * nb, ks, scr, lane); continue; } r -= I_OUT;
            if (r < I_MKV) { const int kb = r / 16, nb = r % 16; transpose_item(p.in[12], 1024, 512, (bf16*)(ws + WS_WMKV), 64 * kb, 32 * nb, 32 * nb, nullptr, scr, lane); continue; } r -= I_MKV;
            if (r < I_PW2) { const int kb = r / 8, nb = r % 8; transpose_item(p.in[9], 256, 256, (bf16*)(ws + WS_WPW2), 64 * kb, 32 * nb, 32 * nb, nullptr, scr, lane); continue; } r -= I_PW2;
            if (r < I_GU) { const int e = r / 512, q = r % 512, kb = q / 64, nb = q % 64; const int n0 = 32 * nb, isup = n0 >> 10, cc = n0 & 1023, j = cc >> 7, c = cc & 127;
                transpose_item_fp8(p.in[20] + (size_t)e * 1024 * 2048, 1024, 2048, (unsigned char*)(ws + WS_WGU) + (size_t)e * 2048 * 1024, 128 * kb, n0, 256 * j + 128 * isup + c, scr, lane); continue; } r -= I_GU;
            { const int e = r / 256, q = r % 256, kb = q / 32, nb = q % 32;
                transpose_item_fp8(p.in[22] + (size_t)e * 1024 * 1024, 1024, 1024, (unsigned char*)(ws + WS_WDN) + (size_t)e * 1024 * 1024, 128 * kb, 32 * nb, 32 * nb, scr, lane); }
        }
        { f32x4 gg[4];
#pragma unroll
          for (int j = 0; j < 4; ++j) gg[j] = ((const f32x4*)p.in[2])[lane + 64 * j];
          for (int m = gw; m < T; m += NGW) rms_row_to_bf16(p.in[0] + (size_t)m * D, gg, (bf16*)(ws + WS_XN) + (size_t)m * D, lane);
#pragma unroll
          for (int j = 0; j < 4; ++j) gg[j] = ((const f32x4*)p.in[11])[lane + 64 * j];
          for (int m = gw; m < TM; m += NGW) rms_row_to_bf16(p.in[1] + (size_t)m * D, gg, (bf16*)(ws + WS_MEMN) + (size_t)m * D, lane); }
        __syncthreads(); }
        if (BOTH(0)) xcd_barrier(bar);
    }
    if (IN(1)) {
        SchedP1 Sc{G, vcu, ws, a.p.in[4]}; pg::EpiP1 E;
        for (int rep = 0; rep < NREP(1); ++rep) pg::gemm_phase<pg::EpiP1, SchedP1, false, false>(lds + RING_OFF, Sc, E, nullptr);
        if (BOTH(1)) xcd_barrier(bar);
    }
    if (IN(2)) {
        constexpr int NU2 = NB * (S / 64);
        for (int u = vcu; u < NU2 * NREP(20); u += G) sb_unit(ws, lds + RING_OFF, u & (NU2 - 1), wave, lane);
        for (int u = vcu; u < NU2 * NREP(21); u += G) mx_unit(ws, lds + RING_OFF, u & (NU2 - 1), wave, lane);
        for (int u = vcu; u < NU2 * NREP(22); u += G) cv_unit(a.p, lds + RING_OFF, u & (NU2 - 1), tid, wave, lane);
        if (BOTH(2)) xcd_barrier(bar);
    }
    if (IN(3)) {
        SchedP3 Sc{G, vcu, ws}; pg::EpiBf16 E;
        for (int rep = 0; rep < NREP(3); ++rep) pg::gemm_phase<pg::EpiBf16, SchedP3, false, false>(lds + RING_OFF, Sc, E, nullptr);
        if (BOTH(3)) xcd_barrier(bar);
    }
    if (IN(4)) {
#if REP_PHASE == 4
      for (int rep4 = 0; rep4 < 2; ++rep4) {
        if (rep4 == 1) { xcd_barrier(bar); if (blockIdx.x == 0 && tid < 32) __hip_atomic_store((unsigned*)(ws + WS_CTL) + CW_CNT + tid, 0u, __ATOMIC_RELAXED, __HIP_MEMORY_SCOPE_AGENT); xcd_barrier(bar); }
#else
      {
#endif
        const Ptrs& p = a.p;
        constexpr int HQP = 1028;
        LAS float* hq = (LAS float*)(lds + RING_OFF);
        LAS float* part = (LAS float*)(lds + RING_OFF + 16 * HQP * 4);
        LAS int* lcnt = (LAS int*)(lds + RING_OFF + 16 * HQP * 4 + 16384);
        LAS int* pend = (LAS int*)(lds + RING_OFF + 16 * HQP * 4 + 16384 + 256);
        const int e = lane & 31, hf = lane >> 5;
        float wreg[2][32];
#pragma unroll
        for (int nb = 0; nb < 2; ++nb)
#pragma unroll
            for (int q = 0; q < 32; ++q) wreg[nb][q] = p.in[18][(size_t)(128 * wave + 4 * q + (lane >> 4)) * NE + 16 * nb + (lane & 15)];
        const float bre = p.in[19][e];
        f32x4 gg4[4];
#pragma unroll
        for (int j = 0; j < 4; ++j) gg4[j] = ((const f32x4*)p.in[17])[lane + 64 * j];
        for (int blk = vcu; blk < T / 128; blk += G) {
        if (tid < 64) lcnt[tid] = 0;
        const int tokbase = blk * 128;
        f32x4 xr[2][4]; unsigned long long mr[2][4];
#pragma unroll
        for (int j2 = 0; j2 < 2; ++j2)
#pragma unroll
            for (int j = 0; j < 4; ++j) { const int tk = tokbase + 2 * wave + j2; xr[j2][j] = ((const f32x4*)(p.in[0] + (size_t)tk * D))[lane + 64 * j]; mr[j2][j] = ((const unsigned long long*)((const bf16*)(ws + WS_MIX) + (size_t)tk * D))[lane + 64 * j]; }
        for (int bt = 0; bt < 8; ++bt) {
#pragma unroll
            for (int j2 = 0; j2 < 2; ++j2) {
                const int tl = 2 * wave + j2, tok = tokbase + 16 * bt + tl;
                f32x4 v[4];
#pragma unroll
                for (int j = 0; j < 4; ++j) { const unsigned lo = (unsigned)mr[j2][j], hi = (unsigned)(mr[j2][j] >> 32); v[j] = (f32x4){xr[j2][j].x + bf2f(lo & 0xffffu), xr[j2][j].y + bf2f(lo >> 16), xr[j2][j].z + bf2f(hi & 0xffffu), xr[j2][j].w + bf2f(hi >> 16)}; }
                float s2 = 0.f;
#pragma unroll
                for (int j = 0; j < 4; ++j) { s2 += (v[j].x * v[j].x + v[j].y * v[j].y) + (v[j].z * v[j].z + v[j].w * v[j].w);
                    ((unsigned long long*)((bf16*)(ws + WS_HB) + (size_t)tok * D))[lane + 64 * j] = (unsigned long long)pk2(v[j].x, v[j].y) | ((unsigned long long)pk2(v[j].z, v[j].w) << 32); }
                const float rs = 1.0f / sqrtf(wave_sum(s2) * (1.f / D) + EPS);
                int* o4 = (int*)((unsigned char*)(ws + WS_HN) + (size_t)tok * D) + lane;
#pragma unroll
                for (int j = 0; j < 4; ++j) { const f32x4 gg = gg4[j]; f32x4 y; y.x = v[j].x * rs * gg.x; y.y = v[j].y * rs * gg.y; y.z = v[j].z * rs * gg.z; y.w = v[j].w * rs * gg.w;
                    { int w8 = 0; w8 = __builtin_amdgcn_cvt_pk_fp8_f32(y.x, y.y, w8, false); w8 = __builtin_amdgcn_cvt_pk_fp8_f32(y.z, y.w, w8, true); o4[64 * j] = w8; }
                    *(LAS f32x4*)(hq + tl * HQP + 4 * lane + 256 * j) = y; }
            }
            LDS_BARRIER();
            if (bt < 7) {
#pragma unroll
                for (int j2 = 0; j2 < 2; ++j2)
#pragma unroll
                    for (int j = 0; j < 4; ++j) { const int tk = tokbase + 16 * (bt + 1) + 2 * wave + j2; xr[j2][j] = ((const f32x4*)(p.in[0] + (size_t)tk * D))[lane + 64 * j]; mr[j2][j] = ((const unsigned long long*)((const bf16*)(ws + WS_MIX) + (size_t)tk * D))[lane + 64 * j]; }
            }
            {
                f32x4 d0 = (f32x4){0.f, 0.f, 0.f, 0.f}, d1 = d0;
                const LAS float* ap = hq + (lane & 15) * HQP + 128 * wave + (lane >> 4);
#pragma unroll
                for (int q = 0; q < 32; ++q) { const float av = ap[4 * q];
                    d0 = __builtin_amdgcn_mfma_f32_16x16x4f32(av, wreg[0][q], d0, 0, 0, 0);
                    d1 = __builtin_amdgcn_mfma_f32_16x16x4f32(av, wreg[1][q], d1, 0, 0, 0); }
#pragma unroll
                for (int i = 0; i < 4; ++i) { part[(wave * 16 + 4 * (lane >> 4) + i) * 32 + (lane & 15)] = d0[i]; part[(wave * 16 + 4 * (lane >> 4) + i) * 32 + 16 + (lane & 15)] = d1[i]; }
            }
            LDS_BARRIER();
#pragma unroll
            for (int j2 = 0; j2 < 2; ++j2) {
                const int tl = 2 * wave + j2;
                float lg = bre;
#pragma unroll
                for (int w2 = 0; w2 < 8; ++w2) lg += part[(w2 * 16 + tl) * 32 + e];
                int my_e = 0; float my_v = 0.f, m0 = 0.f;
#pragma unroll
                for (int k = 0; k < 4; ++k) {
                    const float m = wave_max(lg);
                    const unsigned long long bal = __ballot(lg == m);
                    const int idx = (int)(__ffsll((long long)bal) - 1) & 31;
                    if (lane == k) { my_e = idx; my_v = m; }
                    if (k == 0) m0 = m;
                    if (e == idx) lg = -3.0e38f;
                }
                const float exv = (lane < 4) ? __expf(my_v - m0) : 0.f;
                const float es = __shfl(exv, 0) + __shfl(exv, 1) + __shfl(exv, 2) + __shfl(exv, 3);
                if (lane < 4) {
                    const int rank = __hip_atomic_fetch_add(lcnt + my_e, 1, __ATOMIC_RELAXED, __HIP_MEMORY_SCOPE_WORKGROUP);
                    LAS int* pe = pend + ((16 * bt + tl) * 4 + lane) * 3;
                    pe[0] = my_e; pe[1] = rank; pe[2] = __float_as_int(exv / es);
                }
            }
        }
        LDS_BARRIER();
        if (tid < 32) { const int n = lcnt[tid]; lcnt[32 + tid] = n > 0 ? (int)atomicAdd((unsigned*)(ws + WS_CTL) + CW_CNT + tid, (unsigned)n) : 0; }
        LDS_BARRIER();
        { const int tl = tid >> 2, k = tid & 3, tok = tokbase + tl;
            const LAS int* pe = pend + tid * 3; const int ee = pe[0], slot = lcnt[32 + ee] + pe[1];
            ((int*)(ws + WS_LIST))[(size_t)ee * T + slot] = tok;
            ((int*)(ws + WS_TOKE))[tok * 4 + k] = ee;
            ((int*)(ws + WS_TOKS))[tok * 4 + k] = slot;
            ((float*)(ws + WS_TOKG))[tok * 4 + k] = __int_as_float(pe[2]); }
        LDS_BARRIER();
        }
      }
        if (BOTH(4)) xcd_barrier(bar);
    }
    if (IN(5)) {
        LAS int* ut = (LAS int*)(lds + UTAB_OFF); LAS unsigned* gt = (LAS unsigned*)(lds + GTAB_OFF);
        moe_tables<8>(ut, (const unsigned*)(ws + WS_CTL) + CW_CNT, G, vcu, tid);
        for (int i = 0; i < MAXU; ++i) {
            const int e = ut[UT_UNIT + 4 * i]; if (e < 0) break;
            if (tid < 256) { const int row = ut[UT_UNIT + 4 * i + 1] * 256 + tid, c = ut[UT_CNT + e]; const int src = row < c ? row : c - 1;
                gt[i * 256 + tid] = (unsigned)((const int*)(ws + WS_LIST))[(size_t)e * T + src] * 1024u; }
        }
        __syncthreads();
        SchedGU Sc{ut, ws, a.p.in[21]}; pg::EpiSwiGLU E;
        for (int rep = 0; rep < NREP(5); ++rep) pg::gemm_phase<pg::EpiSwiGLU, SchedGU, true, true>(lds + RING_OFF, Sc, E, gt);
        if (BOTH(5)) xcd_barrier(bar);
    }
    if (IN(6)) {
        LAS int* ut = (LAS int*)(lds + UTAB_OFF);
        moe_tables<4>(ut, (const unsigned*)(ws + WS_CTL) + CW_CNT, G, vcu, tid);
        SchedDN Sc{ut, ws, a.p.in[23]}; pg::EpiFp8 E;
        for (int rep = 0; rep < NREP(6); ++rep) { E.nostore = (rep < NREP(6) - 1); pg::gemm_phase<pg::EpiFp8, SchedDN, false, true>(lds + RING_OFF, Sc, E, nullptr); }
        if (BOTH(6)) xcd_barrier(bar);
    }
    if (IN(7)) {
        const Ptrs& p = a.p;
        LAS int* ut = (LAS int*)(lds + UTAB_OFF);
        moe_tables<4>(ut, (const unsigned*)(ws + WS_CTL) + CW_CNT, G, vcu, tid);
        const int gw = vcu * NWAVES + wave, NGW = G * NWAVES;
        f32x4 gg4[4];
#pragma unroll
        for (int j = 0; j < 4; ++j) gg4[j] = ((const f32x4*)p.in[24])[lane + 64 * j];
        for (int rep7 = 0; rep7 < NREP(7); ++rep7)
        for (int tok0 = gw * 2; tok0 < T; tok0 += NGW * 2) {
            float* const dst = p.out;
            f32x4 v[2][4]; unsigned yv[2][4][4]; float gts[2][4];
#pragma unroll
            for (int j2 = 0; j2 < 2; ++j2) {
                const int tok = tok0 + j2;
#pragma unroll
                for (int j = 0; j < 4; ++j) { const unsigned long long m = ((const unsigned long long*)((const bf16*)(ws + WS_HB) + (size_t)tok * D))[lane + 64 * j]; const unsigned lo_ = (unsigned)m, hi_ = (unsigned)(m >> 32);
                    v[j2][j] = (f32x4){bf2f(lo_ & 0xffffu), bf2f(lo_ >> 16), bf2f(hi_ & 0xffffu), bf2f(hi_ >> 16)}; }
                const int4 ev = *(const int4*)((const int*)(ws + WS_TOKE) + tok * 4), sv = *(const int4*)((const int*)(ws + WS_TOKS) + tok * 4); const f32x4 gv = *(const f32x4*)((const float*)(ws + WS_TOKG) + tok * 4);
                const int es[4] = {ev.x, ev.y, ev.z, ev.w}, ss[4] = {sv.x, sv.y, sv.z, sv.w};
                gts[j2][0] = gv.x; gts[j2][1] = gv.y; gts[j2][2] = gv.z; gts[j2][3] = gv.w;
#pragma unroll
                for (int k = 0; k < 4; ++k) {
                    const unsigned* y4 = (const unsigned*)((const unsigned char*)(ws + WS_Y) + (size_t)(ut[UT_PST + es[k]] + ss[k]) * 1024) + lane;
#pragma unroll
                    for (int j = 0; j < 4; ++j) yv[j2][k][j] = y4[64 * j];
                }
            }
#pragma unroll
            for (int j2 = 0; j2 < 2; ++j2) {
                const int tok = tok0 + j2;
#pragma unroll
                for (int k = 0; k < 4; ++k) { const float gt = gts[j2][k];
#pragma unroll
                    for (int j = 0; j < 4; ++j) { const int w = (int)yv[j2][k][j];
                        v[j2][j].x += gt * __builtin_amdgcn_cvt_f32_fp8(w, 0); v[j2][j].y += gt * __builtin_amdgcn_cvt_f32_fp8(w, 1); v[j2][j].z += gt * __builtin_amdgcn_cvt_f32_fp8(w, 2); v[j2][j].w += gt * __builtin_amdgcn_cvt_f32_fp8(w, 3); } }
                float s2 = 0.f;
#pragma unroll
                for (int j = 0; j < 4; ++j) s2 += (v[j2][j].x * v[j2][j].x + v[j2][j].y * v[j2][j].y) + (v[j2][j].z * v[j2][j].z + v[j2][j].w * v[j2][j].w);
                const float rs = 1.0f / sqrtf(wave_sum(s2) * (1.f / D) + EPS);
#pragma unroll
                for (int j = 0; j < 4; ++j) { const f32x4 gg = gg4[j]; f32x4 y; y.x = v[j2][j].x * rs * gg.x; y.y = v[j2][j].y * rs * gg.y; y.z = v[j2][j].z * rs * gg.z; y.w = v[j2][j].w * rs * gg.w; ((f32x4*)(dst + (size_t)tok * D))[lane + 64 * j] = y; }
            }
        }
    }
#undef IN
#undef BOTH
}

extern "C" void kernel_launch(void* const* d_in, const int* in_sizes, int n_in, void* d_out, int out_size, void* d_ws, size_t ws_size, hipStream_t stream) {
    if (n_in != 25 || out_size != T * D || ws_size < WS_END) { fprintf(stderr, "kernel_launch: unexpected shapes n_in %d out %d ws %zu\n", n_in, out_size, ws_size); return; }
    Ptrs p{};
    for (int i = 0; i < 25; ++i) p.in[i] = (const float*)d_in[i];
    p.out = (float*)d_out; p.ws = (unsigned char*)d_ws;
    (void)hipMemsetAsync((char*)d_ws + WS_CTL, 0, CTL_BYTES, stream);
    static int grid = 0;
    if (grid == 0) {
        int dev = 0, cus = 0;
        if (hipGetDevice(&dev) != hipSuccess || hipDeviceGetAttribute(&cus, hipDeviceAttributeMultiprocessorCount, dev) != hipSuccess) { grid = -1; return; }
        if (hipFuncSetAttribute((const void*)mk_fwd, hipFuncAttributeMaxDynamicSharedMemorySize, LDS_BYTES) != hipSuccess) { fprintf(stderr, "hipFuncSetAttribute failed\n"); grid = -1; return; }
        int per_cu = 0;
        if (hipOccupancyMaxActiveBlocksPerMultiprocessor(&per_cu, (const void*)mk_fwd, NWAVES * 64, LDS_BYTES) != hipSuccess || per_cu < 1) { fprintf(stderr, "occupancy query: %d\n", per_cu); }
        (void)hipGetLastError();
        grid = cus;
    }
    if (grid < 0) return;
#if defined(PROBE_SPLIT)
    { const int k = PROBE_SPLIT; const int reps = PROBE_REPS;
      MKArgs a{}; a.p = p; a.ph_lo = 0; a.ph_hi = k + 1; a.li = 0; hipLaunchKernelGGL(mk_fwd, dim3(grid), dim3(NWAVES * 64), LDS_BYTES, stream, a);
      for (int r = 0; r < reps; ++r) { if (k == 4) (void)hipMemsetAsync((char*)d_ws + WS_CTL + CW_CNT * 4, 0, 128, stream);
          a.ph_lo = k; a.ph_hi = k + 1; hipLaunchKernelGGL(mk_fwd, dim3(grid), dim3(NWAVES * 64), LDS_BYTES, stream, a); }
      a.ph_lo = k + 1; a.ph_hi = 8; a.li = 1; hipLaunchKernelGGL(mk_fwd, dim3(grid), dim3(NWAVES * 64), LDS_BYTES, stream, a); }
#elif !defined(MK_PER_PHASE)
    { MKArgs a{}; a.p = p; a.ph_lo = 0; a.ph_hi = 8; hipLaunchKernelGGL(mk_fwd, dim3(grid), dim3(NWAVES * 64), LDS_BYTES, stream, a); }
#else
    for (int ph = 0; ph < 8; ++ph) { MKArgs a{}; a.p = p; a.ph_lo = ph; a.ph_hi = ph + 1; hipLaunchKernelGGL(mk_fwd, dim3(grid), dim3(NWAVES * 64), LDS_BYTES, stream, a); }
#endif
}
```

```cpp
#include <hip/hip_runtime.h>
#include <cstdio>
#include <cstdint>

typedef unsigned short bf16;
typedef unsigned v4u __attribute__((ext_vector_type(4)));
typedef float f32x4 __attribute__((ext_vector_type(4)));

constexpr int NB = 16, S = 2048, T = NB * S, D = 1024;
constexpr int SBH = 8, HD = 64, SBW = 512, CVW = 256, MXH = 4, MXW = 256, INW = 2304, NMEM = 256, TM = NB * NMEM;
constexpr int NE = 32, TOPK = 4, DFF = 1024, CONVK = 31;
constexpr int PMAX = T * TOPK + NE * 256;
constexpr float EPS = 1e-6f;
constexpr float SB_EXIT_LIN = 4.2483543e-18f;

constexpr size_t MiB = 1u << 20;
constexpr size_t WS_CTL = 0, CTL_BYTES = 64 * 1024;
constexpr size_t WS_WIN = 2 * MiB;
constexpr size_t WS_WOUT = 7 * MiB;
constexpr size_t WS_WMKV = 9 * MiB;
constexpr size_t WS_WPW2 = 10 * MiB;
constexpr size_t WS_WGU = 16 * MiB;
constexpr size_t WS_WDN = 144 * MiB;
constexpr size_t WS_MEMN = 208 * MiB;
constexpr size_t WS_MEMK = 216 * MiB;
constexpr size_t WS_MEMVT = 218 * MiB;
constexpr size_t WS_LIST = 220 * MiB;
constexpr size_t WS_TOKE = 224 * MiB;
constexpr size_t WS_TOKS = 224 * MiB + 512 * 1024;
constexpr size_t WS_TOKG = 225 * MiB;
constexpr size_t WS_HN = 226 * MiB;
constexpr size_t WS_XN = 290 * MiB;
constexpr size_t WS_Q = 354 * MiB;
constexpr size_t WS_K = 386 * MiB;
constexpr size_t WS_VT = 418 * MiB;
constexpr size_t WS_GLU = 450 * MiB;
constexpr size_t WS_QMX = 482 * MiB;
constexpr size_t WS_CAT = 498 * MiB;
constexpr size_t WS_HACT = 562 * MiB;
constexpr size_t WS_Y = 290 * MiB;
constexpr size_t WS_MIX = 700 * MiB;
constexpr size_t WS_HB = 764 * MiB;
constexpr size_t WS_END = 834 * MiB;
constexpr size_t WS_OSB = 562 * MiB;
constexpr size_t WS_OCV = 626 * MiB;
constexpr size_t WS_OMX = 658 * MiB;
static_assert((size_t)PMAX * 1024 * 2 == 272 * MiB, "padded rows");
constexpr int CW_CNT = 64;
constexpr float W8_SCALE = 32.0f;

__device__ __forceinline__ float bf2f(unsigned v) { return __uint_as_float(v << 16); }
__device__ __forceinline__ unsigned f2bf(float f) { unsigned u = __float_as_uint(f); return (u + 0x7fffu + ((u >> 16) & 1u)) >> 16; }
__device__ __forceinline__ unsigned pk2(float lo, float hi) { return f2bf(lo) | (f2bf(hi) << 16); }
__device__ __forceinline__ float wave_sum(float v) {
    v += __int_as_float(__builtin_amdgcn_mov_dpp(__float_as_int(v), 0xB1, 0xf, 0xf, true));
    v += __int_as_float(__builtin_amdgcn_mov_dpp(__float_as_int(v), 0x4E, 0xf, 0xf, true));
    v += __int_as_float(__builtin_amdgcn_mov_dpp(__float_as_int(v), 0x141, 0xf, 0xf, true));
    v += __int_as_float(__builtin_amdgcn_mov_dpp(__float_as_int(v), 0x140, 0xf, 0xf, true));
    const int iv = __float_as_int(v);
    return (__int_as_float(__builtin_amdgcn_readlane(iv, 0)) + __int_as_float(__builtin_amdgcn_readlane(iv, 16))) + (__int_as_float(__builtin_amdgcn_readlane(iv, 32)) + __int_as_float(__builtin_amdgcn_readlane(iv, 48)));
}
__device__ __forceinline__ float wave_max(float v) {
    v = fmaxf(v, __int_as_float(__builtin_amdgcn_mov_dpp(__float_as_int(v), 0xB1, 0xf, 0xf, true)));
    v = fmaxf(v, __int_as_float(__builtin_amdgcn_mov_dpp(__float_as_int(v), 0x4E, 0xf, 0xf, true)));
    v = fmaxf(v, __int_as_float(__builtin_amdgcn_mov_dpp(__float_as_int(v), 0x141, 0xf, 0xf, true)));
    v = fmaxf(v, __int_as_float(__builtin_amdgcn_mov_dpp(__float_as_int(v), 0x140, 0xf, 0xf, true)));
    const int iv = __float_as_int(v);
    return fmaxf(fmaxf(__int_as_float(__builtin_amdgcn_readlane(iv, 0)), __int_as_float(__builtin_amdgcn_readlane(iv, 16))), fmaxf(__int_as_float(__builtin_amdgcn_readlane(iv, 32)), __int_as_float(__builtin_amdgcn_readlane(iv, 48))));
}

__device__ __forceinline__ float xhalf(float v) {
    const auto r = __builtin_amdgcn_permlane32_swap(__float_as_uint(v), __float_as_uint(v), false, false);
    return __uint_as_float((threadIdx.x & 32) ? r[0] : r[1]);
}
__device__ __forceinline__ void transpose_item(const float* W, int K, int N, bf16* WT, int k0, int n0, int dstrow0, const float* kscale, float* scr, int lane) {
    float vv[32];
#pragma unroll
    for (int i = 0; i < 32; ++i) { const int kk = 2 * i + (lane >> 5); vv[i] = W[(size_t)(k0 + kk) * N + n0 + (lane & 31)]; }
#pragma unroll
    for (int i = 0; i < 32; ++i) { const int kk = 2 * i + (lane >> 5); float v = vv[i]; if (kscale) v *= kscale[k0 + kk]; scr[kk * 33 + (lane & 31)] = v; }
    asm volatile("s_waitcnt lgkmcnt(0)" ::: "memory");
    const int c = lane & 7;
#pragma unroll
    for (int j = 0; j < 4; ++j) { const int n = (lane >> 3) + 8 * j; const float* s = scr + (8 * c) * 33 + n;
        v4u o; o.x = pk2(s[0 * 33], s[1 * 33]); o.y = pk2(s[2 * 33], s[3 * 33]); o.z = pk2(s[4 * 33], s[5 * 33]); o.w = pk2(s[6 * 33], s[7 * 33]);
        *(v4u*)(WT + (size_t)(dstrow0 + n) * K + k0 + 8 * c) = o; }
    asm volatile("s_waitcnt lgkmcnt(0)" ::: "memory");
}
__device__ __forceinline__ void transpose_item_fp8(const float* W, int K, int N, unsigned char* WT, int k0, int n0, int dstrow0, float* scr, int lane) {
    float vv[64];
#pragma unroll
    for (int i = 0; i < 64; ++i) { const int kk = 2 * i + (lane >> 5); vv[i] = W[(size_t)(k0 + kk) * N + n0 + (lane & 31)]; }
#pragma unroll
    for (int i = 0; i < 64; ++i) { const int kk = 2 * i + (lane >> 5); scr[kk * 33 + (lane & 31)] = vv[i] * W8_SCALE; }
    asm volatile("s_waitcnt lgkmcnt(0)" ::: "memory");
    const int c = lane & 15;
#pragma unroll
    for (int j = 0; j < 8; ++j) { const int n = (lane >> 4) + 4 * j; const float* s = scr + (8 * c) * 33 + n;
        int w0 = 0, w1 = 0;
        w0 = __builtin_amdgcn_cvt_pk_fp8_f32(s[0 * 33], s[1 * 33], w0, false); w0 = __builtin_amdgcn_cvt_pk_fp8_f32(s[2 * 33], s[3 * 33], w0, true);
        w1 = __builtin_amdgcn_cvt_pk_fp8_f32(s[4 * 33], s[5 * 33], w1, false); w1 = __builtin_amdgcn_cvt_pk_fp8_f32(s[6 * 33], s[7 * 33], w1, true);
        *(unsigned long long*)(WT + (size_t)(dstrow0 + n) * K + k0 + 8 * c) = (unsigned long long)(unsigned)w0 | ((unsigned long long)(unsigned)w1 << 32); }
    asm volatile("s_waitcnt lgkmcnt(0)" ::: "memory");
}
__device__ __forceinline__ void rms_row_to_bf16(const float* xrow, const f32x4 (&gg)[4], bf16* orow, int lane) {
    const f32x4* xr = (const f32x4*)xrow + lane;
    f32x4 v[4]; float s = 0.f;
#pragma unroll
    for (int j = 0; j < 4; ++j) { v[j] = xr[64 * j]; s += (v[j].x * v[j].x + v[j].y * v[j].y) + (v[j].z * v[j].z + v[j].w * v[j].w); }
    const float rs = 1.0f / sqrtf(wave_sum(s) * (1.f / D) + EPS);
    unsigned long long* o8 = (unsigned long long*)orow + lane;
#pragma unroll
    for (int j = 0; j < 4; ++j) o8[64 * j] = (unsigned long long)pk2(v[j].x * rs * gg[j].x, v[j].y * rs * gg[j].y) | ((unsigned long long)pk2(v[j].z * rs * gg[j].z, v[j].w * rs * gg[j].w) << 32);
}

struct Ptrs {
    const float* in[25]; float* out; unsigned char* ws;
};

#define LAS __attribute__((address_space(3)))
typedef short bf16x8 __attribute__((ext_vector_type(8)));
typedef unsigned u32x4 __attribute__((ext_vector_type(4)));
typedef int v4i __attribute__((ext_vector_type(4)));
typedef int v8i __attribute__((ext_vector_type(8)));
namespace pg {
constexpr int BM = 256, BK = 64, HALF = 128, HTB = HALF * BK * 2, STAGE_BYTES = 8 * HTB, GK = 1024;
__host__ __device__ __forceinline__ int lds_byte(int r, int c) { const int st = (r >> 4) * 2 + (c >> 5), rr = r & 15, cc = c & 31, ob = rr * 64 + cc * 2; return st * 1024 + (ob ^ (((ob >> 9) & 1) << 5)); }
__host__ __device__ __forceinline__ void stage_rc(int b, int& R, int& C) { const int st = b / 1024, sb = b % 1024, swz = sb ^ (((sb >> 9) & 1) << 5); R = (st >> 1) * 16 + swz / 64; C = (st & 1) * 32 + (swz % 64) / 2; }
__host__ __device__ __forceinline__ int perm32(int rho) { const int n = rho >> 4, i = rho & 15; return 8 * (i >> 2) + 4 * n + (i & 3); }
__host__ __device__ __forceinline__ int chi4(int fq) { return ((fq & 1) << 1) | (fq >> 1); }
__host__ __device__ __forceinline__ int perm32x(int rho) { const int n = rho >> 4, i = rho & 15; return 8 * chi4(i >> 2) + 4 * n + (i & 3); }
__device__ __forceinline__ unsigned cvt_pk_bf16(float lo, float hi) { unsigned r; asm volatile("v_cvt_pk_bf16_f32 %0, %1, %2" : "=v"(r) : "v"(lo), "v"(hi)); return r; }

struct GU {
    const char* A;
    const char* B;
    char* O;
    const float* bias;
    int ldc; float scale; int gslot; int kind;
    int row0, col0;
};

struct EpiBf16 {
    static constexpr int PERM = 1; bool nostore = false;
    __device__ __forceinline__ void operator()(const f32x4 (&acc)[2][2][4][2], const GU& u, int wr, int wc, int fr, int fq) const {
        bf16* base = (bf16*)u.O + (size_t)(wr * 64 + fr) * u.ldc + wc * 32 + 8 * fq; const float sc = u.scale;
        f32x4 bv[2][2];
#pragma unroll
        for (int bj = 0; bj < 2; ++bj)
#pragma unroll
            for (int n = 0; n < 2; ++n) bv[bj][n] = u.bias ? *(const f32x4*)(u.bias + bj * HALF + wc * 32 + 8 * fq + 4 * n) : (f32x4){0.f, 0.f, 0.f, 0.f};
#pragma unroll
        for (int ai = 0; ai < 2; ++ai)
#pragma unroll
            for (int m = 0; m < 4; ++m) { bf16* rowp = base + (size_t)(ai * HALF + m * 16) * u.ldc;
#pragma unroll
                for (int bj = 0; bj < 2; ++bj) { const f32x4 v0 = acc[ai][bj][m][0] * sc + bv[bj][0], v1 = acc[ai][bj][m][1] * sc + bv[bj][1];
                    u32x4 w; w.x = cvt_pk_bf16(v0[0], v0[1]); w.y = cvt_pk_bf16(v0[2], v0[3]); w.z = cvt_pk_bf16(v1[0], v1[1]); w.w = cvt_pk_bf16(v1[2], v1[3]);
                    if (!nostore) *(u32x4*)(rowp + bj * HALF) = w; } }
    }
};
__device__ __forceinline__ v4i pair16(int a0, int a1, int b0, int b1) {
    const auto s0 = __builtin_amdgcn_permlane32_swap((unsigned)a0, (unsigned)b0, false, false);
    const auto s1 = __builtin_amdgcn_permlane32_swap((unsigned)a1, (unsigned)b1, false, false);
    return (v4i){(int)s0[0], (int)s1[0], (int)s0[1], (int)s1[1]};
}
struct EpiFp8 {
    static constexpr int PERM = 2; bool nostore = false;
    __device__ __forceinline__ void operator()(const f32x4 (&acc)[2][2][4][2], const GU& u, int wr, int wc, int fr, int fq) const {
        const int cx = 8 * chi4(fq);
        unsigned char* base = (unsigned char*)u.O + (size_t)(wr * 64 + fr + (fq >> 1) * 16) * u.ldc + wc * 32 + 16 * (fq & 1); const float sc = u.scale;
        f32x4 bv[2][2];
#pragma unroll
        for (int bj = 0; bj < 2; ++bj)
#pragma unroll
            for (int n = 0; n < 2; ++n) bv[bj][n] = *(const f32x4*)(u.bias + bj * HALF + wc * 32 + cx + 4 * n);
#pragma unroll
        for (int ai = 0; ai < 2; ++ai)
#pragma unroll
            for (int mp = 0; mp < 2; ++mp)
#pragma unroll
                for (int bj = 0; bj < 2; ++bj) { int w[2][2];
#pragma unroll
                    for (int q = 0; q < 2; ++q) { const int m = 2 * mp + q; const f32x4 v0 = acc[ai][bj][m][0] * sc + bv[bj][0], v1 = acc[ai][bj][m][1] * sc + bv[bj][1];
                        int w0 = 0, w1 = 0;
                        w0 = __builtin_amdgcn_cvt_pk_fp8_f32(v0[0], v0[1], w0, false); w0 = __builtin_amdgcn_cvt_pk_fp8_f32(v0[2], v0[3], w0, true);
                        w1 = __builtin_amdgcn_cvt_pk_fp8_f32(v1[0], v1[1], w1, false); w1 = __builtin_amdgcn_cvt_pk_fp8_f32(v1[2], v1[3], w1, true);
                        w[q][0] = w0; w[q][1] = w1; }
                    const v4i o = pair16(w[0][0], w[0][1], w[1][0], w[1][1]);
                    if (!nostore) *(v4i*)(base + (size_t)(ai * HALF + mp * 32) * u.ldc + bj * HALF) = o; }
    }
};
struct EpiP1 {
    static constexpr int PERM = 1;
    __device__ __forceinline__ void operator()(const f32x4 (&acc)[2][2][4][2], const GU& u, int wr, int wc, int fr, int fq) const {
        const float sc = u.scale; const int H = u.ldc;
        f32x4 bv[2][2];
#pragma unroll
        for (int bj = 0; bj < 2; ++bj)
#pragma unroll
            for (int n = 0; n < 2; ++n) bv[bj][n] = u.bias ? *(const f32x4*)(u.bias + bj * HALF + wc * 32 + 8 * fq + 4 * n) : (f32x4){0.f, 0.f, 0.f, 0.f};
#pragma unroll
        for (int ai = 0; ai < 2; ++ai)
#pragma unroll
            for (int m = 0; m < 4; ++m) { const int rr = ai * HALF + wr * 64 + m * 16 + fr;
#pragma unroll
                for (int bj = 0; bj < 2; ++bj) { const int cc = bj * HALF + wc * 32 + 8 * fq;
                    const f32x4 v0 = acc[ai][bj][m][0] * sc + bv[bj][0], v1 = acc[ai][bj][m][1] * sc + bv[bj][1];
                    const unsigned w0 = cvt_pk_bf16(v0[0], v0[1]), w1 = cvt_pk_bf16(v0[2], v0[3]), w2 = cvt_pk_bf16(v1[0], v1[1]), w3 = cvt_pk_bf16(v1[2], v1[3]);
                    if (u.kind == 0) { u32x4 w; w.x = w0; w.y = w1; w.z = w2; w.w = w3; *(u32x4*)((bf16*)u.O + (size_t)rr * u.ldc + cc) = w; }
                    else if (u.kind == 1) { const int row = u.row0 + rr, col = u.col0 + cc, hd = col >> 6, d = col & 63;
                        const size_t off = ((((size_t)(row >> 5) * H + hd) * 4 + (d >> 4)) * 64 + ((d >> 3) & 1) * 32 + (row & 31)) * 8;
                        u32x4 w; w.x = w0; w.y = w1; w.z = w2; w.w = w3; *(u32x4*)((bf16*)u.O + off) = w; }
                    else { const int f = u.row0 + rr, key = u.col0 + cc, hd = f >> 6, d = f & 63;
                        const size_t off = ((((size_t)(key >> 4) * H + hd) * 2 + (d >> 5)) * 64 + (d & 31)) * 8 + ((key >> 3) & 1) * 4;
                        *(unsigned long long*)((bf16*)u.O + off) = (unsigned long long)w0 | ((unsigned long long)w1 << 32);
                        *(unsigned long long*)((bf16*)u.O + off + 32 * 8) = (unsigned long long)w2 | ((unsigned long long)w3 << 32); }
                } }
    }
};
struct EpiSwiGLU {
    static constexpr int PERM = 2;
    __device__ __forceinline__ void operator()(const f32x4 (&acc)[2][2][4][2], const GU& u, int wr, int wc, int fr, int fq) const {
        typedef float f2 __attribute__((ext_vector_type(2)));
        const int cx = 8 * chi4(fq);
        unsigned char* base = (unsigned char*)u.O + (size_t)(wr * 64 + fr + (fq >> 1) * 16) * u.ldc + wc * 32 + 16 * (fq & 1); const float sc = u.scale;
        constexpr float C = -1.702f * 1.44269504f;
        f2 bg[4], bt[4], bu[4];
#pragma unroll
        for (int n = 0; n < 2; ++n) { const f32x4 g4 = *(const f32x4*)(u.bias + wc * 32 + cx + 4 * n), u4 = *(const f32x4*)(u.bias + 1024 + wc * 32 + cx + 4 * n);
            bg[2 * n] = (f2){g4[0], g4[1]}; bg[2 * n + 1] = (f2){g4[2], g4[3]}; bt[2 * n] = bg[2 * n] * C; bt[2 * n + 1] = bg[2 * n + 1] * C;
            bu[2 * n] = (f2){u4[0] + 1.0f, u4[1] + 1.0f}; bu[2 * n + 1] = (f2){u4[2] + 1.0f, u4[3] + 1.0f}; }
        const f2 sc2 = (f2){sc, sc}, sct = (f2){sc * C, sc * C};
#pragma unroll
        for (int ai = 0; ai < 2; ++ai)
#pragma unroll
            for (int mp = 0; mp < 2; ++mp) { int w[2][2];
#pragma unroll
                for (int qq = 0; qq < 2; ++qq) { const int m = 2 * mp + qq; f2 h[4];
#pragma unroll
                    for (int q = 0; q < 4; ++q) { const int n = q >> 1, j = (q & 1) * 2;
                        const f2 ag = (f2){acc[ai][0][m][n][j], acc[ai][0][m][n][j + 1]}, au = (f2){acc[ai][1][m][n][j], acc[ai][1][m][n][j + 1]};
                        f2 g = __builtin_elementwise_fma(ag, sc2, bg[q]), t = __builtin_elementwise_fma(ag, sct, bt[q]), up = __builtin_elementwise_fma(au, sc2, bu[q]);
                        g.x = fminf(g.x, 7.0f); g.y = fminf(g.y, 7.0f); t.x = fmaxf(t.x, 7.0f * C); t.y = fmaxf(t.y, 7.0f * C);
                        up.x = __builtin_amdgcn_fmed3f(up.x, -6.0f, 8.0f); up.y = __builtin_amdgcn_fmed3f(up.y, -6.0f, 8.0f);
                        f2 d; d.x = __builtin_amdgcn_exp2f(t.x); d.y = __builtin_amdgcn_exp2f(t.y); d = d + 1.0f;
                        f2 r; r.x = __builtin_amdgcn_rcpf(d.x); r.y = __builtin_amdgcn_rcpf(d.y);
                        h[q] = (up * g) * r; }
                    int w0 = 0, w1 = 0;
                    w0 = __builtin_amdgcn_cvt_pk_fp8_f32(h[0].x, h[0].y, w0, false); w0 = __builtin_amdgcn_cvt_pk_fp8_f32(h[1].x, h[1].y, w0, true);
                    w1 = __builtin_amdgcn_cvt_pk_fp8_f32(h[2].x, h[2].y, w1, false); w1 = __builtin_amdgcn_cvt_pk_fp8_f32(h[3].x, h[3].y, w1, true);
                    w[qq][0] = w0; w[qq][1] = w1; }
                *(v4i*)(base + (size_t)(ai * HALF + mp * 32) * u.ldc) = pair16(w[0][0], w[0][1], w[1][0], w[1][1]); }
    }
};

#ifndef STAGGER_TICKS
#define STAGGER_TICKS 0
#endif
template <class Epi, class Sched, bool GATHER, bool FP8>
__device__ __forceinline__ void gemm_phase(LAS unsigned char* lds, const Sched& S, const Epi& E, const LAS unsigned* gtab) {
    const int tid = threadIdx.x, wid = __builtin_amdgcn_readfirstlane(tid >> 6), lane = tid & 63, wr = wid >> 2, wc = wid & 3, fr = lane & 15, fq = lane >> 4;
    constexpr int PITCH = FP8 ? GK : GK * 2, nt = FP8 ? GK / 128 : GK / BK;
    unsigned voffB[2]; int Rr[2], Cc2[2];
#pragma unroll
    for (int i = 0; i < 2; ++i) { int R, C; stage_rc(tid * 16 + i * 8192, R, C); const int Rb = (Epi::PERM == 2) ? ((R & ~31) + perm32x(R & 31)) : (Epi::PERM ? ((R & ~31) + perm32(R & 31)) : R);
        voffB[i] = (unsigned)(Rb * PITCH + C * 2); Rr[i] = R; Cc2[i] = C * 2; }
    constexpr size_t kstep = (size_t)(BK * 2);
    constexpr size_t hstep = (size_t)HALF * PITCH;
    const unsigned ldsw = (unsigned)wid * 1024u;
    const int aoff = lds_byte(wr * 64 + fr, fq * 8);
    unsigned boffv = (unsigned)(size_t)lds + 4 * HTB + lds_byte(wc * 32 + fr, fq * 8);
    asm volatile("" : "+v"(boffv));
#define PG_SA(b, h) (((b) * 2 + (h)) * HTB)
#define PG_SB(b, h) ((4 + (b) * 2 + (h)) * HTB)
#define PG_STAGE(bufoff, gbase, voff) do { _Pragma("unroll") for (int _i = 0; _i < 2; ++_i) \
        __builtin_amdgcn_global_load_lds((const unsigned*)((const char*)(gbase) + (voff)[_i]), (LAS unsigned*)(lds + (bufoff) + ldsw + _i * 8192), 16, 0, 0); } while (0)
#define PG_RD16(off) (*(const LAS v4i*)(lds + (off)))
#define PG_LDA(dst, b, h) do { _Pragma("unroll") for (int m = 0; m < 4; ++m) dst[m] = __builtin_shufflevector(PG_RD16(PG_SA(b, h) + aoff + m * 2048), PG_RD16(PG_SA(b, h) + aoff + m * 2048 + 1024), 0, 1, 2, 3, 4, 5, 6, 7); } while (0)
#define PG_RDB16(off) (*(const LAS v4i*)((LAS unsigned char*)(size_t)boffv + (off)))
#define PG_LDB(dst, b, h) do { _Pragma("unroll") for (int n = 0; n < 2; ++n) dst[n] = __builtin_shufflevector(PG_RDB16(((b) * 2 + (h)) * HTB + n * 2048), PG_RDB16(((b) * 2 + (h)) * HTB + n * 2048 + 1024), 0, 1, 2, 3, 4, 5, 6, 7); } while (0)
#define PG_LO(x) __builtin_bit_cast(bf16x8, __builtin_shufflevector((x), (x), 0, 1, 2, 3))
#define PG_HI(x) __builtin_bit_cast(bf16x8, __builtin_shufflevector((x), (x), 4, 5, 6, 7))
#define PG_MMA(ai, bj, At, Bt) do { __builtin_amdgcn_s_setprio(1); _Pragma("unroll") for (int m = 0; m < 4; ++m) _Pragma("unroll") for (int n = 0; n < 2; ++n) { \
        if constexpr (FP8) { asm volatile("v_mfma_scale_f32_16x16x128_f8f6f4 %0, %1, %2, %0, %3, %3 op_sel_hi:[0,0,0]" : "+v"(acc[ai][bj][m][n]) : "v"(Bt[n]), "v"(At[m]), "v"(sc1)); } \
        else { acc[ai][bj][m][n] = __builtin_amdgcn_mfma_f32_16x16x32_bf16(PG_LO(Bt[n]), PG_LO(At[m]), acc[ai][bj][m][n], 0, 0, 0); \
               acc[ai][bj][m][n] = __builtin_amdgcn_mfma_f32_16x16x32_bf16(PG_HI(Bt[n]), PG_HI(At[m]), acc[ai][bj][m][n], 0, 0, 0); } } \
        __builtin_amdgcn_s_setprio(0); } while (0)
#define PG_WAIT_V(n) asm volatile("s_waitcnt vmcnt(" #n ")" ::: "memory")
#define PG_WAIT_L(n) asm volatile("s_waitcnt lgkmcnt(" #n ")" ::: "memory")
#define PG_BAR __builtin_amdgcn_s_barrier()
#define PG_SCHED __builtin_amdgcn_sched_barrier(0)
#define PG_LOADVO(vo, u) do { _Pragma("unroll") for (int _h = 0; _h < 2; ++_h) _Pragma("unroll") for (int _i = 0; _i < 2; ++_i) \
        vo[_h][_i] = GATHER ? (gtab[(u).gslot * 256 + _h * HALF + Rr[_i]] + (unsigned)Cc2[_i]) : (unsigned)((_h * HALF + Rr[_i]) * PITCH + Cc2[_i]); } while (0)
    int sc1 = 0x7f7f7f7f; asm volatile("" : "+v"(sc1));
    GU cur, nxt; int ui = 0;
    if (!S.next(0, cur)) return;
    if (STAGGER_TICKS > 0) {
        const unsigned long long t0 = __builtin_amdgcn_s_memrealtime(); const unsigned long long dl = (unsigned long long)((blockIdx.x * 5u) & 15u) * STAGGER_TICKS;
        while (__builtin_amdgcn_s_memrealtime() - t0 < dl) __builtin_amdgcn_s_sleep(8);
    }
    f32x4 acc[2][2][4][2];
#pragma unroll
    for (int a = 0; a < 2; ++a)
#pragma unroll
        for (int b = 0; b < 2; ++b)
#pragma unroll
            for (int m = 0; m < 4; ++m)
#pragma unroll
                for (int n = 0; n < 2; ++n) acc[a][b][m][n] = (f32x4){0.f, 0.f, 0.f, 0.f};
    v8i At[4], B0[2], B1[2];
    unsigned cvo[2][2], nvo[2][2];
    PG_LOADVO(cvo, cur);
    const char* cA = cur.A; const char* cB = cur.B;
    PG_STAGE(PG_SB(0, 0), cB, voffB); PG_STAGE(PG_SB(0, 1), cB + hstep, voffB); PG_STAGE(PG_SA(0, 0), cA, cvo[0]); PG_STAGE(PG_SA(0, 1), cA, cvo[1]);
    if (wr == 1) PG_BAR;
    PG_WAIT_V(2); PG_BAR;
    PG_STAGE(PG_SB(1, 0), cB + kstep, voffB); PG_STAGE(PG_SA(1, 0), cA + kstep, cvo[0]); PG_STAGE(PG_SB(1, 1), cB + hstep + kstep, voffB);
    PG_WAIT_V(6); PG_BAR;
    for (;;) {
        const bool has_next = S.next(ui + 1, nxt);
        const char* nA = has_next ? nxt.A : cA; const char* nB = has_next ? nxt.B : cB;
        if (GATHER) { if (has_next) { PG_LOADVO(nvo, nxt); } else {
#pragma unroll
            for (int h = 0; h < 2; ++h)
#pragma unroll
                for (int i = 0; i < 2; ++i) nvo[h][i] = cvo[h][i]; } }
#pragma unroll 1
        for (int t = 0; t < nt; t += 2) {
            const bool last = (t == nt - 2);
            const char* a1 = cA + (size_t)(t + 1) * kstep;
            const char* a2 = last ? nA : cA + (size_t)(t + 2) * kstep; const char* b2 = last ? nB : cB + (size_t)(t + 2) * kstep;
            const char* a3 = a2 + kstep; const char* b3 = b2 + kstep;
            unsigned vo2[2][2];
#pragma unroll
            for (int h = 0; h < 2; ++h)
#pragma unroll
                for (int i = 0; i < 2; ++i) vo2[h][i] = (GATHER && last) ? nvo[h][i] : cvo[h][i];
            PG_LDB(B0, 0, 0); PG_LDB(B1, 0, 1); PG_SCHED; PG_LDA(At, 0, 0); PG_STAGE(PG_SA(1, 1), a1, cvo[1]);
            PG_WAIT_V(8); PG_WAIT_L(0); PG_BAR; PG_MMA(0, 0, At, B0); PG_MMA(0, 1, At, B1); PG_BAR; PG_SCHED;
            PG_LDA(At, 0, 1); PG_STAGE(PG_SB(0, 0), b2, voffB); PG_STAGE(PG_SB(0, 1), b2 + hstep, voffB); PG_STAGE(PG_SA(0, 0), a2, vo2[0]);
            PG_WAIT_V(8); PG_WAIT_L(0); PG_BAR; PG_MMA(1, 0, At, B0); PG_MMA(1, 1, At, B1); PG_BAR; PG_SCHED;
            PG_LDB(B0, 1, 0); PG_LDB(B1, 1, 1); PG_SCHED; PG_LDA(At, 1, 0); PG_STAGE(PG_SA(0, 1), a2, vo2[1]);
            PG_WAIT_V(8); PG_WAIT_L(0); PG_BAR; PG_MMA(0, 0, At, B0); PG_MMA(0, 1, At, B1); PG_BAR; PG_SCHED;
            PG_LDA(At, 1, 1); PG_STAGE(PG_SB(1, 0), b3, voffB); PG_STAGE(PG_SB(1, 1), b3 + hstep, voffB); PG_STAGE(PG_SA(1, 0), a3, vo2[0]);
            PG_WAIT_V(8); PG_WAIT_L(0); PG_BAR; PG_MMA(1, 0, At, B0); PG_MMA(1, 1, At, B1); PG_BAR; PG_SCHED;
        }
        if (wr == 0) PG_BAR;
        if constexpr (FP8) { asm volatile("s_nop 15\n\ts_nop 15" ::: "memory"); }
        E(acc, cur, wr, wc, fr, fq);
        if (!has_next) break;
#pragma unroll
        for (int a = 0; a < 2; ++a)
#pragma unroll
            for (int b = 0; b < 2; ++b)
#pragma unroll
                for (int m = 0; m < 4; ++m)
#pragma unroll
                    for (int n = 0; n < 2; ++n) acc[a][b][m][n] = (f32x4){0.f, 0.f, 0.f, 0.f};
        cur = nxt; cA = nA; cB = nB; ++ui;
        if (GATHER) {
#pragma unroll
            for (int h = 0; h < 2; ++h)
#pragma unroll
                for (int i = 0; i < 2; ++i) cvo[h][i] = nvo[h][i]; }
        if (wr == 1) PG_BAR;
    }
    PG_WAIT_V(0);
    PG_BAR;
#undef PG_SA
#undef PG_SB
#undef PG_STAGE
#undef PG_LDA
#undef PG_RD16
#undef PG_RDB16
#undef PG_LO
#undef PG_HI
#undef PG_LDB
#undef PG_MMA
#undef PG_WAIT_V
#undef PG_WAIT_L
#undef PG_BAR
#undef PG_SCHED
#undef PG_LOADVO
}
}

constexpr int NWAVES = 8;
constexpr int RING_OFF = 0, RING_BYTES = 131072;
constexpr int GTAB_OFF = RING_BYTES, GTAB_BYTES = 18 * 1024;
constexpr int UTAB_OFF = GTAB_OFF + GTAB_BYTES, UTAB_BYTES = 1024;
constexpr int MISC_OFF = UTAB_OFF + UTAB_BYTES;
constexpr int LDS_BYTES = MISC_OFF + 512;
static_assert(LDS_BYTES <= 160 * 1024, "LDS");

#ifndef REP_PHASE
#define REP_PHASE -1
#endif
#define NREP(k) ((REP_PHASE) == (k) ? 2 : 1)
struct MKArgs { Ptrs p; int ph_lo, ph_hi, li, pad; };

#define XB_TMO      128
#define XB_XCNT(j)  (256  + 64 * (j))
#define XB_XSUB(j)  (1280 + 64 * (j))
#define XB_XGEN(j)  (2304 + 64 * (j))
#define XB_TOP      3328
#define XB_TOPGEN   3392
#define XCD_BAR_WORDS 3456
#define XB_SPIN_CAP (1u << 18)
__device__ __forceinline__ unsigned xb_ld(unsigned* p)              { return __hip_atomic_load(p, __ATOMIC_RELAXED, __HIP_MEMORY_SCOPE_AGENT); }
__device__ __forceinline__ unsigned xb_add(unsigned* p, unsigned v) { return __hip_atomic_fetch_add(p, v, __ATOMIC_RELAXED, __HIP_MEMORY_SCOPE_AGENT); }
__device__ __forceinline__ unsigned xb_xcc_id() { return (unsigned)__builtin_amdgcn_s_getreg((3 << 11) | 20) & 0xFu; }
#define XB_SPIN(cond, bar) do { unsigned _sp = 0; while (cond) { __builtin_amdgcn_s_sleep(1); \
    if ((++_sp & 255u) == 0u) { if (xb_ld(&(bar)[XB_TMO])) break; if (_sp > XB_SPIN_CAP) { atomicAdd(&(bar)[XB_TMO], 1u); break; } } } } while (0)
struct XcdBarrier { unsigned* bar; unsigned x; volatile LAS unsigned* st; };
__device__ __forceinline__ XcdBarrier xcd_barrier_post(unsigned* bar, volatile LAS unsigned* st) {
    XcdBarrier b; b.bar = bar; b.x = xb_xcc_id(); b.st = st;
    if (threadIdx.x == 0) (void)xb_add(&bar[XB_XCNT(b.x)], 1u);
    return b;
}
__device__ __forceinline__ void xcd_barrier_complete(unsigned* bar, unsigned x, unsigned& nloc, unsigned& nx) {
    const unsigned G = gridDim.x * gridDim.y * gridDim.z;
    unsigned sum, cnt, mine, sp = 0u;
    for (;;) {
        sum = 0u; cnt = 0u; mine = 0u;
#pragma unroll
        for (unsigned j = 0; j < 16; ++j) { const unsigned c = xb_ld(&bar[XB_XCNT(j)]); sum += c; cnt += (c > 0u) ? 1u : 0u; mine = (j == x) ? c : mine; }
        if (sum == G) break;
        __builtin_amdgcn_s_sleep(1);
        if ((++sp & 255u) == 0u) { if (xb_ld(&bar[XB_TMO])) break; if (sp > XB_SPIN_CAP) { atomicAdd(&bar[XB_TMO], 1u); break; } }
    }
    nloc = mine > 0u ? mine : 1u; nx = cnt > 0u ? cnt : 1u;
}
__device__ __forceinline__ void xcd_barrier_core(const XcdBarrier& b) {
    if (threadIdx.x == 0) {
        unsigned* bar = b.bar;
        __builtin_amdgcn_s_waitcnt(0);
        unsigned nloc = b.st[0], nx = b.st[1];
        if (nloc == 0u) { xcd_barrier_complete(bar, b.x, nloc, nx); b.st[0] = nloc; b.st[1] = nx; }
        const unsigned old = xb_add(&bar[XB_XSUB(b.x)], 1u);
        const unsigned gen = old / nloc;
        if (old + 1u == (gen + 1u) * nloc) {
            __builtin_amdgcn_fence(__ATOMIC_RELEASE, "agent");
            asm volatile("s_waitcnt vmcnt(0)" ::: "memory");
            const unsigned og = xb_add(&bar[XB_TOP], 1u);
            const unsigned tg = og / nx;
            if (og + 1u == (tg + 1u) * nx) xb_add(&bar[XB_TOPGEN], 1u);
            else XB_SPIN(xb_ld(&bar[XB_TOPGEN]) == tg, bar);
            __builtin_amdgcn_fence(__ATOMIC_ACQUIRE, "agent");
            xb_add(&bar[XB_XGEN(b.x)], 1u);
            asm volatile("s_waitcnt vmcnt(0)" ::: "memory");
        } else {
            XB_SPIN(xb_ld(&bar[XB_XGEN(b.x)]) == gen, bar);
            __builtin_amdgcn_fence(__ATOMIC_ACQUIRE, "agent");
            asm volatile("s_waitcnt vmcnt(0)" ::: "memory");
        }
    }
}
__device__ __forceinline__ void xcd_barrier(const XcdBarrier& b) {
    asm volatile("s_waitcnt vmcnt(0)" ::: "memory");
    __syncthreads();
    xcd_barrier_core(b);
    __syncthreads();
}
__device__ __forceinline__ void conv_gu_item(const Ptrs& p, int r, float* scr, int lane) {
    const int e = r / 512, q = r % 512, kb = q / 64, nb = q % 64; const int n0 = 32 * nb, isup = n0 >> 10, cc = n0 & 1023, j = cc >> 7, c = cc & 127;
    transpose_item_fp8(p.in[20] + (size_t)e * 1024 * 2048, 1024, 2048, (unsigned char*)(p.ws + WS_WGU) + (size_t)e * 2048 * 1024, 128 * kb, n0, 256 * j + 128 * isup + c, scr, lane);
}
__device__ __forceinline__ void conv_dn_item(const Ptrs& p, int r, float* scr, int lane) {
    const int e = r / 256, q = r % 256, kb = q / 32, nb = q % 32;
    transpose_item_fp8(p.in[22] + (size_t)e * 1024 * 1024, 1024, 1024, (unsigned char*)(p.ws + WS_WDN) + (size_t)e * 1024 * 1024, 128 * kb, 32 * nb, 32 * nb, scr, lane);
}
constexpr int SH_WAVES = 7;
template <int KIND>
__device__ __forceinline__ void shadow_item(const Ptrs& p, int idx, float* scr, int lane) { if (KIND == 1) conv_gu_item(p, idx, scr, lane); else conv_dn_item(p, idx, scr, lane); }
template <int KIND>
__device__ __forceinline__ void xcd_barrier_sh(const XcdBarrier& b, const Ptrs& p, int idx, int wave, float* scr, int lane) {
    asm volatile("s_waitcnt vmcnt(0)" ::: "memory");
    __syncthreads();
    if (wave == 0) xcd_barrier_core(b);
    else shadow_item<KIND>(p, idx, scr, lane);
    __syncthreads();
}
constexpr int CW_BAR = 4096;

struct SchedP1 {
    int G, c; unsigned char* ws; const float* b_glu;
    static constexpr int N_A = 128 * 7, N_B = 256, N_C = 32, NU = N_A + N_B + N_C;
    __device__ __forceinline__ bool next(int i, pg::GU& u) const {
        const int L = i * G + c; if (L >= NU) return false;
        u.bias = nullptr; u.scale = 1.0f; u.gslot = 0; u.kind = 1; u.row0 = 0; u.col0 = 0; u.ldc = 8;
        if (L < N_A) { const int pm = L / 7, pn = L % 7;
            u.A = (const char*)(ws + WS_XN) + (size_t)pm * 256 * 2048; u.row0 = pm * 256;
            const int brow = pn < 4 ? 256 * pn : 256 * (pn + 2); u.B = (const char*)(ws + WS_WIN) + (size_t)brow * 2048;
            if (pn < 2) { u.O = (char*)(ws + WS_Q); u.col0 = pn * 256; u.scale = 0.125f * 1.44269504f; }
            else if (pn < 4) { u.O = (char*)(ws + WS_K); u.col0 = (pn - 2) * 256; }
            else if (pn < 6) { u.kind = 0; u.O = (char*)(ws + WS_GLU) + ((size_t)pm * 256 * 512 + (pn - 4) * 256) * 2; u.ldc = 512; u.bias = b_glu + (pn - 4) * 256; }
            else { u.O = (char*)(ws + WS_QMX); u.ldc = 4; u.scale = 0.125f * 1.44269504f; }
        } else if (L < N_A + N_B) { const int q = L - N_A, pn = q >> 1, pm = q & 1;
            u.A = (const char*)(ws + WS_WIN) + (size_t)(1024 + 256 * pm) * 2048; u.B = (const char*)(ws + WS_XN) + (size_t)pn * 256 * 2048;
            u.kind = 2; u.O = (char*)(ws + WS_VT); u.row0 = 256 * pm; u.col0 = 256 * pn;
        } else { int q = L - N_A - N_B; u.ldc = 4;
            if (q < 16) { u.A = (const char*)(ws + WS_MEMN) + (size_t)q * 256 * 2048; u.B = (const char*)(ws + WS_WMKV); u.O = (char*)(ws + WS_MEMK); u.row0 = q * 256; }
            else { q -= 16; u.A = (const char*)(ws + WS_WMKV) + (size_t)256 * 2048; u.B = (const char*)(ws + WS_MEMN) + (size_t)q * 256 * 2048; u.kind = 2; u.O = (char*)(ws + WS_MEMVT); u.col0 = q * 256; }
        }
        return true;
    }
};
struct SchedP3 {
    int G, c; unsigned char* ws;
    __device__ __forceinline__ bool next(int i, pg::GU& u) const {
        const int L = i * G + c; if (L >= 512) return false;
        const int pm = L >> 2, pn = L & 3;
        u.A = (const char*)(ws + WS_CAT) + (size_t)pm * 256 * 2048; u.B = (const char*)(ws + WS_WOUT) + (size_t)pn * 256 * 2048;
        u.O = (char*)(ws + WS_MIX) + ((size_t)pm * 256 * 1024 + pn * 256) * 2; u.bias = nullptr; u.ldc = 1024; u.scale = 1.0f; u.gslot = 0; u.kind = 0; u.row0 = 0; u.col0 = 0;
        return true;
    }
};
constexpr int UT_CNT = 0, UT_PST = 32, UT_UST = 64, UT_TOT = 96, UT_UNIT = 128, MAXU = 18;
template <int NPN>
__device__ __forceinline__ void moe_tables(LAS int* ut, const unsigned* cnt, int G, int vcu, int tid) {
    if (tid < 64) {
        const int c = tid < 32 ? (int)cnt[tid] : 0; const int np = (c + 255) >> 8;
        int incl = np;
#pragma unroll
        for (int o = 1; o < 32; o <<= 1) { const int v = __shfl_up(incl, o); if ((tid & 63) >= o) incl += v; }
        const int excl = incl - np;
        if (tid < 32) { ut[UT_CNT + tid] = c; ut[UT_PST + tid] = excl * 256; ut[UT_UST + tid] = excl * NPN; }
        if (tid == 31) ut[UT_TOT] = incl * NPN;
    }
    __syncthreads();
    if (tid < MAXU) {
        const int L = tid * G + vcu, U = ut[UT_TOT];
        int e = -1;
        if (L < U) { e = 0; for (int j = 1; j < 32; ++j) if (ut[UT_UST + j] <= L) e = j; }
        const int q = e >= 0 ? L - ut[UT_UST + e] : 0;
        ut[UT_UNIT + 4 * tid + 0] = e; ut[UT_UNIT + 4 * tid + 1] = q / NPN; ut[UT_UNIT + 4 * tid + 2] = q % NPN; ut[UT_UNIT + 4 * tid + 3] = e >= 0 ? ut[UT_PST + e] : 0;
    }
    __syncthreads();
}
struct SchedGU {
    const LAS int* ut; unsigned char* ws; const float* b_gu;
    __device__ __forceinline__ bool next(int i, pg::GU& u) const {
        if (i >= MAXU) return false;
        const int e = __builtin_amdgcn_readfirstlane(ut[UT_UNIT + 4 * i]); if (e < 0) return false;
        const int panel = __builtin_amdgcn_readfirstlane(ut[UT_UNIT + 4 * i + 1]), pn = __builtin_amdgcn_readfirstlane(ut[UT_UNIT + 4 * i + 2]), pst = __builtin_amdgcn_readfirstlane(ut[UT_UNIT + 4 * i + 3]);
        u.A = (const char*)(ws + WS_HN); u.B = (const char*)(ws + WS_WGU) + ((size_t)e * 2048 + pn * 256) * 1024;
        u.O = (char*)(ws + WS_HACT) + ((size_t)(pst + panel * 256) * 1024 + pn * 128); u.bias = b_gu + (size_t)e * 2048 + pn * 128; u.ldc = 1024; u.scale = 1.0f / W8_SCALE; u.gslot = i; u.kind = 0; u.row0 = 0; u.col0 = 0;
        return true;
    }
};
struct SchedDN {
    const LAS int* ut; unsigned char* ws; const float* b_dn;
    __device__ __forceinline__ bool next(int i, pg::GU& u) const {
        if (i >= MAXU) return false;
        const int e = __builtin_amdgcn_readfirstlane(ut[UT_UNIT + 4 * i]); if (e < 0) return false;
        const int panel = __builtin_amdgcn_readfirstlane(ut[UT_UNIT + 4 * i + 1]), pn = __builtin_amdgcn_readfirstlane(ut[UT_UNIT + 4 * i + 2]), pst = __builtin_amdgcn_readfirstlane(ut[UT_UNIT + 4 * i + 3]);
        u.A = (const char*)(ws + WS_HACT) + (size_t)(pst + panel * 256) * 1024; u.B = (const char*)(ws + WS_WDN) + ((size_t)e * 1024 + pn * 256) * 1024;
        u.O = (char*)(ws + WS_Y) + ((size_t)(pst + panel * 256) * 1024 + pn * 256); u.bias = b_dn + (size_t)e * 1024 + pn * 256; u.ldc = 1024; u.scale = 1.0f / W8_SCALE; u.gslot = 0; u.kind = 0; u.row0 = 0; u.col0 = 0;
        return true;
    }
};

#define LDS_BARRIER() do { asm volatile("s_waitcnt lgkmcnt(0)" ::: "memory"); __builtin_amdgcn_s_barrier(); asm volatile("" ::: "memory"); } while (0)
typedef float f32x16 __attribute__((ext_vector_type(16)));
typedef short s16x4 __attribute__((ext_vector_type(4)));
#define MFMA32(a, b, c) __builtin_amdgcn_mfma_f32_32x32x16_bf16((a), (b), (c), 0, 0, 0)
__device__ __forceinline__ bf16x8 pack8(float a0, float a1, float a2, float a3, float a4, float a5, float a6, float a7) {
    u32x4 p; p.x = pg::cvt_pk_bf16(a0, a1); p.y = pg::cvt_pk_bf16(a2, a3); p.z = pg::cvt_pk_bf16(a4, a5); p.w = pg::cvt_pk_bf16(a6, a7);
    return __builtin_bit_cast(bf16x8, p);
}
__device__ __forceinline__ bf16x8 load_vt_frag(const bf16* rowp, int h) {
    const s16x4 lo = *(const s16x4*)(rowp + 4 * h), hi = *(const s16x4*)(rowp + 8 + 4 * h);
    return __builtin_shufflevector(lo, hi, 0, 1, 2, 3, 4, 5, 6, 7);
}
__device__ __forceinline__ void sb_unit(unsigned char* ws, LAS unsigned char* lds, int unit, int wave, int lane) {
    const int b = unit >> 5, t0 = (unit & 31) * 64, hd = wave, r = lane & 31, h = lane >> 5;
    const size_t tb = (size_t)b * S;
    const bf16* Q = (const bf16*)(ws + WS_Q); const bf16* Kp = (const bf16*)(ws + WS_K); const bf16* VT = (const bf16*)(ws + WS_VT);
    bf16x8 qf[2][4];
#pragma unroll
    for (int ni = 0; ni < 2; ++ni)
#pragma unroll
        for (int kk = 0; kk < 4; ++kk) qf[ni][kk] = *(const bf16x8*)(Q + (((((tb + t0) >> 5) + ni) * 8 + hd) * 4 + kk) * 512 + lane * 8);
    f32x16 oacc[2][2];
#pragma unroll
    for (int di = 0; di < 2; ++di)
#pragma unroll
        for (int ni = 0; ni < 2; ++ni)
#pragma unroll
            for (int i = 0; i < 16; ++i) oacc[di][ni][i] = 0.f;
    float carry[2] = {1.0f, 1.0f};
    for (int s0 = t0 + 32; s0 >= 0; s0 -= 32) {
        bf16x8 kf[4];
#pragma unroll
        for (int kk = 0; kk < 4; ++kk) kf[kk] = *(const bf16x8*)(Kp + ((((tb + s0) >> 5) * 8 + hd) * 4 + kk) * 512 + lane * 8);
        bf16x8 vf[2][2];
#pragma unroll
        for (int di = 0; di < 2; ++di)
#pragma unroll
            for (int ks = 0; ks < 2; ++ks) vf[di][ks] = *(const bf16x8*)(VT + (((((tb + s0) >> 4) + ks) * 8 + hd) * 2 + di) * 512 + lane * 8);
        const bool diag = (s0 + 31 >= t0);
        bf16x8 pf[2][2];
#pragma unroll
        for (int ni = 0; ni < 2; ++ni) {
            f32x16 sa;
#pragma unroll
            for (int i = 0; i < 16; ++i) sa[i] = 0.f;
#pragma unroll
            for (int kk = 0; kk < 4; ++kk) sa = MFMA32(kf[kk], qf[ni][kk], sa);
            f32x16 zc = sa;
            if (diag) {
#pragma unroll
                for (int i = 0; i < 16; ++i) { const int key = s0 + (i & 3) + 8 * (i >> 2) + 4 * h, tq = t0 + 32 * ni + r; zc[i] = (key < tq) ? zc[i] : -1.0e30f; }
            }
            f32x16 E;
#pragma unroll
            for (int i = 0; i < 16; ++i) E[i] = __builtin_amdgcn_exp2f(__builtin_amdgcn_fmed3f(zc[i], -1.0e30f, 30.0f));
            const f32x16 dd = E + 1.0f;
            float P1[4], P2[4], P3[4], rg[4], Tg[4], Pg[4];
#pragma unroll
            for (int g = 0; g < 4; ++g) { P1[g] = dd[4 * g]; P2[g] = P1[g] * dd[4 * g + 1]; P3[g] = P2[g] * dd[4 * g + 2];
                rg[g] = __builtin_amdgcn_rcpf(P3[g] * dd[4 * g + 3]);
                Pg[g] = xhalf(rg[g]); Tg[g] = rg[g] * Pg[g]; }
            float suf[4]; suf[3] = 1.0f; suf[2] = Tg[3]; suf[1] = Tg[3] * Tg[2]; suf[0] = suf[1] * Tg[1];
            const float total = suf[0] * Tg[0];
            float av[16];
#pragma unroll
            for (int g = 0; g < 4; ++g) {
                const float br = carry[ni] * suf[g] * (h == 0 ? Pg[g] : 1.0f) * rg[g];
                av[4 * g] = E[4 * g] * br; av[4 * g + 1] = E[4 * g + 1] * (br * P1[g]); av[4 * g + 2] = E[4 * g + 2] * (br * P2[g]); av[4 * g + 3] = E[4 * g + 3] * (br * P3[g]);
            }
            carry[ni] *= total;
            pf[ni][0] = pack8(av[0], av[1], av[2], av[3], av[4], av[5], av[6], av[7]);
            pf[ni][1] = pack8(av[8], av[9], av[10], av[11], av[12], av[13], av[14], av[15]);
        }
#pragma unroll
        for (int di = 0; di < 2; ++di)
#pragma unroll
            for (int ni = 0; ni < 2; ++ni)
#pragma unroll
                for (int ks = 0; ks < 2; ++ks) oacc[di][ni] = MFMA32(vf[di][ks], pf[ni][ks], oacc[di][ni]);
        if (__all((carry[0] < SB_EXIT_LIN) && (carry[1] < SB_EXIT_LIN))) break;
    }
    LAS float* ssq = (LAS float*)lds;
    float ss[2];
#pragma unroll
    for (int ni = 0; ni < 2; ++ni) { float v = 0.f;
#pragma unroll
        for (int di = 0; di < 2; ++di)
#pragma unroll
            for (int i = 0; i < 16; ++i) v += oacc[di][ni][i] * oacc[di][ni][i];
        v += xhalf(v); ss[ni] = v;
        if (h == 0) ssq[(32 * ni + r) * 8 + hd] = v; }
    LDS_BARRIER();
    bf16* cat = (bf16*)(ws + WS_CAT);
#pragma unroll
    for (int ni = 0; ni < 2; ++ni) {
        float tot = 0.f;
#pragma unroll
        for (int w = 0; w < 8; ++w) tot += ssq[(32 * ni + r) * 8 + w];
        const float rs = 1.0f / sqrtf(tot * (1.f / 512.f) + EPS);
        bf16* rowp = cat + (tb + t0 + 32 * ni + r) * 1024 + hd * 64 + 8 * h;
#pragma unroll
        for (int di = 0; di < 2; ++di)
#pragma unroll
            for (int gp = 0; gp < 2; ++gp) { const int g0 = 2 * gp, g1 = 2 * gp + 1;
                const v4i o = pg::pair16((int)pg::cvt_pk_bf16(oacc[di][ni][4 * g0] * rs, oacc[di][ni][4 * g0 + 1] * rs), (int)pg::cvt_pk_bf16(oacc[di][ni][4 * g0 + 2] * rs, oacc[di][ni][4 * g0 + 3] * rs),
                                          (int)pg::cvt_pk_bf16(oacc[di][ni][4 * g1] * rs, oacc[di][ni][4 * g1 + 1] * rs), (int)pg::cvt_pk_bf16(oacc[di][ni][4 * g1 + 2] * rs, oacc[di][ni][4 * g1 + 3] * rs));
                *(v4i*)(rowp + 32 * di + 16 * gp) = o; }
    }
    LDS_BARRIER();
}

__device__ __forceinline__ void mx_unit(unsigned char* ws, LAS unsigned char* lds, int unit, int wave, int lane) {
    const int b = unit >> 5, t0 = (unit & 31) * 64, hd = wave & 3, qh = wave >> 2, r = lane & 31, h = lane >> 5;
    const size_t tb = (size_t)b * S;
    const bf16* QM = (const bf16*)(ws + WS_QMX); const bf16* MK = (const bf16*)(ws + WS_MEMK); const bf16* MVT = (const bf16*)(ws + WS_MEMVT);
    bf16x8 qf[4];
#pragma unroll
    for (int kk = 0; kk < 4; ++kk) qf[kk] = *(const bf16x8*)(QM + (((((tb + t0) >> 5) + qh) * 4 + hd) * 4 + kk) * 512 + lane * 8);
    f32x16 sa[8];
#pragma unroll
    for (int mi = 0; mi < 8; ++mi) {
#pragma unroll
        for (int i = 0; i < 16; ++i) sa[mi][i] = 0.f;
#pragma unroll
        for (int kk = 0; kk < 4; ++kk) { const bf16x8 kf = *(const bf16x8*)(MK + (size_t)(((b * 8 + mi) * 4 + hd) * 4 + kk) * 512 + lane * 8); sa[mi] = MFMA32(kf, qf[kk], sa[mi]); }
    }
    float mx = -3.0e38f;
#pragma unroll
    for (int mi = 0; mi < 8; ++mi)
#pragma unroll
        for (int i = 0; i < 16; ++i) mx = fmaxf(mx, sa[mi][i]);
    mx = fmaxf(mx, xhalf(mx));
    float sum = 0.f;
#pragma unroll
    for (int mi = 0; mi < 8; ++mi)
#pragma unroll
        for (int i = 0; i < 16; ++i) { const float pv = __builtin_amdgcn_exp2f(sa[mi][i] - mx); sa[mi][i] = pv; sum += pv; }
    sum += xhalf(sum);
    f32x16 oacc[2];
#pragma unroll
    for (int di = 0; di < 2; ++di)
#pragma unroll
        for (int i = 0; i < 16; ++i) oacc[di][i] = 0.f;
#pragma unroll
    for (int mi = 0; mi < 8; ++mi)
#pragma unroll
        for (int s2 = 0; s2 < 2; ++s2) {
            const bf16x8 pf = pack8(sa[mi][8 * s2], sa[mi][8 * s2 + 1], sa[mi][8 * s2 + 2], sa[mi][8 * s2 + 3], sa[mi][8 * s2 + 4], sa[mi][8 * s2 + 5], sa[mi][8 * s2 + 6], sa[mi][8 * s2 + 7]);
#pragma unroll
            for (int di = 0; di < 2; ++di) { const bf16x8 vf = *(const bf16x8*)(MVT + (size_t)(((b * 16 + 2 * mi + s2) * 4 + hd) * 2 + di) * 512 + lane * 8); oacc[di] = MFMA32(vf, pf, oacc[di]); }
        }
    const float inv = 1.0f / sum;
    LAS float* ssq = (LAS float*)lds;
    float v = 0.f;
#pragma unroll
    for (int di = 0; di < 2; ++di)
#pragma unroll
        for (int i = 0; i < 16; ++i) { oacc[di][i] *= inv; v += oacc[di][i] * oacc[di][i]; }
    v += xhalf(v);
    if (h == 0) ssq[(32 * qh + r) * 4 + hd] = v;
    LDS_BARRIER();
    const float tot = (ssq[(32 * qh + r) * 4 + 0] + ssq[(32 * qh + r) * 4 + 1]) + (ssq[(32 * qh + r) * 4 + 2] + ssq[(32 * qh + r) * 4 + 3]);
    const float rs = 1.0f / sqrtf(tot * (1.f / 256.f) + EPS);
    bf16* rowp = (bf16*)(ws + WS_CAT) + (tb + t0 + 32 * qh + r) * 1024 + 768 + hd * 64 + 8 * h;
#pragma unroll
    for (int di = 0; di < 2; ++di)
#pragma unroll
        for (int gp = 0; gp < 2; ++gp) { const int g0 = 2 * gp, g1 = 2 * gp + 1;
            const v4i o = pg::pair16((int)pg::cvt_pk_bf16(oacc[di][4 * g0] * rs, oacc[di][4 * g0 + 1] * rs), (int)pg::cvt_pk_bf16(oacc[di][4 * g0 + 2] * rs, oacc[di][4 * g0 + 3] * rs),
                                      (int)pg::cvt_pk_bf16(oacc[di][4 * g1] * rs, oacc[di][4 * g1 + 1] * rs), (int)pg::cvt_pk_bf16(oacc[di][4 * g1 + 2] * rs, oacc[di][4 * g1 + 3] * rs));
            *(v4i*)(rowp + 32 * di + 16 * gp) = o; }
    LDS_BARRIER();
}

constexpr int CV_U_OFF = 0, CV_ACT_OFF = 96256, CV_ACT_PITCH = 528, CV_SSQ_OFF = 65536;
static_assert(CV_ACT_OFF + 64 * CV_ACT_PITCH <= RING_BYTES, "conv LDS");
__device__ __forceinline__ void cv_unit(const Ptrs& p, LAS unsigned char* lds, int unit, int tid, int wave, int lane) {
    unsigned char* ws = p.ws;
    const int b = unit >> 5, t0 = (unit & 31) * 64;
    const size_t tb = (size_t)b * S;
    LAS float* U = (LAS float*)(lds + CV_U_OFF);
    const bf16* GLU = (const bf16*)(ws + WS_GLU);
    {
        v4u av[6], gv[6];
#pragma unroll
        for (int i = 0; i < 6; ++i) { const int it = tid + i * NWAVES * 64, row = it >> 5, ch = (it & 31) * 8, tl = t0 - (CONVK - 1) + row;
            if (it < 94 * 32 && tl >= 0) { av[i] = *(const v4u*)(GLU + (tb + tl) * 512 + ch); gv[i] = *(const v4u*)(GLU + (tb + tl) * 512 + 256 + ch); }
            else { av[i] = (v4u){0u, 0u, 0u, 0u}; gv[i] = (v4u){0u, 0u, 0u, 0u}; } }
#pragma unroll
        for (int i = 0; i < 6; ++i) { const int it = tid + i * NWAVES * 64, row = it >> 5, ch = (it & 31) * 8;
            if (it < 94 * 32) { float uu[8];
#pragma unroll
                for (int j = 0; j < 4; ++j) { const float a0 = bf2f(av[i][j] & 0xffffu), a1 = bf2f(av[i][j] >> 16), g0 = bf2f(gv[i][j] & 0xffffu), g1 = bf2f(gv[i][j] >> 16);
                    uu[2 * j] = a0 * __builtin_amdgcn_rcpf(1.0f + __builtin_amdgcn_exp2f(-1.44269504f * g0)); uu[2 * j + 1] = a1 * __builtin_amdgcn_rcpf(1.0f + __builtin_amdgcn_exp2f(-1.44269504f * g1)); }
                *(LAS f32x4*)(U + row * 256 + ch) = (f32x4){uu[0], uu[1], uu[2], uu[3]}; *(LAS f32x4*)(U + row * 256 + ch + 4) = (f32x4){uu[4], uu[5], uu[6], uu[7]}; } }
    }
    LDS_BARRIER();
    {
        const int c = tid & 255, th = tid >> 8;
        typedef float f2 __attribute__((ext_vector_type(2)));
        f2 wp[CONVK + 1], acc2[16];
        { float wprev = 0.f;
#pragma unroll
          for (int j = 0; j < CONVK; ++j) { const float wj = p.in[5][j * CVW + c]; wp[j] = (f2){wj, wprev}; wprev = wj; }
          wp[CONVK] = (f2){0.f, wprev}; }
        const float bd = p.in[6][c];
#pragma unroll
        for (int m = 0; m < 16; ++m) acc2[m] = (f2){bd, bd};
#pragma unroll
        for (int ii = 0; ii < 62; ++ii) { const float uv = U[(32 * th + ii) * 256 + c]; const f2 uv2 = (f2){uv, uv};
#pragma unroll
            for (int m = 0; m < 16; ++m) { const int j = ii - 2 * m; if (j >= 0 && j <= CONVK) acc2[m] = __builtin_elementwise_fma(wp[j], uv2, acc2[m]); } }
        float acc[32];
#pragma unroll
        for (int m = 0; m < 16; ++m) { acc[2 * m] = acc2[m].x; acc[2 * m + 1] = acc2[m].y; }
        LDS_BARRIER();
#pragma unroll
        for (int tt = 0; tt < 32; ++tt) U[(32 * th + tt) * 256 + c] = acc[tt];
    }
    LDS_BARRIER();
    {
        const f32x4 gl = *(const f32x4*)(p.in[7] + 4 * lane), bl = *(const f32x4*)(p.in[8] + 4 * lane);
#pragma unroll
        for (int k = 0; k < 8; ++k) { const int tok = 8 * wave + k;
            const f32x4 x = *(const LAS f32x4*)(U + tok * 256 + 4 * lane);
            const float mu = wave_sum((x.x + x.y) + (x.z + x.w)) * (1.f / 256.f);
            const f32x4 d = x - mu;
            const float rstd = 1.0f / sqrtf(wave_sum((d.x * d.x + d.y * d.y) + (d.z * d.z + d.w * d.w)) * (1.f / 256.f) + EPS);
            f32x4 y = d * rstd * gl + bl;
            y.x = y.x * __builtin_amdgcn_rcpf(1.0f + __builtin_amdgcn_exp2f(-1.44269504f * y.x)); y.y = y.y * __builtin_amdgcn_rcpf(1.0f + __builtin_amdgcn_exp2f(-1.44269504f * y.y)); y.z = y.z * __builtin_amdgcn_rcpf(1.0f + __builtin_amdgcn_exp2f(-1.44269504f * y.z)); y.w = y.w * __builtin_amdgcn_rcpf(1.0f + __builtin_amdgcn_exp2f(-1.44269504f * y.w));
            *(LAS unsigned long long*)(lds + CV_ACT_OFF + tok * CV_ACT_PITCH + 8 * lane) = (unsigned long long)pg::cvt_pk_bf16(y.x, y.y) | ((unsigned long long)pg::cvt_pk_bf16(y.z, y.w) << 32);
        }
    }
    LDS_BARRIER();
    {
        const int r = lane & 31, h = lane >> 5;
        const bf16* WT = (const bf16*)(ws + WS_WPW2);
        f32x16 acc[2];
#pragma unroll
        for (int ti = 0; ti < 2; ++ti)
#pragma unroll
            for (int i = 0; i < 16; ++i) acc[ti][i] = 0.f;
#pragma unroll 4
        for (int kk = 0; kk < 16; ++kk) {
            const bf16x8 af = *(const bf16x8*)(WT + (size_t)(32 * wave + r) * 256 + 16 * kk + 8 * h);
#pragma unroll
            for (int ti = 0; ti < 2; ++ti) { const bf16x8 bfr = *(const LAS bf16x8*)(lds + CV_ACT_OFF + (32 * ti + r) * CV_ACT_PITCH + (16 * kk + 8 * h) * 2); acc[ti] = MFMA32(af, bfr, acc[ti]); }
        }
        LAS float* ssq = (LAS float*)(lds + CV_SSQ_OFF);
#pragma unroll
        for (int g = 0; g < 4; ++g) { const f32x4 bb = *(const f32x4*)(p.in[10] + 32 * wave + 8 * g + 4 * h);
#pragma unroll
            for (int ti = 0; ti < 2; ++ti) { acc[ti][4 * g] += bb.x; acc[ti][4 * g + 1] += bb.y; acc[ti][4 * g + 2] += bb.z; acc[ti][4 * g + 3] += bb.w; } }
#pragma unroll
        for (int ti = 0; ti < 2; ++ti) { float v = 0.f;
#pragma unroll
            for (int i = 0; i < 16; ++i) v += acc[ti][i] * acc[ti][i];
            v += xhalf(v);
            if (h == 0) ssq[(32 * ti + r) * 8 + wave] = v; }
        LDS_BARRIER();
#pragma unroll
        for (int ti = 0; ti < 2; ++ti) { float tot = 0.f;
#pragma unroll
            for (int w2 = 0; w2 < 8; ++w2) tot += ssq[(32 * ti + r) * 8 + w2];
            const float rs = 1.0f / sqrtf(tot * (1.f / 256.f) + EPS);
            bf16* rowp = (bf16*)(ws + WS_CAT) + (tb + t0 + 32 * ti + r) * 1024 + 512 + 32 * wave + 8 * h;
#pragma unroll
            for (int gp = 0; gp < 2; ++gp) { const int g0 = 2 * gp, g1 = 2 * gp + 1;
                const v4i o = pg::pair16((int)pg::cvt_pk_bf16(acc[ti][4 * g0] * rs, acc[ti][4 * g0 + 1] * rs), (int)pg::cvt_pk_bf16(acc[ti][4 * g0 + 2] * rs, acc[ti][4 * g0 + 3] * rs),
                                          (int)pg::cvt_pk_bf16(acc[ti][4 * g1] * rs, acc[ti][4 * g1 + 1] * rs), (int)pg::cvt_pk_bf16(acc[ti][4 * g1 + 2] * rs, acc[ti][4 * g1 + 3] * rs));
                *(v4i*)(rowp + 16 * gp) = o; } }
    }
    LDS_BARRIER();
}

__global__ void __launch_bounds__(NWAVES * 64, 2) mk_fwd(MKArgs a) {
    extern __shared__ __attribute__((aligned(16))) unsigned char lds_raw[];
    LAS unsigned char* lds = (LAS unsigned char*)lds_raw;
    const int tid = threadIdx.x, lane = tid & 63, wave = __builtin_amdgcn_readfirstlane(tid >> 6);
    const int G = gridDim.x; const int bx = blockIdx.x; const int vcu = (G % 8 == 0) ? (bx % 8) * (G / 8) + bx / 8 : bx;
    unsigned char* ws = a.p.ws;
    const int lo = a.ph_lo, hi = a.ph_hi;
#define IN(k) (lo <= (k) && (k) < hi)
#define BOTH(k) (IN(k) && IN((k) + 1))
    const int SHG = 4 * SH_WAVES * G, SHD = SH_WAVES * G;
    float* const shscr = (float*)(lds_raw + RING_OFF + wave * 17408);
#define SEAM(k, KIND) do { const int _idx = ((KIND) == 1 ? (k) * SH_WAVES * G : 0) + vcu * SH_WAVES + wave - 1; \
        if (BOTH(k)) xcd_barrier_sh<KIND>(bar, a.p, _idx, wave, shscr, lane); else { __syncthreads(); if (wave > 0) shadow_item<KIND>(a.p, _idx, shscr, lane); } } while (0)
    volatile LAS unsigned* misc = (volatile LAS unsigned*)(lds + MISC_OFF);
    if (tid < 4) misc[tid] = 0u;
    __syncthreads();
    XcdBarrier bar; bar.bar = (unsigned*)(ws + WS_CTL) + CW_BAR + a.li * 4096; bar.x = 0; bar.st = misc;
    if (hi - lo > 1) bar = xcd_barrier_post((unsigned*)(ws + WS_CTL) + CW_BAR + a.li * 4096, misc);
    if (IN(0)) { for (int rep = 0; rep < NREP(0); ++rep) {
        float* scr = (float*)(lds_raw + RING_OFF + wave * 17408);
        const int gw = vcu * NWAVES + wave, NGW = G * NWAVES;
        const Ptrs& p = a.p;
        constexpr int I_IN = 16 * 72, I_OUT = 16 * 32, I_MKV = 16 * 16, I_PW2 = 4 * 8, I_GU = 32 * 8 * 64, I_DN = 32 * 8 * 32;
        const int R_GU = I_GU - SHG, R_DN = I_DN - SHD;
        const int NIT = I_IN + I_OUT + I_MKV + I_PW2 + R_GU + R_DN;
        for (int it = gw; it < NIT; it += NGW) {
            int r = it;
            if (r < I_IN) { const int kb = r / 72, nb = r % 72; transpose_item(p.in[3], 1024, INW, (bf16*)(ws + WS_WIN), 64 * kb, 32 * nb, 32 * nb, nullptr, scr, lane); continue; } r -= I_IN;
            if (r < I_OUT) { const int kb = r / 32, nb = r % 32; const int k0 = 64 * kb;
                const float* ks = k0 < 512 ? p.in[13] : (k0 < 768 ? p.in[14] - 512 : p.in[15] - 768);
                transpose_item(p.in[16], 1024, 1024, (bf16*)(ws + WS_WOUT), k0, 32 * nb, 32 * nb, ks, scr, lane); continue; } r -= I_OUT;
            if (r < I_MKV) { const int kb = r / 16, nb = r % 16; transpose_item(p.in[12], 1024, 512, (bf16*)(ws + WS_WMKV), 64 * kb, 32 * nb, 32 * nb, nullptr, scr, lane); continue; } r -= I_MKV;
            if (r < I_PW2) { const int kb = r / 8, nb = r % 8; transpose_item(p.in[9], 256, 256, (bf16*)(ws + WS_WPW2), 64 * kb, 32 * nb, 32 * nb, nullptr, scr, lane); continue; } r -= I_PW2;
            if (r < R_GU) { conv_gu_item(p, r + SHG, scr, lane); continue; } r -= R_GU;
            conv_dn_item(p, r + SHD, scr, lane);
        }
        { f32x4 gg[4];
#pragma unroll
          for (int j = 0; j < 4; ++j) gg[j] = ((const f32x4*)p.in[2])[lane + 64 * j];
          for (int m = gw; m < T; m += NGW) rms_row_to_bf16(p.in[0] + (size_t)m * D, gg, (bf16*)(ws + WS_XN) + (size_t)m * D, lane);
#pragma unroll
          for (int j = 0; j < 4; ++j) gg[j] = ((const f32x4*)p.in[11])[lane + 64 * j];
          for (int m = gw; m < TM; m += NGW) rms_row_to_bf16(p.in[1] + (size_t)m * D, gg, (bf16*)(ws + WS_MEMN) + (size_t)m * D, lane); }
        __syncthreads(); }
        SEAM(0, 1);
    }
    if (IN(1)) {
        SchedP1 Sc{G, vcu, ws, a.p.in[4]}; pg::EpiP1 E;
        for (int rep = 0; rep < NREP(1); ++rep) pg::gemm_phase<pg::EpiP1, SchedP1, false, false>(lds + RING_OFF, Sc, E, nullptr);
        SEAM(1, 1);
    }
    if (IN(2)) {
        constexpr int NU2 = NB * (S / 64);
        for (int u = vcu; u < NU2 * NREP(20); u += G) sb_unit(ws, lds + RING_OFF, u & (NU2 - 1), wave, lane);
        for (int u = vcu; u < NU2 * NREP(21); u += G) mx_unit(ws, lds + RING_OFF, u & (NU2 - 1), wave, lane);
        for (int u = vcu; u < NU2 * NREP(22); u += G) cv_unit(a.p, lds + RING_OFF, u & (NU2 - 1), tid, wave, lane);
        SEAM(2, 1);
    }
    if (IN(3)) {
        SchedP3 Sc{G, vcu, ws}; pg::EpiBf16 E;
        for (int rep = 0; rep < NREP(3); ++rep) pg::gemm_phase<pg::EpiBf16, SchedP3, false, false>(lds + RING_OFF, Sc, E, nullptr);
        SEAM(3, 1);
    }
    if (IN(4)) {
#if REP_PHASE == 4
      for (int rep4 = 0; rep4 < 2; ++rep4) {
        if (rep4 == 1) { xcd_barrier(bar); if (blockIdx.x == 0 && tid < 32) __hip_atomic_store((unsigned*)(ws + WS_CTL) + CW_CNT + tid, 0u, __ATOMIC_RELAXED, __HIP_MEMORY_SCOPE_AGENT); xcd_barrier(bar); }
#else
      {
#endif
        const Ptrs& p = a.p;
        constexpr int HQP = 1028;
        LAS float* hq = (LAS float*)(lds + RING_OFF);
        LAS float* part = (LAS float*)(lds + RING_OFF + 16 * HQP * 4);
        LAS int* lcnt = (LAS int*)(lds + RING_OFF + 16 * HQP * 4 + 16384);
        LAS int* pend = (LAS int*)(lds + RING_OFF + 16 * HQP * 4 + 16384 + 256);
        const int e = lane & 31, hf = lane >> 5;
        float wreg[2][32];
#pragma unroll
        for (int nb = 0; nb < 2; ++nb)
#pragma unroll
            for (int q = 0; q < 32; ++q) wreg[nb][q] = p.in[18][(size_t)(128 * wave + 4 * q + (lane >> 4)) * NE + 16 * nb + (lane & 15)];
        const float bre = p.in[19][e];
        f32x4 gg4[4];
#pragma unroll
        for (int j = 0; j < 4; ++j) gg4[j] = ((const f32x4*)p.in[17])[lane + 64 * j];
        for (int blk = vcu; blk < T / 128; blk += G) {
        if (tid < 64) lcnt[tid] = 0;
        const int tokbase = blk * 128;
        f32x4 xr[2][4]; unsigned long long mr[2][4];
#pragma unroll
        for (int j2 = 0; j2 < 2; ++j2)
#pragma unroll
            for (int j = 0; j < 4; ++j) { const int tk = tokbase + 2 * wave + j2; xr[j2][j] = ((const f32x4*)(p.in[0] + (size_t)tk * D))[lane + 64 * j]; mr[j2][j] = ((const unsigned long long*)((const bf16*)(ws + WS_MIX) + (size_t)tk * D))[lane + 64 * j]; }
        for (int bt = 0; bt < 8; ++bt) {
#pragma unroll
            for (int j2 = 0; j2 < 2; ++j2) {
                const int tl = 2 * wave + j2, tok = tokbase + 16 * bt + tl;
                f32x4 v[4];
#pragma unroll
                for (int j = 0; j < 4; ++j) { const unsigned lo = (unsigned)mr[j2][j], hi = (unsigned)(mr[j2][j] >> 32); v[j] = (f32x4){xr[j2][j].x + bf2f(lo & 0xffffu), xr[j2][j].y + bf2f(lo >> 16), xr[j2][j].z + bf2f(hi & 0xffffu), xr[j2][j].w + bf2f(hi >> 16)}; }
                float s2 = 0.f;
#pragma unroll
                for (int j = 0; j < 4; ++j) { s2 += (v[j].x * v[j].x + v[j].y * v[j].y) + (v[j].z * v[j].z + v[j].w * v[j].w);
                    ((unsigned long long*)((bf16*)(ws + WS_HB) + (size_t)tok * D))[lane + 64 * j] = (unsigned long long)pk2(v[j].x, v[j].y) | ((unsigned long long)pk2(v[j].z, v[j].w) << 32); }
                const float rs = 1.0f / sqrtf(wave_sum(s2) * (1.f / D) + EPS);
                int* o4 = (int*)((unsigned char*)(ws + WS_HN) + (size_t)tok * D) + lane;
#pragma unroll
                for (int j = 0; j < 4; ++j) { const f32x4 gg = gg4[j]; f32x4 y; y.x = v[j].x * rs * gg.x; y.y = v[j].y * rs * gg.y; y.z = v[j].z * rs * gg.z; y.w = v[j].w * rs * gg.w;
                    { int w8 = 0; w8 = __builtin_amdgcn_cvt_pk_fp8_f32(y.x, y.y, w8, false); w8 = __builtin_amdgcn_cvt_pk_fp8_f32(y.z, y.w, w8, true); o4[64 * j] = w8; }
                    *(LAS f32x4*)(hq + tl * HQP + 4 * lane + 256 * j) = y; }
            }
            LDS_BARRIER();
            if (bt < 7) {
#pragma unroll
                for (int j2 = 0; j2 < 2; ++j2)
#pragma unroll
                    for (int j = 0; j < 4; ++j) { const int tk = tokbase + 16 * (bt + 1) + 2 * wave + j2; xr[j2][j] = ((const f32x4*)(p.in[0] + (size_t)tk * D))[lane + 64 * j]; mr[j2][j] = ((const unsigned long long*)((const bf16*)(ws + WS_MIX) + (size_t)tk * D))[lane + 64 * j]; }
            }
            {
                f32x4 d0 = (f32x4){0.f, 0.f, 0.f, 0.f}, d1 = d0;
                const LAS float* ap = hq + (lane & 15) * HQP + 128 * wave + (lane >> 4);
#pragma unroll
                for (int q = 0; q < 32; ++q) { const float av = ap[4 * q];
                    d0 = __builtin_amdgcn_mfma_f32_16x16x4f32(av, wreg[0][q], d0, 0, 0, 0);
                    d1 = __builtin_amdgcn_mfma_f32_16x16x4f32(av, wreg[1][q], d1, 0, 0, 0); }
#pragma unroll
                for (int i = 0; i < 4; ++i) { part[(wave * 16 + 4 * (lane >> 4) + i) * 32 + (lane & 15)] = d0[i]; part[(wave * 16 + 4 * (lane >> 4) + i) * 32 + 16 + (lane & 15)] = d1[i]; }
            }
            LDS_BARRIER();
#pragma unroll
            for (int j2 = 0; j2 < 2; ++j2) {
                const int tl = 2 * wave + j2;
                float lg = bre;
#pragma unroll
                for (int w2 = 0; w2 < 8; ++w2) lg += part[(w2 * 16 + tl) * 32 + e];
                int my_e = 0; float my_v = 0.f, m0 = 0.f;
#pragma unroll
                for (int k = 0; k < 4; ++k) {
                    const float m = wave_max(lg);
                    const unsigned long long bal = __ballot(lg == m);
                    const int idx = (int)(__ffsll((long long)bal) - 1) & 31;
                    if (lane == k) { my_e = idx; my_v = m; }
                    if (k == 0) m0 = m;
                    if (e == idx) lg = -3.0e38f;
                }
                const float exv = (lane < 4) ? __expf(my_v - m0) : 0.f;
                const float es = __shfl(exv, 0) + __shfl(exv, 1) + __shfl(exv, 2) + __shfl(exv, 3);
                if (lane < 4) {
                    const int rank = __hip_atomic_fetch_add(lcnt + my_e, 1, __ATOMIC_RELAXED, __HIP_MEMORY_SCOPE_WORKGROUP);
                    LAS int* pe = pend + ((16 * bt + tl) * 4 + lane) * 3;
                    pe[0] = my_e; pe[1] = rank; pe[2] = __float_as_int(exv / es);
                }
            }
        }
        LDS_BARRIER();
        if (tid < 32) { const int n = lcnt[tid]; lcnt[32 + tid] = n > 0 ? (int)atomicAdd((unsigned*)(ws + WS_CTL) + CW_CNT + tid, (unsigned)n) : 0; }
        LDS_BARRIER();
        { const int tl = tid >> 2, k = tid & 3, tok = tokbase + tl;
            const LAS int* pe = pend + tid * 3; const int ee = pe[0], slot = lcnt[32 + ee] + pe[1];
            ((int*)(ws + WS_LIST))[(size_t)ee * T + slot] = tok;
            ((int*)(ws + WS_TOKE))[tok * 4 + k] = ee;
            ((int*)(ws + WS_TOKS))[tok * 4 + k] = slot;
            ((float*)(ws + WS_TOKG))[tok * 4 + k] = __int_as_float(pe[2]); }
        LDS_BARRIER();
        }
      }
        SEAM(4, 2);
    }
    if (IN(5)) {
        LAS int* ut = (LAS int*)(lds + UTAB_OFF); LAS unsigned* gt = (LAS unsigned*)(lds + GTAB_OFF);
        moe_tables<8>(ut, (const unsigned*)(ws + WS_CTL) + CW_CNT, G, vcu, tid);
        for (int i = 0; i < MAXU; ++i) {
            const int e = ut[UT_UNIT + 4 * i]; if (e < 0) break;
            if (tid < 256) { const int row = ut[UT_UNIT + 4 * i + 1] * 256 + tid, c = ut[UT_CNT + e]; const int src = row < c ? row : c - 1;
                gt[i * 256 + tid] = (unsigned)((const int*)(ws + WS_LIST))[(size_t)e * T + src] * 1024u; }
        }
        __syncthreads();
        SchedGU Sc{ut, ws, a.p.in[21]}; pg::EpiSwiGLU E;
        for (int rep = 0; rep < NREP(5); ++rep) pg::gemm_phase<pg::EpiSwiGLU, SchedGU, true, true>(lds + RING_OFF, Sc, E, gt);
        if (BOTH(5)) xcd_barrier(bar);
    }
    if (IN(6)) {
        LAS int* ut = (LAS int*)(lds + UTAB_OFF);
        moe_tables<4>(ut, (const unsigned*)(ws + WS_CTL) + CW_CNT, G, vcu, tid);
        SchedDN Sc{ut, ws, a.p.in[23]}; pg::EpiFp8 E;
        for (int rep = 0; rep < NREP(6); ++rep) { E.nostore = (rep < NREP(6) - 1); pg::gemm_phase<pg::EpiFp8, SchedDN, false, true>(lds + RING_OFF, Sc, E, nullptr); }
        if (BOTH(6)) xcd_barrier(bar);
    }
    if (IN(7)) {
        const Ptrs& p = a.p;
        LAS int* ut = (LAS int*)(lds + UTAB_OFF);
        moe_tables<4>(ut, (const unsigned*)(ws + WS_CTL) + CW_CNT, G, vcu, tid);
        const int gw = vcu * NWAVES + wave, NGW = G * NWAVES;
        f32x4 gg4[4];
#pragma unroll
        for (int j = 0; j < 4; ++j) gg4[j] = ((const f32x4*)p.in[24])[lane + 64 * j];
        for (int rep7 = 0; rep7 < NREP(7); ++rep7)
        for (int tok0 = gw * 2; tok0 < T; tok0 += NGW * 2) {
            float* const dst = p.out;
            f32x4 v[2][4]; unsigned yv[2][4][4]; float gts[2][4];
#pragma unroll
            for (int j2 = 0; j2 < 2; ++j2) {
                const int tok = tok0 + j2;
#pragma unroll
                for (int j = 0; j < 4; ++j) { const unsigned long long m = ((const unsigned long long*)((const bf16*)(ws + WS_HB) + (size_t)tok * D))[lane + 64 * j]; const unsigned lo_ = (unsigned)m, hi_ = (unsigned)(m >> 32);
                    v[j2][j] = (f32x4){bf2f(lo_ & 0xffffu), bf2f(lo_ >> 16), bf2f(hi_ & 0xffffu), bf2f(hi_ >> 16)}; }
                const int4 ev = *(const int4*)((const int*)(ws + WS_TOKE) + tok * 4), sv = *(const int4*)((const int*)(ws + WS_TOKS) + tok * 4); const f32x4 gv = *(const f32x4*)((const float*)(ws + WS_TOKG) + tok * 4);
                const int es[4] = {ev.x, ev.y, ev.z, ev.w}, ss[4] = {sv.x, sv.y, sv.z, sv.w};
                gts[j2][0] = gv.x; gts[j2][1] = gv.y; gts[j2][2] = gv.z; gts[j2][3] = gv.w;
#pragma unroll
                for (int k = 0; k < 4; ++k) {
                    const unsigned* y4 = (const unsigned*)((const unsigned char*)(ws + WS_Y) + (size_t)(ut[UT_PST + es[k]] + ss[k]) * 1024) + lane;
#pragma unroll
                    for (int j = 0; j < 4; ++j) yv[j2][k][j] = y4[64 * j];
                }
            }
#pragma unroll
            for (int j2 = 0; j2 < 2; ++j2) {
                const int tok = tok0 + j2;
#pragma unroll
                for (int k = 0; k < 4; ++k) { const float gt = gts[j2][k];
#pragma unroll
                    for (int j = 0; j < 4; ++j) { const int w = (int)yv[j2][k][j];
                        v[j2][j].x += gt * __builtin_amdgcn_cvt_f32_fp8(w, 0); v[j2][j].y += gt * __builtin_amdgcn_cvt_f32_fp8(w, 1); v[j2][j].z += gt * __builtin_amdgcn_cvt_f32_fp8(w, 2); v[j2][j].w += gt * __builtin_amdgcn_cvt_f32_fp8(w, 3); } }
                float s2 = 0.f;
#pragma unroll
                for (int j = 0; j < 4; ++j) s2 += (v[j2][j].x * v[j2][j].x + v[j2][j].y * v[j2][j].y) + (v[j2][j].z * v[j2][j].z + v[j2][j].w * v[j2][j].w);
                const float rs = 1.0f / sqrtf(wave_sum(s2) * (1.f / D) + EPS);
#pragma unroll
                for (int j = 0; j < 4; ++j) { const f32x4 gg = gg4[j]; f32x4 y; y.x = v[j2][j].x * rs * gg.x; y.y = v[j2][j].y * rs * gg.y; y.z = v[j2][j].z * rs * gg.z; y.w = v[j2][j].w * rs * gg.w; ((f32x4*)(dst + (size_t)tok * D))[lane + 64 * j] = y; }
            }
        }
    }
#undef IN
#undef BOTH
#undef SEAM
}

extern "C" void kernel_launch(void* const* d_in, const int* in_sizes, int n_in, void* d_out, int out_size, void* d_ws, size_t ws_size, hipStream_t stream) {
    if (n_in != 25 || out_size != T * D || ws_size < WS_END) { fprintf(stderr, "kernel_launch: unexpected shapes n_in %d out %d ws %zu\n", n_in, out_size, ws_size); return; }
    Ptrs p{};
    for (int i = 0; i < 25; ++i) p.in[i] = (const float*)d_in[i];
    p.out = (float*)d_out; p.ws = (unsigned char*)d_ws;
    (void)hipMemsetAsync((char*)d_ws + WS_CTL, 0, CTL_BYTES, stream);
    static int grid = 0;
    if (grid == 0) {
        int dev = 0, cus = 0;
        if (hipGetDevice(&dev) != hipSuccess || hipDeviceGetAttribute(&cus, hipDeviceAttributeMultiprocessorCount, dev) != hipSuccess) { grid = -1; return; }
        if (hipFuncSetAttribute((const void*)mk_fwd, hipFuncAttributeMaxDynamicSharedMemorySize, LDS_BYTES) != hipSuccess) { fprintf(stderr, "hipFuncSetAttribute failed\n"); grid = -1; return; }
        int per_cu = 0;
        if (hipOccupancyMaxActiveBlocksPerMultiprocessor(&per_cu, (const void*)mk_fwd, NWAVES * 64, LDS_BYTES) != hipSuccess || per_cu < 1) { fprintf(stderr, "occupancy query: %d\n", per_cu); }
        (void)hipGetLastError();
        grid = cus;
    }
    if (grid < 0) return;
#if defined(PROBE_SPLIT)
    { const int k = PROBE_SPLIT; const int reps = PROBE_REPS;
      MKArgs a{}; a.p = p; a.ph_lo = 0; a.ph_hi = k + 1; a.li = 0; hipLaunchKernelGGL(mk_fwd, dim3(grid), dim3(NWAVES * 64), LDS_BYTES, stream, a);
      for (int r = 0; r < reps; ++r) { if (k == 4) (void)hipMemsetAsync((char*)d_ws + WS_CTL + CW_CNT * 4, 0, 128, stream);
          a.ph_lo = k; a.ph_hi = k + 1; hipLaunchKernelGGL(mk_fwd, dim3(grid), dim3(NWAVES * 64), LDS_BYTES, stream, a); }
      a.ph_lo = k + 1; a.ph_hi = 8; a.li = 1; hipLaunchKernelGGL(mk_fwd, dim3(grid), dim3(NWAVES * 64), LDS_BYTES, stream, a); }
#elif !defined(MK_PER_PHASE)
    { MKArgs a{}; a.p = p; a.ph_lo = 0; a.ph_hi = 8; hipLaunchKernelGGL(mk_fwd, dim3(grid), dim3(NWAVES * 64), LDS_BYTES, stream, a); }
#else
    for (int ph = 0; ph < 8; ++ph) { MKArgs a{}; a.p = p; a.ph_lo = ph; a.ph_hi = ph + 1; hipLaunchKernelGGL(mk_fwd, dim3(grid), dim3(NWAVES * 64), LDS_BYTES, stream, a); }
#endif
}
```

```cpp
#include <hip/hip_runtime.h>
#include <cstdio>
#include <cstdint>

typedef unsigned short bf16;
typedef unsigned v4u __attribute__((ext_vector_type(4)));
typedef float f32x4 __attribute__((ext_vector_type(4)));

constexpr int NB = 16, S = 2048, T = NB * S, D = 1024;
constexpr int SBH = 8, HD = 64, SBW = 512, CVW = 256, MXH = 4, MXW = 256, INW = 2304, NMEM = 256, TM = NB * NMEM;
constexpr int NE = 32, TOPK = 4, DFF = 1024, CONVK = 31;
constexpr int PMAX = T * TOPK + NE * 256;
constexpr float EPS = 1e-6f;
constexpr float SB_EXIT_LIN = 2.0611536e-9f;

constexpr size_t MiB = 1u << 20;
constexpr size_t WS_CTL = 0, CTL_BYTES = 64 * 1024;
constexpr size_t WS_WIN = 2 * MiB;
constexpr size_t WS_WOUT = 7 * MiB;
constexpr size_t WS_WMKV = 9 * MiB;
constexpr size_t WS_WPW2 = 10 * MiB;
constexpr size_t WS_WGU = 16 * MiB;
constexpr size_t WS_WDN = 144 * MiB;
constexpr size_t WS_MEMN = 208 * MiB;
constexpr size_t WS_MEMK = 216 * MiB;
constexpr size_t WS_MEMVT = 218 * MiB;
constexpr size_t WS_LIST = 220 * MiB;
constexpr size_t WS_TOKE = 224 * MiB;
constexpr size_t WS_TOKS = 224 * MiB + 512 * 1024;
constexpr size_t WS_TOKG = 225 * MiB;
constexpr size_t WS_RSX = 225 * MiB + 512 * 1024;
constexpr size_t WS_HN = 226 * MiB;
constexpr size_t WS_XN = 768 * MiB;
constexpr size_t WS_Q = 832 * MiB;
constexpr size_t WS_K = 864 * MiB;
constexpr size_t WS_VT = 896 * MiB;
constexpr size_t WS_GLU = 928 * MiB;
constexpr size_t WS_QMX = 944 * MiB;
constexpr size_t WS_CAT = 960 * MiB;
constexpr size_t WS_HACT = 562 * MiB;
constexpr size_t WS_Y = 290 * MiB;
constexpr size_t WS_MIX = 700 * MiB;
constexpr size_t WS_HB = 426 * MiB;
constexpr size_t WS_END = 1024 * MiB;
constexpr size_t WS_OSB = 562 * MiB;
constexpr size_t WS_OCV = 626 * MiB;
constexpr size_t WS_OMX = 658 * MiB;
static_assert((size_t)PMAX * 1024 * 2 == 272 * MiB, "padded rows");
constexpr int CW_CNT = 64;
constexpr float W8_SCALE = 32.0f;

__device__ __forceinline__ float bf2f(unsigned v) { return __uint_as_float(v << 16); }
__device__ __forceinline__ unsigned f2bf(float f) { unsigned u = __float_as_uint(f); return (u + 0x7fffu + ((u >> 16) & 1u)) >> 16; }
__device__ __forceinline__ unsigned pk2(float lo, float hi) { return f2bf(lo) | (f2bf(hi) << 16); }
__device__ __forceinline__ float wave_sum(float v) {
    v += __int_as_float(__builtin_amdgcn_mov_dpp(__float_as_int(v), 0xB1, 0xf, 0xf, true));
    v += __int_as_float(__builtin_amdgcn_mov_dpp(__float_as_int(v), 0x4E, 0xf, 0xf, true));
    v += __int_as_float(__builtin_amdgcn_mov_dpp(__float_as_int(v), 0x141, 0xf, 0xf, true));
    v += __int_as_float(__builtin_amdgcn_mov_dpp(__float_as_int(v), 0x140, 0xf, 0xf, true));
    const int iv = __float_as_int(v);
    return (__int_as_float(__builtin_amdgcn_readlane(iv, 0)) + __int_as_float(__builtin_amdgcn_readlane(iv, 16))) + (__int_as_float(__builtin_amdgcn_readlane(iv, 32)) + __int_as_float(__builtin_amdgcn_readlane(iv, 48)));
}
__device__ __forceinline__ float wave_max(float v) {
    v = fmaxf(v, __int_as_float(__builtin_amdgcn_mov_dpp(__float_as_int(v), 0xB1, 0xf, 0xf, true)));
    v = fmaxf(v, __int_as_float(__builtin_amdgcn_mov_dpp(__float_as_int(v), 0x4E, 0xf, 0xf, true)));
    v = fmaxf(v, __int_as_float(__builtin_amdgcn_mov_dpp(__float_as_int(v), 0x141, 0xf, 0xf, true)));
    v = fmaxf(v, __int_as_float(__builtin_amdgcn_mov_dpp(__float_as_int(v), 0x140, 0xf, 0xf, true)));
    const int iv = __float_as_int(v);
    return fmaxf(fmaxf(__int_as_float(__builtin_amdgcn_readlane(iv, 0)), __int_as_float(__builtin_amdgcn_readlane(iv, 16))), fmaxf(__int_as_float(__builtin_amdgcn_readlane(iv, 32)), __int_as_float(__builtin_amdgcn_readlane(iv, 48))));
}

__device__ __forceinline__ float half_max(float v) {
    v = fmaxf(v, __int_as_float(__builtin_amdgcn_mov_dpp(__float_as_int(v), 0xB1, 0xf, 0xf, true)));
    v = fmaxf(v, __int_as_float(__builtin_amdgcn_mov_dpp(__float_as_int(v), 0x4E, 0xf, 0xf, true)));
    v = fmaxf(v, __int_as_float(__builtin_amdgcn_mov_dpp(__float_as_int(v), 0x141, 0xf, 0xf, true)));
    v = fmaxf(v, __int_as_float(__builtin_amdgcn_mov_dpp(__float_as_int(v), 0x140, 0xf, 0xf, true)));
    const int iv = __float_as_int(v);
    const float lo = fmaxf(__int_as_float(__builtin_amdgcn_readlane(iv, 0)), __int_as_float(__builtin_amdgcn_readlane(iv, 16))), hi = fmaxf(__int_as_float(__builtin_amdgcn_readlane(iv, 32)), __int_as_float(__builtin_amdgcn_readlane(iv, 48)));
    return (threadIdx.x & 32) ? hi : lo;
}
__device__ __forceinline__ float xhalf(float v) {
    const auto r = __builtin_amdgcn_permlane32_swap(__float_as_uint(v), __float_as_uint(v), false, false);
    return __uint_as_float((threadIdx.x & 32) ? r[0] : r[1]);
}
__device__ __forceinline__ void transpose_item(const float* W, int K, int N, bf16* WT, int k0, int n0, int dstrow0, const float* kscale, float* scr, int lane) {
    float vv[32];
#pragma unroll
    for (int i = 0; i < 32; ++i) { const int kk = 2 * i + (lane >> 5); vv[i] = __builtin_nontemporal_load(W + (size_t)(k0 + kk) * N + n0 + (lane & 31)); }
#pragma unroll
    for (int i = 0; i < 32; ++i) { const int kk = 2 * i + (lane >> 5); float v = vv[i]; if (kscale) v *= kscale[k0 + kk]; scr[kk * 33 + (lane & 31)] = v; }
    asm volatile("s_waitcnt lgkmcnt(0)" ::: "memory");
    const int c = lane & 7;
#pragma unroll
    for (int j = 0; j < 4; ++j) { const int n = (lane >> 3) + 8 * j; const float* s = scr + (8 * c) * 33 + n;
        v4u o; o.x = pk2(s[0 * 33], s[1 * 33]); o.y = pk2(s[2 * 33], s[3 * 33]); o.z = pk2(s[4 * 33], s[5 * 33]); o.w = pk2(s[6 * 33], s[7 * 33]);
        *(v4u*)(WT + (size_t)(dstrow0 + n) * K + k0 + 8 * c) = o; }
    asm volatile("s_waitcnt lgkmcnt(0)" ::: "memory");
}
__device__ __forceinline__ void transpose_item_fp8(const float* W, int K, int N, unsigned char* WT, int k0, int n0, int dstrow0, float* scr, int lane) {
    float vv[64];
#pragma unroll
    for (int i = 0; i < 64; ++i) { const int kk = 2 * i + (lane >> 5); vv[i] = __builtin_nontemporal_load(W + (size_t)(k0 + kk) * N + n0 + (lane & 31)); }
#pragma unroll
    for (int i = 0; i < 64; ++i) { const int kk = 2 * i + (lane >> 5); scr[kk * 33 + (lane & 31)] = vv[i] * W8_SCALE; }
    asm volatile("s_waitcnt lgkmcnt(0)" ::: "memory");
    const int c = lane & 15;
#pragma unroll
    for (int j = 0; j < 8; ++j) { const int n = (lane >> 4) + 4 * j; const float* s = scr + (8 * c) * 33 + n;
        int w0 = 0, w1 = 0;
        w0 = __builtin_amdgcn_cvt_pk_fp8_f32(s[0 * 33], s[1 * 33], w0, false); w0 = __builtin_amdgcn_cvt_pk_fp8_f32(s[2 * 33], s[3 * 33], w0, true);
        w1 = __builtin_amdgcn_cvt_pk_fp8_f32(s[4 * 33], s[5 * 33], w1, false); w1 = __builtin_amdgcn_cvt_pk_fp8_f32(s[6 * 33], s[7 * 33], w1, true);
        __builtin_nontemporal_store((unsigned long long)(unsigned)w0 | ((unsigned long long)(unsigned)w1 << 32), (unsigned long long*)(WT + (size_t)(dstrow0 + n) * K + k0 + 8 * c)); }
    asm volatile("s_waitcnt lgkmcnt(0)" ::: "memory");
}
__device__ __forceinline__ void rms_row_to_bf16(const float* xrow, const f32x4 (&gg)[4], bf16* orow, int lane, float* irs_out = nullptr) {
    const f32x4* xr = (const f32x4*)xrow + lane;
    f32x4 v[4]; float s = 0.f;
#pragma unroll
    for (int j = 0; j < 4; ++j) { v[j] = __builtin_nontemporal_load(xr + 64 * j); s += (v[j].x * v[j].x + v[j].y * v[j].y) + (v[j].z * v[j].z + v[j].w * v[j].w); }
    const float sq = sqrtf(wave_sum(s) * (1.f / D) + EPS), rs = 1.0f / sq;
    if (irs_out && lane == 0) *irs_out = sq;
    unsigned long long* o8 = (unsigned long long*)orow + lane;
#pragma unroll
    for (int j = 0; j < 4; ++j) o8[64 * j] = (unsigned long long)pk2(v[j].x * rs * gg[j].x, v[j].y * rs * gg[j].y) | ((unsigned long long)pk2(v[j].z * rs * gg[j].z, v[j].w * rs * gg[j].w) << 32);
}

struct Ptrs {
    const float* in[25]; float* out; unsigned char* ws;
};

#define LAS __attribute__((address_space(3)))
typedef short bf16x8 __attribute__((ext_vector_type(8)));
typedef unsigned u32x4 __attribute__((ext_vector_type(4)));
typedef int v4i __attribute__((ext_vector_type(4)));
typedef int v8i __attribute__((ext_vector_type(8)));
namespace pg {
constexpr int BM = 256, BK = 64, HALF = 128, HTB = HALF * BK * 2, STAGE_BYTES = 8 * HTB, GK = 1024;
__host__ __device__ __forceinline__ int lds_byte(int r, int c) { const int st = (r >> 4) * 2 + (c >> 5), rr = r & 15, cc = c & 31, ob = rr * 64 + cc * 2; return st * 1024 + (ob ^ (((ob >> 9) & 1) << 5)); }
__host__ __device__ __forceinline__ void stage_rc(int b, int& R, int& C) { const int st = b / 1024, sb = b % 1024, swz = sb ^ (((sb >> 9) & 1) << 5); R = (st >> 1) * 16 + swz / 64; C = (st & 1) * 32 + (swz % 64) / 2; }
__host__ __device__ __forceinline__ int perm32(int rho) { const int n = rho >> 4, i = rho & 15; return 8 * (i >> 2) + 4 * n + (i & 3); }
__host__ __device__ __forceinline__ int chi4(int fq) { return ((fq & 1) << 1) | (fq >> 1); }
__host__ __device__ __forceinline__ int perm32x(int rho) { const int n = rho >> 4, i = rho & 15; return 8 * chi4(i >> 2) + 4 * n + (i & 3); }
__device__ __forceinline__ unsigned cvt_pk_bf16(float lo, float hi) { unsigned r; asm volatile("v_cvt_pk_bf16_f32 %0, %1, %2" : "=v"(r) : "v"(lo), "v"(hi)); return r; }

struct GU {
    const char* A;
    const char* B;
    char* O;
    const float* bias;
    int ldc; float scale; int gslot; int kind;
    int row0, col0;
};

struct EpiBf16 {
    static constexpr int PERM = 1; bool nostore = false;
    __device__ __forceinline__ void operator()(const f32x4 (&acc)[2][2][4][2], const GU& u, int wr, int wc, int fr, int fq) const {
        bf16* base = (bf16*)u.O + (size_t)(wr * 64 + fr) * u.ldc + wc * 32 + 8 * fq; const float sc = u.scale;
        f32x4 bv[2][2];
#pragma unroll
        for (int bj = 0; bj < 2; ++bj)
#pragma unroll
            for (int n = 0; n < 2; ++n) bv[bj][n] = u.bias ? *(const f32x4*)(u.bias + bj * HALF + wc * 32 + 8 * fq + 4 * n) : (f32x4){0.f, 0.f, 0.f, 0.f};
#pragma unroll
        for (int ai = 0; ai < 2; ++ai)
#pragma unroll
            for (int m = 0; m < 4; ++m) { bf16* rowp = base + (size_t)(ai * HALF + m * 16) * u.ldc;
#pragma unroll
                for (int bj = 0; bj < 2; ++bj) { const f32x4 v0 = acc[ai][bj][m][0] * sc + bv[bj][0], v1 = acc[ai][bj][m][1] * sc + bv[bj][1];
                    u32x4 w; w.x = cvt_pk_bf16(v0[0], v0[1]); w.y = cvt_pk_bf16(v0[2], v0[3]); w.z = cvt_pk_bf16(v1[0], v1[1]); w.w = cvt_pk_bf16(v1[2], v1[3]);
                    if (!nostore) *(u32x4*)(rowp + bj * HALF) = w; } }
    }
};
struct EpiRes {
    static constexpr int PERM = 1; bool nostore = false; const bf16* xn; const float* rsx; const float* g1;
    __device__ __forceinline__ void operator()(const f32x4 (&acc)[2][2][4][2], const GU& u, int wr, int wc, int fr, int fq) const {
        const float sc = u.scale; const int r0 = u.row0 + wr * 64 + fr, c0 = u.col0 + wc * 32 + 8 * fq;
        f32x4 ig[2][2];
#pragma unroll
        for (int bj = 0; bj < 2; ++bj)
#pragma unroll
            for (int n = 0; n < 2; ++n) { const f32x4 g = *(const f32x4*)(g1 + c0 + bj * HALF + 4 * n); ig[bj][n] = (f32x4){1.0f / g.x, 1.0f / g.y, 1.0f / g.z, 1.0f / g.w}; }
#pragma unroll
        for (int ai = 0; ai < 2; ++ai) {
            u32x4 xv[4][2]; float irs[4];
#pragma unroll
            for (int m = 0; m < 4; ++m) { const int row = r0 + ai * HALF + m * 16; irs[m] = rsx[row];
#pragma unroll
                for (int bj = 0; bj < 2; ++bj) xv[m][bj] = *(const u32x4*)(xn + (size_t)row * 1024 + c0 + bj * HALF); }
#pragma unroll
            for (int m = 0; m < 4; ++m) { const int row = r0 + ai * HALF + m * 16;
#pragma unroll
                for (int bj = 0; bj < 2; ++bj) { const u32x4 x = xv[m][bj]; const f32x4 s0 = ig[bj][0] * irs[m], s1 = ig[bj][1] * irs[m];
                    const f32x4 v0 = acc[ai][bj][m][0] * sc + (f32x4){bf2f(x.x & 0xffffu), bf2f(x.x >> 16), bf2f(x.y & 0xffffu), bf2f(x.y >> 16)} * s0;
                    const f32x4 v1 = acc[ai][bj][m][1] * sc + (f32x4){bf2f(x.z & 0xffffu), bf2f(x.z >> 16), bf2f(x.w & 0xffffu), bf2f(x.w >> 16)} * s1;
                    u32x4 w; w.x = cvt_pk_bf16(v0[0], v0[1]); w.y = cvt_pk_bf16(v0[2], v0[3]); w.z = cvt_pk_bf16(v1[0], v1[1]); w.w = cvt_pk_bf16(v1[2], v1[3]);
                    if (!nostore) *(u32x4*)((bf16*)u.O + (size_t)row * 1024 + c0 + bj * HALF) = w; } }
        }
    }
};
__device__ __forceinline__ v4i pair16(int a0, int a1, int b0, int b1) {
    const auto s0 = __builtin_amdgcn_permlane32_swap((unsigned)a0, (unsigned)b0, false, false);
    const auto s1 = __builtin_amdgcn_permlane32_swap((unsigned)a1, (unsigned)b1, false, false);
    return (v4i){(int)s0[0], (int)s1[0], (int)s0[1], (int)s1[1]};
}
struct EpiFp8 {
    static constexpr int PERM = 2; bool nostore = false; unsigned char* rbase = nullptr;
    __device__ __forceinline__ void operator()(const f32x4 (&acc)[2][2][4][2], const GU& u, int wr, int wc, int fr, int fq) const {
        const int cx = 8 * chi4(fq);
        unsigned char* base = (rbase ? rbase : (unsigned char*)u.O) + (size_t)(wr * 64 + fr + (fq >> 1) * 16) * u.ldc + wc * 32 + 16 * (fq & 1); const float sc = u.scale;
        f32x4 bv[2][2];
#pragma unroll
        for (int bj = 0; bj < 2; ++bj)
#pragma unroll
            for (int n = 0; n < 2; ++n) bv[bj][n] = *(const f32x4*)(u.bias + bj * HALF + wc * 32 + cx + 4 * n);
#pragma unroll
        for (int ai = 0; ai < 2; ++ai)
#pragma unroll
            for (int mp = 0; mp < 2; ++mp)
#pragma unroll
                for (int bj = 0; bj < 2; ++bj) { int w[2][2];
#pragma unroll
                    for (int q = 0; q < 2; ++q) { const int m = 2 * mp + q; const f32x4 v0 = acc[ai][bj][m][0] * sc + bv[bj][0], v1 = acc[ai][bj][m][1] * sc + bv[bj][1];
                        int w0 = 0, w1 = 0;
                        w0 = __builtin_amdgcn_cvt_pk_fp8_f32(v0[0], v0[1], w0, false); w0 = __builtin_amdgcn_cvt_pk_fp8_f32(v0[2], v0[3], w0, true);
                        w1 = __builtin_amdgcn_cvt_pk_fp8_f32(v1[0], v1[1], w1, false); w1 = __builtin_amdgcn_cvt_pk_fp8_f32(v1[2], v1[3], w1, true);
                        w[q][0] = w0; w[q][1] = w1; }
                    const v4i o = pair16(w[0][0], w[0][1], w[1][0], w[1][1]);
                    if (!nostore) *(v4i*)(base + (size_t)(ai * HALF + mp * 32) * u.ldc + bj * HALF) = o; }
    }
};
struct EpiP1 {
    static constexpr int PERM = 1;
    __device__ __forceinline__ void operator()(const f32x4 (&acc)[2][2][4][2], const GU& u, int wr, int wc, int fr, int fq) const {
        const float sc = u.scale; const int H = u.ldc;
        if (u.kind == 3) {
            f32x4 ba[2], bgt[2];
#pragma unroll
            for (int n = 0; n < 2; ++n) { ba[n] = *(const f32x4*)(u.bias + wc * 32 + 8 * fq + 4 * n); bgt[n] = *(const f32x4*)(u.bias + 256 + wc * 32 + 8 * fq + 4 * n); }
#pragma unroll
            for (int ai = 0; ai < 2; ++ai)
#pragma unroll
                for (int m = 0; m < 4; ++m) { const int rr = ai * HALF + wr * 64 + m * 16 + fr; unsigned w[4];
#pragma unroll
                    for (int n = 0; n < 2; ++n) { const f32x4 av = acc[ai][0][m][n] * sc + ba[n], gv = acc[ai][1][m][n] * sc + bgt[n]; f32x4 uv;
#pragma unroll
                        for (int i = 0; i < 4; ++i) uv[i] = av[i] * __builtin_amdgcn_rcpf(1.0f + __builtin_amdgcn_exp2f(-1.44269504f * gv[i]));
                        w[2 * n] = cvt_pk_bf16(uv[0], uv[1]); w[2 * n + 1] = cvt_pk_bf16(uv[2], uv[3]); }
                    u32x4 o; o.x = w[0]; o.y = w[1]; o.z = w[2]; o.w = w[3];
                    *(u32x4*)((bf16*)u.O + (size_t)(u.row0 + rr) * 256 + u.col0 + wc * 32 + 8 * fq) = o; }
            return;
        }
        f32x4 bv[2][2];
#pragma unroll
        for (int bj = 0; bj < 2; ++bj)
#pragma unroll
            for (int n = 0; n < 2; ++n) bv[bj][n] = u.bias ? *(const f32x4*)(u.bias + bj * HALF + wc * 32 + 8 * fq + 4 * n) : (f32x4){0.f, 0.f, 0.f, 0.f};
#pragma unroll
        for (int ai = 0; ai < 2; ++ai)
#pragma unroll
            for (int m = 0; m < 4; ++m) { const int rr = ai * HALF + wr * 64 + m * 16 + fr;
#pragma unroll
                for (int bj = 0; bj < 2; ++bj) { const int cc = bj * HALF + wc * 32 + 8 * fq;
                    const f32x4 v0 = acc[ai][bj][m][0] * sc + bv[bj][0], v1 = acc[ai][bj][m][1] * sc + bv[bj][1];
                    const unsigned w0 = cvt_pk_bf16(v0[0], v0[1]), w1 = cvt_pk_bf16(v0[2], v0[3]), w2 = cvt_pk_bf16(v1[0], v1[1]), w3 = cvt_pk_bf16(v1[2], v1[3]);
                    if (u.kind == 0) { u32x4 w; w.x = w0; w.y = w1; w.z = w2; w.w = w3; *(u32x4*)((bf16*)u.O + (size_t)rr * u.ldc + cc) = w; }
                    else if (u.kind == 1) { const int row = u.row0 + rr, col = u.col0 + cc, hd = col >> 6, d = col & 63;
                        const size_t off = ((((size_t)(row >> 5) * H + hd) * 4 + (d >> 4)) * 64 + ((d >> 3) & 1) * 32 + (row & 31)) * 8;
                        u32x4 w; w.x = w0; w.y = w1; w.z = w2; w.w = w3; *(u32x4*)((bf16*)u.O + off) = w; }
                    else { const int f = u.row0 + rr, key = u.col0 + cc, hd = f >> 6, d = f & 63;
                        const size_t off = ((((size_t)(key >> 4) * H + hd) * 2 + (d >> 5)) * 64 + (d & 31)) * 8 + ((key >> 3) & 1) * 4;
                        *(unsigned long long*)((bf16*)u.O + off) = (unsigned long long)w0 | ((unsigned long long)w1 << 32);
                        *(unsigned long long*)((bf16*)u.O + off + 32 * 8) = (unsigned long long)w2 | ((unsigned long long)w3 << 32); }
                } }
    }
};
struct EpiSwiGLU {
    static constexpr int PERM = 2;
    __device__ __forceinline__ void operator()(const f32x4 (&acc)[2][2][4][2], const GU& u, int wr, int wc, int fr, int fq) const {
        typedef float f2 __attribute__((ext_vector_type(2)));
        const int cx = 8 * chi4(fq);
        unsigned char* base = (unsigned char*)u.O + (size_t)(wr * 64 + fr + (fq >> 1) * 16) * u.ldc + wc * 32 + 16 * (fq & 1); const float sc = u.scale;
        constexpr float C = -1.702f * 1.44269504f;
        f2 bg[4], bu[4];
#pragma unroll
        for (int n = 0; n < 2; ++n) { const f32x4 g4 = *(const f32x4*)(u.bias + wc * 32 + cx + 4 * n), u4 = *(const f32x4*)(u.bias + 1024 + wc * 32 + cx + 4 * n);
            bg[2 * n] = (f2){g4[0], g4[1]}; bg[2 * n + 1] = (f2){g4[2], g4[3]};
            bu[2 * n] = (f2){u4[0] + 1.0f, u4[1] + 1.0f}; bu[2 * n + 1] = (f2){u4[2] + 1.0f, u4[3] + 1.0f}; }
        const f2 sc2 = (f2){sc, sc};
#pragma unroll
        for (int ai = 0; ai < 2; ++ai)
#pragma unroll
            for (int mp = 0; mp < 2; ++mp) { int w[2][2];
#pragma unroll
                for (int qq = 0; qq < 2; ++qq) { const int m = 2 * mp + qq; f2 h[4];
#pragma unroll
                    for (int q = 0; q < 4; ++q) { const int n = q >> 1, j = (q & 1) * 2;
                        const f2 ag = (f2){acc[ai][0][m][n][j], acc[ai][0][m][n][j + 1]}, au = (f2){acc[ai][1][m][n][j], acc[ai][1][m][n][j + 1]};
                        f2 g = __builtin_elementwise_fma(ag, sc2, bg[q]), up = __builtin_elementwise_fma(au, sc2, bu[q]);
                        g.x = fminf(g.x, 7.0f); g.y = fminf(g.y, 7.0f); const f2 t = g * C;
                        up.x = __builtin_amdgcn_fmed3f(up.x, -6.0f, 8.0f); up.y = __builtin_amdgcn_fmed3f(up.y, -6.0f, 8.0f);
                        f2 d; d.x = __builtin_amdgcn_exp2f(t.x); d.y = __builtin_amdgcn_exp2f(t.y); d = d + 1.0f;
                        f2 r; r.x = __builtin_amdgcn_rcpf(d.x); r.y = __builtin_amdgcn_rcpf(d.y);
                        h[q] = (up * g) * r; }
                    int w0 = 0, w1 = 0;
                    w0 = __builtin_amdgcn_cvt_pk_fp8_f32(h[0].x, h[0].y, w0, false); w0 = __builtin_amdgcn_cvt_pk_fp8_f32(h[1].x, h[1].y, w0, true);
                    w1 = __builtin_amdgcn_cvt_pk_fp8_f32(h[2].x, h[2].y, w1, false); w1 = __builtin_amdgcn_cvt_pk_fp8_f32(h[3].x, h[3].y, w1, true);
                    w[qq][0] = w0; w[qq][1] = w1; }
                *(v4i*)(base + (size_t)(ai * HALF + mp * 32) * u.ldc) = pair16(w[0][0], w[0][1], w[1][0], w[1][1]); }
    }
};

#ifndef STAGGER_TICKS
#define STAGGER_TICKS 0
#endif
template <class Epi, class Sched, bool GATHER, bool FP8>
__device__ __forceinline__ void gemm_phase(LAS unsigned char* lds, const Sched& S, const Epi& E, const LAS unsigned* gtab) {
    const int tid = threadIdx.x, wid = __builtin_amdgcn_readfirstlane(tid >> 6), lane = tid & 63, wr = wid >> 2, wc = wid & 3, fr = lane & 15, fq = lane >> 4;
    constexpr int PITCH = FP8 ? GK : GK * 2, nt = FP8 ? GK / 128 : GK / BK;
    unsigned voffB[2]; int Rr[2], Cc2[2];
#pragma unroll
    for (int i = 0; i < 2; ++i) { int R, C; stage_rc(tid * 16 + i * 8192, R, C); const int Rb = (Epi::PERM == 2) ? ((R & ~31) + perm32x(R & 31)) : (Epi::PERM ? ((R & ~31) + perm32(R & 31)) : R);
        voffB[i] = (unsigned)(Rb * PITCH + C * 2); Rr[i] = R; Cc2[i] = C * 2; }
    constexpr size_t kstep = (size_t)(BK * 2);
    constexpr size_t hstep = (size_t)HALF * PITCH;
    const unsigned ldsw = (unsigned)wid * 1024u;
    const int aoff = lds_byte(wr * 64 + fr, fq * 8);
    unsigned boffv = (unsigned)(size_t)lds + 4 * HTB + lds_byte(wc * 32 + fr, fq * 8);
    asm volatile("" : "+v"(boffv));
#define PG_SA(b, h) (((b) * 2 + (h)) * HTB)
#define PG_SB(b, h) ((4 + (b) * 2 + (h)) * HTB)
#define PG_STAGE(bufoff, gbase, voff) do { _Pragma("unroll") for (int _i = 0; _i < 2; ++_i) \
        __builtin_amdgcn_global_load_lds((const unsigned*)((const char*)(gbase) + (voff)[_i]), (LAS unsigned*)(lds + (bufoff) + ldsw + _i * 8192), 16, 0, 0); } while (0)
#define PG_RD16(off) (*(const LAS v4i*)(lds + (off)))
#define PG_LDA(dst, b, h) do { _Pragma("unroll") for (int m = 0; m < 4; ++m) dst[m] = __builtin_shufflevector(PG_RD16(PG_SA(b, h) + aoff + m * 2048), PG_RD16(PG_SA(b, h) + aoff + m * 2048 + 1024), 0, 1, 2, 3, 4, 5, 6, 7); } while (0)
#define PG_RDB16(off) (*(const LAS v4i*)((LAS unsigned char*)(size_t)boffv + (off)))
#define PG_LDB(dst, b, h) do { _Pragma("unroll") for (int n = 0; n < 2; ++n) dst[n] = __builtin_shufflevector(PG_RDB16(((b) * 2 + (h)) * HTB + n * 2048), PG_RDB16(((b) * 2 + (h)) * HTB + n * 2048 + 1024), 0, 1, 2, 3, 4, 5, 6, 7); } while (0)
#define PG_LO(x) __builtin_bit_cast(bf16x8, __builtin_shufflevector((x), (x), 0, 1, 2, 3))
#define PG_HI(x) __builtin_bit_cast(bf16x8, __builtin_shufflevector((x), (x), 4, 5, 6, 7))
#define PG_MMA(ai, bj, At, Bt) do { __builtin_amdgcn_s_setprio(1); _Pragma("unroll") for (int m = 0; m < 4; ++m) _Pragma("unroll") for (int n = 0; n < 2; ++n) { \
        if constexpr (FP8) { asm volatile("v_mfma_scale_f32_16x16x128_f8f6f4 %0, %1, %2, %0, %3, %3 op_sel_hi:[0,0,0]" : "+v"(acc[ai][bj][m][n]) : "v"(Bt[n]), "v"(At[m]), "v"(sc1)); } \
        else { acc[ai][bj][m][n] = __builtin_amdgcn_mfma_f32_16x16x32_bf16(PG_LO(Bt[n]), PG_LO(At[m]), acc[ai][bj][m][n], 0, 0, 0); \
               acc[ai][bj][m][n] = __builtin_amdgcn_mfma_f32_16x16x32_bf16(PG_HI(Bt[n]), PG_HI(At[m]), acc[ai][bj][m][n], 0, 0, 0); } } \
        __builtin_amdgcn_s_setprio(0); } while (0)
#define PG_WAIT_V(n) asm volatile("s_waitcnt vmcnt(" #n ")" ::: "memory")
#define PG_WAIT_L(n) asm volatile("s_waitcnt lgkmcnt(" #n ")" ::: "memory")
#define PG_BAR __builtin_amdgcn_s_barrier()
#define PG_SCHED __builtin_amdgcn_sched_barrier(0)
#define PG_LOADVO(vo, u) do { _Pragma("unroll") for (int _h = 0; _h < 2; ++_h) _Pragma("unroll") for (int _i = 0; _i < 2; ++_i) \
        vo[_h][_i] = GATHER ? (gtab[(u).gslot * 256 + _h * HALF + Rr[_i]] + (unsigned)Cc2[_i]) : (unsigned)((_h * HALF + Rr[_i]) * PITCH + Cc2[_i]); } while (0)
    int sc1 = 0x7f7f7f7f; asm volatile("" : "+v"(sc1));
    GU cur, nxt; int ui = 0;
    if (!S.next(0, cur)) return;
    if (STAGGER_TICKS > 0) {
        const unsigned long long t0 = __builtin_amdgcn_s_memrealtime(); const unsigned long long dl = (unsigned long long)((blockIdx.x * 5u) & 15u) * STAGGER_TICKS;
        while (__builtin_amdgcn_s_memrealtime() - t0 < dl) __builtin_amdgcn_s_sleep(8);
    }
    f32x4 acc[2][2][4][2];
#pragma unroll
    for (int a = 0; a < 2; ++a)
#pragma unroll
        for (int b = 0; b < 2; ++b)
#pragma unroll
            for (int m = 0; m < 4; ++m)
#pragma unroll
                for (int n = 0; n < 2; ++n) acc[a][b][m][n] = (f32x4){0.f, 0.f, 0.f, 0.f};
    v8i At[4], B0[2], B1[2];
    unsigned cvo[2][2], nvo[2][2];
    PG_LOADVO(cvo, cur);
    const char* cA = cur.A; const char* cB = cur.B;
    PG_STAGE(PG_SB(0, 0), cB, voffB); PG_STAGE(PG_SB(0, 1), cB + hstep, voffB); PG_STAGE(PG_SA(0, 0), cA, cvo[0]); PG_STAGE(PG_SA(0, 1), cA, cvo[1]);
    if (wr == 1) PG_BAR;
    PG_WAIT_V(2); PG_BAR;
    PG_STAGE(PG_SB(1, 0), cB + kstep, voffB); PG_STAGE(PG_SA(1, 0), cA + kstep, cvo[0]); PG_STAGE(PG_SB(1, 1), cB + hstep + kstep, voffB);
    PG_WAIT_V(6); PG_BAR;
    for (;;) {
        const bool has_next = S.next(ui + 1, nxt);
        const char* nA = has_next ? nxt.A : cA; const char* nB = has_next ? nxt.B : cB;
        if (GATHER) { if (has_next) { PG_LOADVO(nvo, nxt); } else {
#pragma unroll
            for (int h = 0; h < 2; ++h)
#pragma unroll
                for (int i = 0; i < 2; ++i) nvo[h][i] = cvo[h][i]; } }
#pragma unroll 1
        for (int t = 0; t < nt; t += 2) {
            const bool last = (t == nt - 2);
            const char* a1 = cA + (size_t)(t + 1) * kstep;
            const char* a2 = last ? nA : cA + (size_t)(t + 2) * kstep; const char* b2 = last ? nB : cB + (size_t)(t + 2) * kstep;
            const char* a3 = a2 + kstep; const char* b3 = b2 + kstep;
            unsigned vo2[2][2];
#pragma unroll
            for (int h = 0; h < 2; ++h)
#pragma unroll
                for (int i = 0; i < 2; ++i) vo2[h][i] = (GATHER && last) ? nvo[h][i] : cvo[h][i];
            PG_LDB(B0, 0, 0); PG_LDB(B1, 0, 1); PG_SCHED; PG_LDA(At, 0, 0); PG_STAGE(PG_SA(1, 1), a1, cvo[1]);
            PG_WAIT_V(8); PG_WAIT_L(0); PG_BAR; PG_MMA(0, 0, At, B0); PG_MMA(0, 1, At, B1); PG_BAR; PG_SCHED;
            PG_LDA(At, 0, 1); PG_STAGE(PG_SB(0, 0), b2, voffB); PG_STAGE(PG_SB(0, 1), b2 + hstep, voffB); PG_STAGE(PG_SA(0, 0), a2, vo2[0]);
            PG_WAIT_V(8); PG_WAIT_L(0); PG_BAR; PG_MMA(1, 0, At, B0); PG_MMA(1, 1, At, B1); PG_BAR; PG_SCHED;
            PG_LDB(B0, 1, 0); PG_LDB(B1, 1, 1); PG_SCHED; PG_LDA(At, 1, 0); PG_STAGE(PG_SA(0, 1), a2, vo2[1]);
            PG_WAIT_V(8); PG_WAIT_L(0); PG_BAR; PG_MMA(0, 0, At, B0); PG_MMA(0, 1, At, B1); PG_BAR; PG_SCHED;
            PG_LDA(At, 1, 1); PG_STAGE(PG_SB(1, 0), b3, voffB); PG_STAGE(PG_SB(1, 1), b3 + hstep, voffB); PG_STAGE(PG_SA(1, 0), a3, vo2[0]);
            PG_WAIT_V(8); PG_WAIT_L(0); PG_BAR; PG_MMA(1, 0, At, B0); PG_MMA(1, 1, At, B1); PG_BAR; PG_SCHED;
        }
        if (wr == 0) PG_BAR;
        if constexpr (FP8) { asm volatile("s_nop 15\n\ts_nop 15" ::: "memory"); }
        E(acc, cur, wr, wc, fr, fq);
        if (!has_next) break;
#pragma unroll
        for (int a = 0; a < 2; ++a)
#pragma unroll
            for (int b = 0; b < 2; ++b)
#pragma unroll
                for (int m = 0; m < 4; ++m)
#pragma unroll
                    for (int n = 0; n < 2; ++n) acc[a][b][m][n] = (f32x4){0.f, 0.f, 0.f, 0.f};
        cur = nxt; cA = nA; cB = nB; ++ui;
        if (GATHER) {
#pragma unroll
            for (int h = 0; h < 2; ++h)
#pragma unroll
                for (int i = 0; i < 2; ++i) cvo[h][i] = nvo[h][i]; }
        if (wr == 1) PG_BAR;
    }
    PG_WAIT_V(0);
    PG_BAR;
#undef PG_SA
#undef PG_SB
#undef PG_STAGE
#undef PG_LDA
#undef PG_RD16
#undef PG_RDB16
#undef PG_LO
#undef PG_HI
#undef PG_LDB
#undef PG_MMA
#undef PG_WAIT_V
#undef PG_WAIT_L
#undef PG_BAR
#undef PG_SCHED
#undef PG_LOADVO
}
}

constexpr int NWAVES = 8;
constexpr int RING_OFF = 0, RING_BYTES = 131072;
constexpr int GTAB_OFF = RING_BYTES, GTAB_BYTES = 18 * 1024;
constexpr int UTAB_OFF = GTAB_OFF + GTAB_BYTES, UTAB_BYTES = 1024;
constexpr int MISC_OFF = UTAB_OFF + UTAB_BYTES;
constexpr int LDS_BYTES = MISC_OFF + 512;
static_assert(LDS_BYTES <= 160 * 1024, "LDS");

#ifndef REP_PHASE
#define REP_PHASE -1
#endif
#define NREP(k) ((REP_PHASE) == (k) ? 2 : 1)
struct MKArgs { Ptrs p; int ph_lo, ph_hi, li, pad; };

#define XB_TMO      128
#define XB_XCNT(j)  (256  + 64 * (j))
#define XB_XSUB(j)  (1280 + 64 * (j))
#define XB_XGEN(j)  (2304 + 64 * (j))
#define XB_TOP      3328
#define XB_TOPGEN   3392
#define XCD_BAR_WORDS 3456
#define XB_SPIN_CAP (1u << 18)
__device__ __forceinline__ unsigned xb_ld(unsigned* p)              { return __hip_atomic_load(p, __ATOMIC_RELAXED, __HIP_MEMORY_SCOPE_AGENT); }
__device__ __forceinline__ unsigned xb_add(unsigned* p, unsigned v) { return __hip_atomic_fetch_add(p, v, __ATOMIC_RELAXED, __HIP_MEMORY_SCOPE_AGENT); }
__device__ __forceinline__ unsigned xb_xcc_id() { return (unsigned)__builtin_amdgcn_s_getreg((3 << 11) | 20) & 0xFu; }
#define XB_SPIN(cond, bar) do { unsigned _sp = 0; while (cond) { __builtin_amdgcn_s_sleep(1); \
    if ((++_sp & 255u) == 0u) { if (xb_ld(&(bar)[XB_TMO])) break; if (_sp > XB_SPIN_CAP) { atomicAdd(&(bar)[XB_TMO], 1u); break; } } } } while (0)
struct XcdBarrier { unsigned* bar; unsigned x; volatile LAS unsigned* st; };
__device__ __forceinline__ XcdBarrier xcd_barrier_post(unsigned* bar, volatile LAS unsigned* st) {
    XcdBarrier b; b.bar = bar; b.x = xb_xcc_id(); b.st = st;
    if (threadIdx.x == 0) (void)xb_add(&bar[XB_XCNT(b.x)], 1u);
    return b;
}
__device__ __forceinline__ void xcd_barrier_complete(unsigned* bar, unsigned x, unsigned& nloc, unsigned& nx) {
    const unsigned G = gridDim.x * gridDim.y * gridDim.z;
    unsigned sum, cnt, mine, sp = 0u;
    for (;;) {
        sum = 0u; cnt = 0u; mine = 0u;
#pragma unroll
        for (unsigned j = 0; j < 16; ++j) { const unsigned c = xb_ld(&bar[XB_XCNT(j)]); sum += c; cnt += (c > 0u) ? 1u : 0u; mine = (j == x) ? c : mine; }
        if (sum == G) break;
        __builtin_amdgcn_s_sleep(1);
        if ((++sp & 255u) == 0u) { if (xb_ld(&bar[XB_TMO])) break; if (sp > XB_SPIN_CAP) { atomicAdd(&bar[XB_TMO], 1u); break; } }
    }
    nloc = mine > 0u ? mine : 1u; nx = cnt > 0u ? cnt : 1u;
}
__device__ __forceinline__ void xcd_barrier_core(const XcdBarrier& b) {
    if (threadIdx.x == 0) {
        unsigned* bar = b.bar;
        __builtin_amdgcn_s_waitcnt(0);
        unsigned nloc = b.st[0], nx = b.st[1];
        if (nloc == 0u) { xcd_barrier_complete(bar, b.x, nloc, nx); b.st[0] = nloc; b.st[1] = nx; }
        const unsigned old = xb_add(&bar[XB_XSUB(b.x)], 1u);
        const unsigned gen = old / nloc;
        if (old + 1u == (gen + 1u) * nloc) {
            __builtin_amdgcn_fence(__ATOMIC_RELEASE, "agent");
            asm volatile("s_waitcnt vmcnt(0)" ::: "memory");
            const unsigned og = xb_add(&bar[XB_TOP], 1u);
            const unsigned tg = og / nx;
            if (og + 1u == (tg + 1u) * nx) xb_add(&bar[XB_TOPGEN], 1u);
            else XB_SPIN(xb_ld(&bar[XB_TOPGEN]) == tg, bar);
            __builtin_amdgcn_fence(__ATOMIC_ACQUIRE, "agent");
            xb_add(&bar[XB_XGEN(b.x)], 1u);
            asm volatile("s_waitcnt vmcnt(0)" ::: "memory");
        } else {
            XB_SPIN(xb_ld(&bar[XB_XGEN(b.x)]) == gen, bar);
            __builtin_amdgcn_fence(__ATOMIC_ACQUIRE, "agent");
            asm volatile("s_waitcnt vmcnt(0)" ::: "memory");
        }
    }
}
__device__ __forceinline__ void xcd_barrier(const XcdBarrier& b) {
    asm volatile("s_waitcnt vmcnt(0)" ::: "memory");
    __syncthreads();
    xcd_barrier_core(b);
    __syncthreads();
}
__device__ __forceinline__ void conv_gu_item(const Ptrs& p, int r, float* scr, int lane) {
    const int e = r / 512, q = r % 512, kb = q / 64, nb = q % 64; const int n0 = 32 * nb, isup = n0 >> 10, cc = n0 & 1023, j = cc >> 7, c = cc & 127;
    transpose_item_fp8(p.in[20] + (size_t)e * 1024 * 2048, 1024, 2048, (unsigned char*)(p.ws + WS_WGU) + (size_t)e * 2048 * 1024, 128 * kb, n0, 256 * j + 128 * isup + c, scr, lane);
}
__device__ __forceinline__ void conv_dn_item(const Ptrs& p, int r, float* scr, int lane) {
    const int e = r / 256, q = r % 256, kb = q / 32, nb = q % 32;
    transpose_item_fp8(p.in[22] + (size_t)e * 1024 * 1024, 1024, 1024, (unsigned char*)(p.ws + WS_WDN) + (size_t)e * 1024 * 1024, 128 * kb, 32 * nb, 32 * nb, scr, lane);
}
constexpr int SH_WAVES = 7;
#ifndef SH_Q0
#define SH_Q0 3
#define SH_Q1 3
#define SH_Q1H 5
#define SH_Q2 2
#define SH_Q3 2
#define SH_Q4 2
#endif
constexpr int SH_I_GU = 32 * 8 * 64, SH_I_DN = 32 * 8 * 32;
__host__ __device__ constexpr int sh_quota(int k) { return k == 0 ? SH_Q0 : k == 1 ? SH_Q1 : k == 2 ? SH_Q2 : k == 3 ? SH_Q3 : k == 4 ? SH_Q4 : 0; }
__host__ __device__ constexpr int sh_base(int k, int G, int n1) { int t = 0; for (int j = 0; j < k; ++j) t += (j == 1) ? n1 : sh_quota(j) * SH_WAVES * G; return t; }
#ifndef SH_T5
#define SH_T5 2048
#endif
constexpr int SH_LIN_END = SH_I_GU + SH_I_DN - SH_T5;
__device__ __forceinline__ void conv_lin_item(const Ptrs& p, int r, float* scr, int lane, int lim = SH_LIN_END) { if (r < SH_I_GU) conv_gu_item(p, r, scr, lane); else if (r < lim) conv_dn_item(p, r - SH_I_GU, scr, lane); }
__device__ __forceinline__ void shadow_items(const Ptrs& p, int idx, int n, float* scr, int lane) {
    for (int i = 0; i < n; ++i) conv_lin_item(p, idx + i, scr, lane); }
__device__ __forceinline__ void xcd_barrier_sh(const XcdBarrier& b, const Ptrs& p, int idx, int n, int wave, float* scr, int lane) {
    asm volatile("s_waitcnt vmcnt(0)" ::: "memory");
    __syncthreads();
    if (wave == 0) xcd_barrier_core(b);
    else shadow_items(p, idx, n, scr, lane);
    __syncthreads();
}
constexpr int CW_BAR = 4096;

struct SchedP1 {
    int G, c; unsigned char* ws; const float* b_glu;
    static constexpr int N_A = 128 * 7, N_B = 256, N_C = 32, NU = N_A + N_B + N_C;
    __device__ __forceinline__ bool next(int i, pg::GU& u) const {
        const int L = i * G + c; if (L >= NU) return false;
        u.bias = nullptr; u.scale = 1.0f; u.gslot = 0; u.kind = 1; u.row0 = 0; u.col0 = 0; u.ldc = 8;
        if (L < N_A) { const int pm = L / 7, pn = L % 7;
            u.A = (const char*)(ws + WS_XN) + (size_t)pm * 256 * 2048; u.row0 = pm * 256;
            const int brow = pn < 4 ? 256 * pn : 256 * (pn + 2); u.B = (const char*)(ws + WS_WIN) + (size_t)brow * 2048;
            if (pn < 2) { u.O = (char*)(ws + WS_Q); u.col0 = pn * 256; u.scale = 0.125f * 1.44269504f; }
            else if (pn < 4) { u.O = (char*)(ws + WS_K); u.col0 = (pn - 2) * 256; }
            else if (pn < 6) { u.kind = 3; u.O = (char*)(ws + WS_GLU); u.col0 = (pn - 4) * 128; u.bias = b_glu + (pn - 4) * 128; }
            else { u.O = (char*)(ws + WS_QMX); u.ldc = 4; u.scale = 0.125f * 1.44269504f; }
        } else if (L < N_A + N_B) { const int q = L - N_A, pn = q >> 1, pm = q & 1;
            u.A = (const char*)(ws + WS_WIN) + (size_t)(1024 + 256 * pm) * 2048; u.B = (const char*)(ws + WS_XN) + (size_t)pn * 256 * 2048;
            u.kind = 2; u.O = (char*)(ws + WS_VT); u.row0 = 256 * pm; u.col0 = 256 * pn;
        } else { int q = L - N_A - N_B; u.ldc = 4;
            if (q < 16) { u.A = (const char*)(ws + WS_MEMN) + (size_t)q * 256 * 2048; u.B = (const char*)(ws + WS_WMKV); u.O = (char*)(ws + WS_MEMK); u.row0 = q * 256; }
            else { q -= 16; u.A = (const char*)(ws + WS_WMKV) + (size_t)256 * 2048; u.B = (const char*)(ws + WS_MEMN) + (size_t)q * 256 * 2048; u.kind = 2; u.O = (char*)(ws + WS_MEMVT); u.col0 = q * 256; }
        }
        return true;
    }
};
struct SchedP3 {
    int G, c; unsigned char* ws;
    __device__ __forceinline__ bool next(int i, pg::GU& u) const {
        const int L = i * G + c; if (L >= 512) return false;
        const int pm = L >> 2, pn = L & 3;
        u.A = (const char*)(ws + WS_CAT) + (size_t)pm * 256 * 2048; u.B = (const char*)(ws + WS_WOUT) + (size_t)pn * 256 * 2048;
        u.O = (char*)(ws + WS_HB); u.bias = nullptr; u.ldc = 1024; u.scale = 1.0f; u.gslot = 0; u.kind = 0; u.row0 = pm * 256; u.col0 = pn * 256;
        return true;
    }
};
constexpr int UT_CNT = 0, UT_PST = 32, UT_UST = 64, UT_TOT = 96, UT_UNIT = 128, MAXU = 18;
template <int NPN, bool BACK = false>
__device__ __forceinline__ void moe_tables(LAS int* ut, const unsigned* cnt, int G, int vcu, int tid) {
    if (tid < 64) {
        const int c = tid < 32 ? (int)cnt[tid] : 0; const int np = (c + 255) >> 8;
        int incl = np;
#pragma unroll
        for (int o = 1; o < 32; o <<= 1) { const int v = __shfl_up(incl, o); if ((tid & 63) >= o) incl += v; }
        const int excl = incl - np;
        if (tid < 32) { ut[UT_CNT + tid] = c; ut[UT_PST + tid] = excl * 256; ut[UT_UST + tid] = excl; }
        if (tid == 31) ut[UT_TOT] = incl;
    }
    __syncthreads();
    if (tid < MAXU) {
        const int NX = (G % 8 == 0) ? 8 : 1, CL = G / NX, x = vcu / CL, lc = vcu % CL, NP = ut[UT_TOT];
        const int p0 = x * NP / NX, p1 = (x + 1) * NP / NX, nloc = (p1 - p0) * NPN;
        const int l0 = tid * CL + lc, l = BACK ? nloc - 1 - l0 : l0;
        int e = -1, gp = 0;
        if (l0 < nloc) { gp = p0 + l / NPN; e = 0; for (int j = 1; j < 32; ++j) if (ut[UT_UST + j] <= gp) e = j; }
        ut[UT_UNIT + 4 * tid + 0] = e; ut[UT_UNIT + 4 * tid + 1] = e >= 0 ? gp - ut[UT_UST + e] : 0; ut[UT_UNIT + 4 * tid + 2] = e >= 0 ? l % NPN : 0; ut[UT_UNIT + 4 * tid + 3] = e >= 0 ? ut[UT_PST + e] : 0;
    }
    __syncthreads();
}
struct SchedGU {
    const LAS int* ut; unsigned char* ws; const float* b_gu;
    __device__ __forceinline__ bool next(int i, pg::GU& u) const {
        if (i >= MAXU) return false;
        const int e = __builtin_amdgcn_readfirstlane(ut[UT_UNIT + 4 * i]); if (e < 0) return false;
        const int panel = __builtin_amdgcn_readfirstlane(ut[UT_UNIT + 4 * i + 1]), pn = __builtin_amdgcn_readfirstlane(ut[UT_UNIT + 4 * i + 2]), pst = __builtin_amdgcn_readfirstlane(ut[UT_UNIT + 4 * i + 3]);
        u.A = (const char*)(ws + WS_HN); u.B = (const char*)(ws + WS_WGU) + ((size_t)e * 2048 + pn * 256) * 1024;
        u.O = (char*)(ws + WS_HACT) + ((size_t)(pst + panel * 256) * 1024 + pn * 128); u.bias = b_gu + (size_t)e * 2048 + pn * 128; u.ldc = 1024; u.scale = 1.0f / W8_SCALE; u.gslot = i; u.kind = 0; u.row0 = 0; u.col0 = 0;
        return true;
    }
};
struct SchedDN {
    const LAS int* ut; unsigned char* ws; const float* b_dn;
    __device__ __forceinline__ bool next(int i, pg::GU& u) const {
        if (i >= MAXU) return false;
        const int e = __builtin_amdgcn_readfirstlane(ut[UT_UNIT + 4 * i]); if (e < 0) return false;
        const int panel = __builtin_amdgcn_readfirstlane(ut[UT_UNIT + 4 * i + 1]), pn = __builtin_amdgcn_readfirstlane(ut[UT_UNIT + 4 * i + 2]), pst = __builtin_amdgcn_readfirstlane(ut[UT_UNIT + 4 * i + 3]);
        u.A = (const char*)(ws + WS_HACT) + (size_t)(pst + panel * 256) * 1024; u.B = (const char*)(ws + WS_WDN) + ((size_t)e * 1024 + pn * 256) * 1024;
        u.O = (char*)(ws + WS_Y) + ((size_t)(pst + panel * 256) * 1024 + pn * 256); u.bias = b_dn + (size_t)e * 1024 + pn * 256; u.ldc = 1024; u.scale = 1.0f / W8_SCALE; u.gslot = 0; u.kind = 0; u.row0 = 0; u.col0 = 0;
        return true;
    }
};

#define LDS_BARRIER() do { asm volatile("s_waitcnt lgkmcnt(0)" ::: "memory"); __builtin_amdgcn_s_barrier(); asm volatile("" ::: "memory"); } while (0)
typedef float f32x16 __attribute__((ext_vector_type(16)));
typedef short s16x4 __attribute__((ext_vector_type(4)));
#define MFMA32(a, b, c) __builtin_amdgcn_mfma_f32_32x32x16_bf16((a), (b), (c), 0, 0, 0)
__device__ __forceinline__ bf16x8 pack8(float a0, float a1, float a2, float a3, float a4, float a5, float a6, float a7) {
    u32x4 p; p.x = pg::cvt_pk_bf16(a0, a1); p.y = pg::cvt_pk_bf16(a2, a3); p.z = pg::cvt_pk_bf16(a4, a5); p.w = pg::cvt_pk_bf16(a6, a7);
    return __builtin_bit_cast(bf16x8, p);
}
__device__ __forceinline__ bf16x8 load_vt_frag(const bf16* rowp, int h) {
    const s16x4 lo = *(const s16x4*)(rowp + 4 * h), hi = *(const s16x4*)(rowp + 8 + 4 * h);
    return __builtin_shufflevector(lo, hi, 0, 1, 2, 3, 4, 5, 6, 7);
}
__device__ __forceinline__ void sb_unit(unsigned char* ws, LAS unsigned char* lds, int unit, int wave, int lane) {
    const int b = unit >> 5, t0 = (unit & 31) * 64, hd = wave, r = lane & 31, h = lane >> 5;
    const size_t tb = (size_t)b * S;
    const bf16* Q = (const bf16*)(ws + WS_Q); const bf16* Kp = (const bf16*)(ws + WS_K); const bf16* VT = (const bf16*)(ws + WS_VT);
    bf16x8 qf[2][4];
#pragma unroll
    for (int ni = 0; ni < 2; ++ni)
#pragma unroll
        for (int kk = 0; kk < 4; ++kk) qf[ni][kk] = __builtin_nontemporal_load((const bf16x8*)(Q + (((((tb + t0) >> 5) + ni) * 8 + hd) * 4 + kk) * 512 + lane * 8));
    f32x16 oacc[2][2];
#pragma unroll
    for (int di = 0; di < 2; ++di)
#pragma unroll
        for (int ni = 0; ni < 2; ++ni)
#pragma unroll
            for (int i = 0; i < 16; ++i) oacc[di][ni][i] = 0.f;
    float carry[2] = {1.0f, 1.0f};
    bf16x8 kfn[4];
#pragma unroll
    for (int kk = 0; kk < 4; ++kk) kfn[kk] = *(const bf16x8*)(Kp + ((((tb + t0 + 32) >> 5) * 8 + hd) * 4 + kk) * 512 + lane * 8);
    for (int s0 = t0 + 32; s0 >= 0; s0 -= 32) {
        bf16x8 kf[4], vf[2][2];
#pragma unroll
        for (int kk = 0; kk < 4; ++kk) kf[kk] = kfn[kk];
#pragma unroll
        for (int di = 0; di < 2; ++di)
#pragma unroll
            for (int ks = 0; ks < 2; ++ks) vf[di][ks] = *(const bf16x8*)(VT + (((((tb + s0) >> 4) + ks) * 8 + hd) * 2 + di) * 512 + lane * 8);
        if (s0 >= 32) {
#pragma unroll
            for (int kk = 0; kk < 4; ++kk) kfn[kk] = *(const bf16x8*)(Kp + ((((tb + s0 - 32) >> 5) * 8 + hd) * 4 + kk) * 512 + lane * 8); }
        const bool diag = (s0 + 31 >= t0);
        bf16x8 pf[2][2];
#pragma unroll
        for (int ni = 0; ni < 2; ++ni) {
            if (ni == 0 && s0 > t0) continue;
            f32x16 sa;
#pragma unroll
            for (int i = 0; i < 16; ++i) sa[i] = 0.f;
#pragma unroll
            for (int kk = 0; kk < 4; ++kk) sa = MFMA32(kf[kk], qf[ni][kk], sa);
            f32x16 zc = sa;
            if (diag) {
#pragma unroll
                for (int i = 0; i < 16; ++i) { const int key = s0 + (i & 3) + 8 * (i >> 2) + 4 * h, tq = t0 + 32 * ni + r; zc[i] = (key < tq) ? zc[i] : -1.0e30f; }
            }
            f32x16 E;
#pragma unroll
            for (int i = 0; i < 16; ++i) E[i] = __builtin_amdgcn_exp2f(__builtin_amdgcn_fmed3f(zc[i], -1.0e30f, 30.0f));
            const f32x16 dd = E + 1.0f;
            float P1[4], P2[4], P3[4], rg[4], Tg[4], Pg[4];
#pragma unroll
            for (int g = 0; g < 4; ++g) { P1[g] = dd[4 * g]; P2[g] = P1[g] * dd[4 * g + 1]; P3[g] = P2[g] * dd[4 * g + 2];
                rg[g] = __builtin_amdgcn_rcpf(P3[g] * dd[4 * g + 3]);
                Pg[g] = xhalf(rg[g]); Tg[g] = rg[g] * Pg[g]; }
            float suf[4]; suf[3] = 1.0f; suf[2] = Tg[3]; suf[1] = Tg[3] * Tg[2]; suf[0] = suf[1] * Tg[1];
            const float total = suf[0] * Tg[0];
            float av[16];
#pragma unroll
            for (int g = 0; g < 4; ++g) {
                const float br = carry[ni] * suf[g] * (h == 0 ? Pg[g] : 1.0f) * rg[g];
                av[4 * g] = E[4 * g] * br; av[4 * g + 1] = E[4 * g + 1] * (br * P1[g]); av[4 * g + 2] = E[4 * g + 2] * (br * P2[g]); av[4 * g + 3] = E[4 * g + 3] * (br * P3[g]);
            }
            carry[ni] *= total;
            pf[ni][0] = pack8(av[0], av[1], av[2], av[3], av[4], av[5], av[6], av[7]);
            pf[ni][1] = pack8(av[8], av[9], av[10], av[11], av[12], av[13], av[14], av[15]);
        }
#pragma unroll
        for (int di = 0; di < 2; ++di)
#pragma unroll
            for (int ni = 0; ni < 2; ++ni) {
                if (ni == 0 && s0 > t0) continue;
#pragma unroll
                for (int ks = 0; ks < 2; ++ks) oacc[di][ni] = MFMA32(vf[di][ks], pf[ni][ks], oacc[di][ni]); }
        if (__all((carry[0] < SB_EXIT_LIN) && (carry[1] < SB_EXIT_LIN))) break;
    }
    LAS float* ssq = (LAS float*)lds;
    float ss[2];
#pragma unroll
    for (int ni = 0; ni < 2; ++ni) { float v = 0.f;
#pragma unroll
        for (int di = 0; di < 2; ++di)
#pragma unroll
            for (int i = 0; i < 16; ++i) v += oacc[di][ni][i] * oacc[di][ni][i];
        v += xhalf(v); ss[ni] = v;
        if (h == 0) ssq[(32 * ni + r) * 8 + hd] = v; }
    LDS_BARRIER();
    bf16* cat = (bf16*)(ws + WS_CAT);
#pragma unroll
    for (int ni = 0; ni < 2; ++ni) {
        float tot = 0.f;
#pragma unroll
        for (int w = 0; w < 8; ++w) tot += ssq[(32 * ni + r) * 8 + w];
        const float rs = 1.0f / sqrtf(tot * (1.f / 512.f) + EPS);
        bf16* rowp = cat + (tb + t0 + 32 * ni + r) * 1024 + hd * 64 + 8 * h;
#pragma unroll
        for (int di = 0; di < 2; ++di)
#pragma unroll
            for (int gp = 0; gp < 2; ++gp) { const int g0 = 2 * gp, g1 = 2 * gp + 1;
                const v4i o = pg::pair16((int)pg::cvt_pk_bf16(oacc[di][ni][4 * g0] * rs, oacc[di][ni][4 * g0 + 1] * rs), (int)pg::cvt_pk_bf16(oacc[di][ni][4 * g0 + 2] * rs, oacc[di][ni][4 * g0 + 3] * rs),
                                          (int)pg::cvt_pk_bf16(oacc[di][ni][4 * g1] * rs, oacc[di][ni][4 * g1 + 1] * rs), (int)pg::cvt_pk_bf16(oacc[di][ni][4 * g1 + 2] * rs, oacc[di][ni][4 * g1 + 3] * rs));
                *(v4i*)(rowp + 32 * di + 16 * gp) = o; }
    }
    LDS_BARRIER();
}

__device__ __forceinline__ void mx_unit(unsigned char* ws, LAS unsigned char* lds, int unit, int wave, int lane) {
    const int b = unit >> 5, t0 = (unit & 31) * 64, hd = wave & 3, qh = wave >> 2, r = lane & 31, h = lane >> 5;
    const size_t tb = (size_t)b * S;
    const bf16* QM = (const bf16*)(ws + WS_QMX); const bf16* MK = (const bf16*)(ws + WS_MEMK); const bf16* MVT = (const bf16*)(ws + WS_MEMVT);
    bf16x8 qf[4];
#pragma unroll
    for (int kk = 0; kk < 4; ++kk) qf[kk] = __builtin_nontemporal_load((const bf16x8*)(QM + (((((tb + t0) >> 5) + qh) * 4 + hd) * 4 + kk) * 512 + lane * 8));
    bf16x8 kf[8][4];
#pragma unroll
    for (int mi = 0; mi < 8; ++mi)
#pragma unroll
        for (int kk = 0; kk < 4; ++kk) kf[mi][kk] = *(const bf16x8*)(MK + (size_t)(((b * 8 + mi) * 4 + hd) * 4 + kk) * 512 + lane * 8);
    f32x16 sa[8];
#pragma unroll
    for (int mi = 0; mi < 8; ++mi) {
#pragma unroll
        for (int i = 0; i < 16; ++i) sa[mi][i] = 0.f;
#pragma unroll
        for (int kk = 0; kk < 4; ++kk) sa[mi] = MFMA32(kf[mi][kk], qf[kk], sa[mi]);
    }
    bf16x8 vfa[4][2][2];
#pragma unroll
    for (int mi = 0; mi < 4; ++mi)
#pragma unroll
        for (int s2 = 0; s2 < 2; ++s2)
#pragma unroll
            for (int di = 0; di < 2; ++di) vfa[mi][s2][di] = *(const bf16x8*)(MVT + (size_t)(((b * 16 + 2 * mi + s2) * 4 + hd) * 2 + di) * 512 + lane * 8);
    float mx = -3.0e38f;
#pragma unroll
    for (int mi = 0; mi < 8; ++mi)
#pragma unroll
        for (int i = 0; i < 16; ++i) mx = fmaxf(mx, sa[mi][i]);
    mx = fmaxf(mx, xhalf(mx));
    float sum = 0.f;
    bf16x8 pf[8][2];
#pragma unroll
    for (int mi = 0; mi < 8; ++mi) {
#pragma unroll
        for (int i = 0; i < 16; ++i) { const float pv = __builtin_amdgcn_exp2f(sa[mi][i] - mx); sa[mi][i] = pv; sum += pv; }
#pragma unroll
        for (int s2 = 0; s2 < 2; ++s2) pf[mi][s2] = pack8(sa[mi][8 * s2], sa[mi][8 * s2 + 1], sa[mi][8 * s2 + 2], sa[mi][8 * s2 + 3], sa[mi][8 * s2 + 4], sa[mi][8 * s2 + 5], sa[mi][8 * s2 + 6], sa[mi][8 * s2 + 7]);
    }
    sum += xhalf(sum);
    bf16x8 vfb[4][2][2];
#pragma unroll
    for (int mi = 0; mi < 4; ++mi)
#pragma unroll
        for (int s2 = 0; s2 < 2; ++s2)
#pragma unroll
            for (int di = 0; di < 2; ++di) vfb[mi][s2][di] = *(const bf16x8*)(MVT + (size_t)(((b * 16 + 2 * (mi + 4) + s2) * 4 + hd) * 2 + di) * 512 + lane * 8);
    f32x16 oacc[2];
#pragma unroll
    for (int di = 0; di < 2; ++di)
#pragma unroll
        for (int i = 0; i < 16; ++i) oacc[di][i] = 0.f;
#pragma unroll
    for (int mi = 0; mi < 4; ++mi)
#pragma unroll
        for (int s2 = 0; s2 < 2; ++s2)
#pragma unroll
            for (int di = 0; di < 2; ++di) oacc[di] = MFMA32(vfa[mi][s2][di], pf[mi][s2], oacc[di]);
#pragma unroll
    for (int mi = 0; mi < 4; ++mi)
#pragma unroll
        for (int s2 = 0; s2 < 2; ++s2)
#pragma unroll
            for (int di = 0; di < 2; ++di) oacc[di] = MFMA32(vfb[mi][s2][di], pf[mi + 4][s2], oacc[di]);
    const float inv = 1.0f / sum;
    LAS float* ssq = (LAS float*)lds;
    float v = 0.f;
#pragma unroll
    for (int di = 0; di < 2; ++di)
#pragma unroll
        for (int i = 0; i < 16; ++i) { oacc[di][i] *= inv; v += oacc[di][i] * oacc[di][i]; }
    v += xhalf(v);
    if (h == 0) ssq[(32 * qh + r) * 4 + hd] = v;
    LDS_BARRIER();
    const float tot = (ssq[(32 * qh + r) * 4 + 0] + ssq[(32 * qh + r) * 4 + 1]) + (ssq[(32 * qh + r) * 4 + 2] + ssq[(32 * qh + r) * 4 + 3]);
    const float rs = 1.0f / sqrtf(tot * (1.f / 256.f) + EPS);
    bf16* rowp = (bf16*)(ws + WS_CAT) + (tb + t0 + 32 * qh + r) * 1024 + 768 + hd * 64 + 8 * h;
#pragma unroll
    for (int di = 0; di < 2; ++di)
#pragma unroll
        for (int gp = 0; gp < 2; ++gp) { const int g0 = 2 * gp, g1 = 2 * gp + 1;
            const v4i o = pg::pair16((int)pg::cvt_pk_bf16(oacc[di][4 * g0] * rs, oacc[di][4 * g0 + 1] * rs), (int)pg::cvt_pk_bf16(oacc[di][4 * g0 + 2] * rs, oacc[di][4 * g0 + 3] * rs),
                                      (int)pg::cvt_pk_bf16(oacc[di][4 * g1] * rs, oacc[di][4 * g1 + 1] * rs), (int)pg::cvt_pk_bf16(oacc[di][4 * g1 + 2] * rs, oacc[di][4 * g1 + 3] * rs));
            *(v4i*)(rowp + 32 * di + 16 * gp) = o; }
    LDS_BARRIER();
}

constexpr int CV_U_OFF = 0, CV_ACT_OFF = 96256, CV_ACT_PITCH = 528, CV_SSQ_OFF = 65536;
static_assert(CV_ACT_OFF + 64 * CV_ACT_PITCH <= RING_BYTES, "conv LDS");
__device__ __forceinline__ void cv_unit(const Ptrs& p, LAS unsigned char* lds, int unit, int tid, int wave, int lane) {
    unsigned char* ws = p.ws;
    const int b = unit >> 5, t0 = (unit & 31) * 64;
    const size_t tb = (size_t)b * S;
    LAS float* U = (LAS float*)(lds + CV_U_OFF);
    const bf16* GLU = (const bf16*)(ws + WS_GLU);
    const int c = tid & 255, th = tid >> 8;
    typedef float f2 __attribute__((ext_vector_type(2)));
    f2 wp[CONVK + 1];
    { float wprev = 0.f;
#pragma unroll
      for (int j = 0; j < CONVK; ++j) { const float wj = p.in[5][j * CVW + c]; wp[j] = (f2){wj, wprev}; wprev = wj; }
      wp[CONVK] = (f2){0.f, wprev}; }
    const float bd = p.in[6][c];
    {
        v4u av[6];
#pragma unroll
        for (int i = 0; i < 6; ++i) { const int it = tid + i * NWAVES * 64, row = it >> 5, ch = (it & 31) * 8, tl = t0 - (CONVK - 1) + row;
            if (it < 94 * 32 && tl >= 0) av[i] = __builtin_nontemporal_load((const v4u*)(GLU + (tb + tl) * 256 + ch));
            else av[i] = (v4u){0u, 0u, 0u, 0u}; }
#pragma unroll
        for (int i = 0; i < 6; ++i) { const int it = tid + i * NWAVES * 64, row = it >> 5, ch = (it & 31) * 8;
            if (it < 94 * 32) {
                *(LAS f32x4*)(U + row * 256 + ch) = (f32x4){bf2f(av[i][0] & 0xffffu), bf2f(av[i][0] >> 16), bf2f(av[i][1] & 0xffffu), bf2f(av[i][1] >> 16)};
                *(LAS f32x4*)(U + row * 256 + ch + 4) = (f32x4){bf2f(av[i][2] & 0xffffu), bf2f(av[i][2] >> 16), bf2f(av[i][3] & 0xffffu), bf2f(av[i][3] >> 16)}; } }
    }
    LDS_BARRIER();
    {
        f2 acc2[16];
#pragma unroll
        for (int m = 0; m < 16; ++m) acc2[m] = (f2){bd, bd};
#pragma unroll
        for (int ii = 0; ii < 62; ++ii) { const float uv = U[(32 * th + ii) * 256 + c]; const f2 uv2 = (f2){uv, uv};
#pragma unroll
            for (int m = 0; m < 16; ++m) { const int j = ii - 2 * m; if (j >= 0 && j <= CONVK) acc2[m] = __builtin_elementwise_fma(wp[j], uv2, acc2[m]); } }
        float acc[32];
#pragma unroll
        for (int m = 0; m < 16; ++m) { acc[2 * m] = acc2[m].x; acc[2 * m + 1] = acc2[m].y; }
        LDS_BARRIER();
#pragma unroll
        for (int tt = 0; tt < 32; ++tt) U[(32 * th + tt) * 256 + c] = acc[tt];
    }
    LDS_BARRIER();
    bf16x8 af[16];
#pragma unroll
    for (int kk = 0; kk < 16; ++kk) af[kk] = *(const bf16x8*)((const bf16*)(ws + WS_WPW2) + (size_t)(32 * wave + (lane & 31)) * 256 + 16 * kk + 8 * (lane >> 5));
    {
        const f32x4 gl = *(const f32x4*)(p.in[7] + 4 * lane), bl = *(const f32x4*)(p.in[8] + 4 * lane);
#pragma unroll
        for (int k = 0; k < 8; ++k) { const int tok = 8 * wave + k;
            const f32x4 x = *(const LAS f32x4*)(U + tok * 256 + 4 * lane);
            const float mu = wave_sum((x.x + x.y) + (x.z + x.w)) * (1.f / 256.f);
            const f32x4 d = x - mu;
            const float rstd = 1.0f / sqrtf(wave_sum((d.x * d.x + d.y * d.y) + (d.z * d.z + d.w * d.w)) * (1.f / 256.f) + EPS);
            f32x4 y = d * rstd * gl + bl;
            y.x = y.x * __builtin_amdgcn_rcpf(1.0f + __builtin_amdgcn_exp2f(-1.44269504f * y.x)); y.y = y.y * __builtin_amdgcn_rcpf(1.0f + __builtin_amdgcn_exp2f(-1.44269504f * y.y)); y.z = y.z * __builtin_amdgcn_rcpf(1.0f + __builtin_amdgcn_exp2f(-1.44269504f * y.z)); y.w = y.w * __builtin_amdgcn_rcpf(1.0f + __builtin_amdgcn_exp2f(-1.44269504f * y.w));
            *(LAS unsigned long long*)(lds + CV_ACT_OFF + tok * CV_ACT_PITCH + 8 * lane) = (unsigned long long)pg::cvt_pk_bf16(y.x, y.y) | ((unsigned long long)pg::cvt_pk_bf16(y.z, y.w) << 32);
        }
    }
    LDS_BARRIER();
    {
        const int r = lane & 31, h = lane >> 5;
        f32x16 acc[2];
#pragma unroll
        for (int ti = 0; ti < 2; ++ti)
#pragma unroll
            for (int i = 0; i < 16; ++i) acc[ti][i] = 0.f;
#pragma unroll
        for (int kk = 0; kk < 16; ++kk) {
#pragma unroll
            for (int ti = 0; ti < 2; ++ti) { const bf16x8 bfr = *(const LAS bf16x8*)(lds + CV_ACT_OFF + (32 * ti + r) * CV_ACT_PITCH + (16 * kk + 8 * h) * 2); acc[ti] = MFMA32(af[kk], bfr, acc[ti]); }
        }
        LAS float* ssq = (LAS float*)(lds + CV_SSQ_OFF);
#pragma unroll
        for (int g = 0; g < 4; ++g) { const f32x4 bb = *(const f32x4*)(p.in[10] + 32 * wave + 8 * g + 4 * h);
#pragma unroll
            for (int ti = 0; ti < 2; ++ti) { acc[ti][4 * g] += bb.x; acc[ti][4 * g + 1] += bb.y; acc[ti][4 * g + 2] += bb.z; acc[ti][4 * g + 3] += bb.w; } }
#pragma unroll
        for (int ti = 0; ti < 2; ++ti) { float v = 0.f;
#pragma unroll
            for (int i = 0; i < 16; ++i) v += acc[ti][i] * acc[ti][i];
            v += xhalf(v);
            if (h == 0) ssq[(32 * ti + r) * 8 + wave] = v; }
        LDS_BARRIER();
#pragma unroll
        for (int ti = 0; ti < 2; ++ti) { float tot = 0.f;
#pragma unroll
            for (int w2 = 0; w2 < 8; ++w2) tot += ssq[(32 * ti + r) * 8 + w2];
            const float rs = 1.0f / sqrtf(tot * (1.f / 256.f) + EPS);
            bf16* rowp = (bf16*)(ws + WS_CAT) + (tb + t0 + 32 * ti + r) * 1024 + 512 + 32 * wave + 8 * h;
#pragma unroll
            for (int gp = 0; gp < 2; ++gp) { const int g0 = 2 * gp, g1 = 2 * gp + 1;
                const v4i o = pg::pair16((int)pg::cvt_pk_bf16(acc[ti][4 * g0] * rs, acc[ti][4 * g0 + 1] * rs), (int)pg::cvt_pk_bf16(acc[ti][4 * g0 + 2] * rs, acc[ti][4 * g0 + 3] * rs),
                                          (int)pg::cvt_pk_bf16(acc[ti][4 * g1] * rs, acc[ti][4 * g1 + 1] * rs), (int)pg::cvt_pk_bf16(acc[ti][4 * g1 + 2] * rs, acc[ti][4 * g1 + 3] * rs));
                *(v4i*)(rowp + 16 * gp) = o; } }
    }
    LDS_BARRIER();
}

__global__ void __launch_bounds__(NWAVES * 64, 2) mk_fwd(MKArgs a) {
    extern __shared__ __attribute__((aligned(16))) unsigned char lds_raw[];
    LAS unsigned char* lds = (LAS unsigned char*)lds_raw;
    const int tid = threadIdx.x, lane = tid & 63, wave = __builtin_amdgcn_readfirstlane(tid >> 6);
    const int G = gridDim.x; const int bx = blockIdx.x; const int vcu = (G % 8 == 0) ? (bx % 8) * (G / 8) + bx / 8 : bx;
    unsigned char* ws = a.p.ws;
    const int lo = a.ph_lo, hi = a.ph_hi;
#define IN(k) (lo <= (k) && (k) < hi)
#define BOTH(k) (IN(k) && IN((k) + 1))
    const int sh_thr = SchedP1::NU % G;
    const int SH_N1 = SH_WAVES * (sh_thr * SH_Q1 + (G - sh_thr) * SH_Q1H);
    const int SH_E4 = sh_base(4, G, SH_N1) < SH_I_GU ? sh_base(4, G, SH_N1) : SH_I_GU;
    const int SH_B4 = sh_base(4, G, SH_N1) > SH_I_GU ? sh_base(4, G, SH_N1) : SH_I_GU;
    const int SH_ALL = SH_B4 + sh_quota(4) * SH_WAVES * G;
    float* const shscr = (float*)(lds_raw + RING_OFF + wave * 17408);
#define SEAM(k) do { int _n = sh_quota(k), _idx = ((k) == 4 ? SH_B4 : sh_base(k, G, SH_N1)) + (vcu * SH_WAVES + wave - 1) * sh_quota(k); \
        if ((k) == 1) { _n = vcu < sh_thr ? SH_Q1 : SH_Q1H; _idx = sh_base(1, G, SH_N1) + (vcu < sh_thr ? vcu * SH_WAVES * SH_Q1 : sh_thr * SH_WAVES * SH_Q1 + (vcu - sh_thr) * SH_WAVES * SH_Q1H) + (wave - 1) * _n; } \
        if (BOTH(k)) xcd_barrier_sh(bar, a.p, _idx, _n, wave, shscr, lane); else { __syncthreads(); if (wave > 0) shadow_items(a.p, _idx, _n, shscr, lane); } } while (0)
    volatile LAS unsigned* misc = (volatile LAS unsigned*)(lds + MISC_OFF);
    if (tid < 4) misc[tid] = 0u;
    __syncthreads();
    XcdBarrier bar; bar.bar = (unsigned*)(ws + WS_CTL) + CW_BAR + a.li * 4096; bar.x = 0; bar.st = misc;
    if (hi - lo > 1) bar = xcd_barrier_post((unsigned*)(ws + WS_CTL) + CW_BAR + a.li * 4096, misc);
    if (IN(0)) { for (int rep = 0; rep < NREP(0); ++rep) {
        float* scr = (float*)(lds_raw + RING_OFF + wave * 17408);
        const int gw = vcu * NWAVES + wave, NGW = G * NWAVES;
        const Ptrs& p = a.p;
        constexpr int I_IN = 16 * 72, I_OUT = 16 * 32, I_MKV = 16 * 16, I_PW2 = 4 * 8, I_GU = 32 * 8 * 64, I_DN = 32 * 8 * 32;
        const int R_G = I_GU - SH_E4, R_EX = SH_LIN_END > SH_ALL ? SH_LIN_END - SH_ALL : 0;
        const int NIT = I_IN + I_OUT + I_MKV + I_PW2 + R_G + R_EX;
        for (int it = gw; it < NIT; it += NGW) {
            int r = it;
            if (r < I_IN) { const int kb = r / 72, nb = r % 72; const int n0 = 32 * nb; int drow = n0;
                if (n0 >= 1536 && n0 < 2048) { const int cch = (n0 - 1536) & 255; drow = 1536 + 256 * (cch >> 7) + ((n0 >= 1792) ? 128 : 0) + (cch & 127); }
                transpose_item(p.in[3], 1024, INW, (bf16*)(ws + WS_WIN), 64 * kb, n0, drow, nullptr, scr, lane); continue; } r -= I_IN;
            if (r < I_OUT) { const int kb = r / 32, nb = r % 32; const int k0 = 64 * kb;
                const float* ks = k0 < 512 ? p.in[13] : (k0 < 768 ? p.in[14] - 512 : p.in[15] - 768);
                transpose_item(p.in[16], 1024, 1024, (bf16*)(ws + WS_WOUT), k0, 32 * nb, 32 * nb, ks, scr, lane); continue; } r -= I_OUT;
            if (r < I_MKV) { const int kb = r / 16, nb = r % 16; transpose_item(p.in[12], 1024, 512, (bf16*)(ws + WS_WMKV), 64 * kb, 32 * nb, 32 * nb, nullptr, scr, lane); continue; } r -= I_MKV;
            if (r < I_PW2) { const int kb = r / 8, nb = r % 8; transpose_item(p.in[9], 256, 256, (bf16*)(ws + WS_WPW2), 64 * kb, 32 * nb, 32 * nb, nullptr, scr, lane); continue; } r -= I_PW2;
            if (r < R_G) { conv_gu_item(p, r + SH_E4, scr, lane); continue; } r -= R_G;
            conv_lin_item(p, r + SH_ALL, scr, lane);
        }
        { f32x4 gg[4];
#pragma unroll
          for (int j = 0; j < 4; ++j) gg[j] = ((const f32x4*)p.in[2])[lane + 64 * j];
          for (int m = gw; m < T; m += NGW) rms_row_to_bf16(p.in[0] + (size_t)m * D, gg, (bf16*)(ws + WS_XN) + (size_t)m * D, lane, (float*)(ws + WS_RSX) + m);
#pragma unroll
          for (int j = 0; j < 4; ++j) gg[j] = ((const f32x4*)p.in[11])[lane + 64 * j];
          for (int m = gw; m < TM; m += NGW) rms_row_to_bf16(p.in[1] + (size_t)m * D, gg, (bf16*)(ws + WS_MEMN) + (size_t)m * D, lane); }
        __syncthreads(); }
        SEAM(0);
    }
    if (IN(1)) {
        SchedP1 Sc{G, vcu, ws, a.p.in[4]}; pg::EpiP1 E;
        for (int rep = 0; rep < NREP(1); ++rep) pg::gemm_phase<pg::EpiP1, SchedP1, false, false>(lds + RING_OFF, Sc, E, nullptr);
        SEAM(1);
    }
    if (IN(2)) {
        constexpr int NU2 = NB * (S / 64);
        if (vcu & 1) {
            for (int u = vcu; u < NU2 * NREP(22); u += G) cv_unit(a.p, lds + RING_OFF, u & (NU2 - 1), tid, wave, lane);
            for (int u = vcu; u < NU2 * NREP(21); u += G) mx_unit(ws, lds + RING_OFF, u & (NU2 - 1), wave, lane);
            for (int u = vcu; u < NU2 * NREP(20); u += G) sb_unit(ws, lds + RING_OFF, u & (NU2 - 1), wave, lane);
        } else {
            for (int u = vcu; u < NU2 * NREP(20); u += G) sb_unit(ws, lds + RING_OFF, u & (NU2 - 1), wave, lane);
            for (int u = vcu; u < NU2 * NREP(21); u += G) mx_unit(ws, lds + RING_OFF, u & (NU2 - 1), wave, lane);
            for (int u = vcu; u < NU2 * NREP(22); u += G) cv_unit(a.p, lds + RING_OFF, u & (NU2 - 1), tid, wave, lane);
        }
        SEAM(2);
    }
    if (IN(3)) {
        SchedP3 Sc{G, vcu, ws}; pg::EpiRes E; E.xn = (const bf16*)(ws + WS_XN); E.rsx = (const float*)(ws + WS_RSX); E.g1 = a.p.in[2];
        for (int rep = 0; rep < NREP(3); ++rep) pg::gemm_phase<pg::EpiRes, SchedP3, false, false>(lds + RING_OFF, Sc, E, nullptr);
        SEAM(3);
    }
    if (IN(4)) {
#if REP_PHASE == 4
      for (int rep4 = 0; rep4 < 2; ++rep4) {
        if (rep4 == 1) { xcd_barrier(bar); if (blockIdx.x == 0 && tid < 32) __hip_atomic_store((unsigned*)(ws + WS_CTL) + CW_CNT + tid, 0u, __ATOMIC_RELAXED, __HIP_MEMORY_SCOPE_AGENT); xcd_barrier(bar); }
#else
      {
#endif
        const Ptrs& p = a.p;
        constexpr int HQP = 1028;
        LAS float* hq = (LAS float*)(lds + RING_OFF);
        LAS float* part = (LAS float*)(lds + RING_OFF + 16 * HQP * 4);
        LAS int* lcnt = (LAS int*)(lds + RING_OFF + 16 * HQP * 4 + 32768);
        LAS int* pend = (LAS int*)(lds + RING_OFF + 16 * HQP * 4 + 32768 + 256);
        const int e = lane & 31, hf = lane >> 5;
        float wreg[2][32];
#pragma unroll
        for (int nb = 0; nb < 2; ++nb)
#pragma unroll
            for (int q = 0; q < 32; ++q) wreg[nb][q] = p.in[18][(size_t)(128 * wave + 4 * q + (lane >> 4)) * NE + 16 * nb + (lane & 15)];
        const float bre = p.in[19][e];
        f32x4 gg4[4];
#pragma unroll
        for (int j = 0; j < 4; ++j) gg4[j] = ((const f32x4*)p.in[17])[lane + 64 * j];
        for (int blk = vcu; blk < T / 128; blk += G) {
        if (tid < 64) lcnt[tid] = 0;
        const int tokbase = blk * 128;
        unsigned long long mr[2][4];
        f32x4 yq[2][4];
        auto load_rows = [&](int bt) {
#pragma unroll
            for (int j2 = 0; j2 < 2; ++j2)
#pragma unroll
                for (int j = 0; j < 4; ++j) { const int tk = tokbase + 16 * bt + 2 * wave + j2; mr[j2][j] = __builtin_nontemporal_load((const unsigned long long*)((const bf16*)(ws + WS_HB) + (size_t)tk * D) + lane + 64 * j); } };
        auto a_math = [&](int bt) {
#pragma unroll
            for (int j2 = 0; j2 < 2; ++j2) {
                const int tl = 2 * wave + j2, tok = tokbase + 16 * bt + tl;
                f32x4 v[4];
#pragma unroll
                for (int j = 0; j < 4; ++j) { const unsigned lo = (unsigned)mr[j2][j], hi = (unsigned)(mr[j2][j] >> 32); v[j] = (f32x4){bf2f(lo & 0xffffu), bf2f(lo >> 16), bf2f(hi & 0xffffu), bf2f(hi >> 16)}; }
                float s2 = 0.f;
#pragma unroll
                for (int j = 0; j < 4; ++j) s2 += (v[j].x * v[j].x + v[j].y * v[j].y) + (v[j].z * v[j].z + v[j].w * v[j].w);
                const float rs = 1.0f / sqrtf(wave_sum(s2) * (1.f / D) + EPS);
                int* o4 = (int*)((unsigned char*)(ws + WS_HN) + (size_t)tok * D) + lane;
#pragma unroll
                for (int j = 0; j < 4; ++j) { const f32x4 gg = gg4[j]; f32x4 y; y.x = v[j].x * rs * gg.x; y.y = v[j].y * rs * gg.y; y.z = v[j].z * rs * gg.z; y.w = v[j].w * rs * gg.w;
                    { int w8 = 0; w8 = __builtin_amdgcn_cvt_pk_fp8_f32(y.x, y.y, w8, false); w8 = __builtin_amdgcn_cvt_pk_fp8_f32(y.z, y.w, w8, true); o4[64 * j] = w8; }
                    yq[j2][j] = y; }
            } };
        auto hq_write = [&]() {
#pragma unroll
            for (int j2 = 0; j2 < 2; ++j2)
#pragma unroll
                for (int j = 0; j < 4; ++j) *(LAS f32x4*)(hq + (2 * wave + j2) * HQP + 4 * lane + 256 * j) = yq[j2][j]; };
        auto c_stage = [&](int bt) {
            const LAS float* pb = part + (bt & 1) * 4096;
            const int tl = 2 * wave + hf;
            float lg = bre;
#pragma unroll
            for (int w2 = 0; w2 < 8; ++w2) lg += pb[(w2 * 16 + tl) * 32 + e];
            int my_e = 0; float my_v = 0.f, m0 = 0.f;
#pragma unroll
            for (int k = 0; k < 4; ++k) {
                const float m = half_max(lg);
                const unsigned long long bal = __ballot(lg == m);
                const unsigned msk = hf ? (unsigned)(bal >> 32) : (unsigned)bal;
                const int idx = (int)(__ffs((int)msk) - 1) & 31;
                if (e == k) { my_e = idx; my_v = m; }
                if (k == 0) m0 = m;
                if (e == idx) lg = -3.0e38f;
            }
            const float exv = (e < 4) ? __expf(my_v - m0) : 0.f;
            float es = exv + __int_as_float(__builtin_amdgcn_mov_dpp(__float_as_int(exv), 0xB1, 0xf, 0xf, true));
            es += __int_as_float(__builtin_amdgcn_mov_dpp(__float_as_int(es), 0x4E, 0xf, 0xf, true));
            if (e < 4) {
                const int rank = __hip_atomic_fetch_add(lcnt + my_e, 1, __ATOMIC_RELAXED, __HIP_MEMORY_SCOPE_WORKGROUP);
                LAS int* pe = pend + ((16 * bt + tl) * 4 + e) * 3;
                pe[0] = my_e; pe[1] = rank; pe[2] = __float_as_int(exv / es);
            } };
        load_rows(0); a_math(0); load_rows(1); hq_write();
        LDS_BARRIER();
        for (int bt = 0; bt < 8; ++bt) {
            f32x4 d0 = (f32x4){0.f, 0.f, 0.f, 0.f}, d1 = d0;
            { const LAS float* ap = hq + (lane & 15) * HQP + 128 * wave + (lane >> 4);
#pragma unroll
              for (int q = 0; q < 32; ++q) { const float av = ap[4 * q];
                  d0 = __builtin_amdgcn_mfma_f32_16x16x4f32(av, wreg[0][q], d0, 0, 0, 0);
                  d1 = __builtin_amdgcn_mfma_f32_16x16x4f32(av, wreg[1][q], d1, 0, 0, 0); } }
            if (bt > 0) c_stage(bt - 1);
            if (bt < 7) { a_math(bt + 1); if (bt < 6) load_rows(bt + 2); }
            { LAS float* pb = part + (bt & 1) * 4096;
#pragma unroll
              for (int i = 0; i < 4; ++i) { pb[(wave * 16 + 4 * (lane >> 4) + i) * 32 + (lane & 15)] = d0[i]; pb[(wave * 16 + 4 * (lane >> 4) + i) * 32 + 16 + (lane & 15)] = d1[i]; } }
            LDS_BARRIER();
            if (bt < 7) hq_write();
            LDS_BARRIER();
        }
        c_stage(7);
        LDS_BARRIER();
        if (tid < 32) { const int n = lcnt[tid]; lcnt[32 + tid] = n > 0 ? (int)atomicAdd((unsigned*)(ws + WS_CTL) + CW_CNT + tid, (unsigned)n) : 0; }
        LDS_BARRIER();
        { const int tl = tid >> 2, k = tid & 3, tok = tokbase + tl;
            const LAS int* pe = pend + tid * 3; const int ee = pe[0], slot = lcnt[32 + ee] + pe[1];
            ((int*)(ws + WS_LIST))[(size_t)ee * T + slot] = tok;
            ((int*)(ws + WS_TOKE))[tok * 4 + k] = ee;
            ((int*)(ws + WS_TOKS))[tok * 4 + k] = slot;
            ((float*)(ws + WS_TOKG))[tok * 4 + k] = __int_as_float(pe[2]); }
        LDS_BARRIER();
        }
      }
        SEAM(4);
    }
    if (IN(5)) {
        LAS int* ut = (LAS int*)(lds + UTAB_OFF); LAS unsigned* gt = (LAS unsigned*)(lds + GTAB_OFF);
        moe_tables<8>(ut, (const unsigned*)(ws + WS_CTL) + CW_CNT, G, vcu, tid);
        for (int i = 0; i < MAXU; ++i) {
            const int e = ut[UT_UNIT + 4 * i]; if (e < 0) break;
            if (tid < 256) { const int row = ut[UT_UNIT + 4 * i + 1] * 256 + tid, c = ut[UT_CNT + e]; const int src = row < c ? row : c - 1;
                gt[i * 256 + tid] = (unsigned)((const int*)(ws + WS_LIST))[(size_t)e * T + src] * 1024u; }
        }
        __syncthreads();
        SchedGU Sc{ut, ws, a.p.in[21]}; pg::EpiSwiGLU E;
        for (int rep = 0; rep < NREP(5); ++rep) pg::gemm_phase<pg::EpiSwiGLU, SchedGU, true, true>(lds + RING_OFF, Sc, E, gt);
        {
            const int NX = (G % 8 == 0) ? 8 : 1, CL = G / NX, xq = vcu / CL, lc = vcu % CL, NP = ut[UT_TOT];
            int before = 0, total = 0, myrem = 0;
            for (int x2 = 0; x2 < NX; ++x2) { const int nl = ((x2 + 1) * NP / NX - x2 * NP / NX) * 8, rm = nl % CL, ns = rm ? CL - rm : 0; if (x2 < xq) before += ns; if (x2 == xq) myrem = rm; total += ns; }
            const int cov = total * 2 * NWAVES < SH_T5 ? total * 2 * NWAVES : SH_T5;
            if (myrem && lc >= myrem) { const int j0 = ((before + lc - myrem) * NWAVES + wave) * 2;
                for (int i = 0; i < 2; ++i) if (j0 + i < cov) conv_lin_item(a.p, SH_LIN_END + j0 + i, shscr, lane, SH_I_GU + SH_I_DN); }
            for (int j = cov + vcu * NWAVES + wave; j < SH_T5; j += G * NWAVES) conv_lin_item(a.p, SH_LIN_END + j, shscr, lane, SH_I_GU + SH_I_DN);
        }
        if (BOTH(5)) xcd_barrier(bar);
    }
    if (IN(6)) {
        LAS int* ut = (LAS int*)(lds + UTAB_OFF);
        moe_tables<4, true>(ut, (const unsigned*)(ws + WS_CTL) + CW_CNT, G, vcu, tid);
        SchedDN Sc{ut, ws, a.p.in[23]}; pg::EpiFp8 E;
        for (int rep = 0; rep < NREP(6); ++rep) { E.nostore = false; E.rbase = (rep < NREP(6) - 1) ? ws + 840 * MiB + (size_t)blockIdx.x * 262144 : nullptr; pg::gemm_phase<pg::EpiFp8, SchedDN, false, true>(lds + RING_OFF, Sc, E, nullptr); }
        if (BOTH(6)) xcd_barrier(bar);
    }
    if (IN(7)) {
        const Ptrs& p = a.p;
        LAS int* ut = (LAS int*)(lds + UTAB_OFF);
        moe_tables<4>(ut, (const unsigned*)(ws + WS_CTL) + CW_CNT, G, vcu, tid);
        const int gw = vcu * NWAVES + wave, NGW = G * NWAVES;
        f32x4 gg4[4];
#pragma unroll
        for (int j = 0; j < 4; ++j) gg4[j] = ((const f32x4*)p.in[24])[lane + 64 * j];
        for (int rep7 = 0; rep7 < NREP(7); ++rep7)
        for (int tok0 = gw * 2; tok0 < T; tok0 += NGW * 2) {
            float* const dst = p.out;
            f32x4 v[2][4]; unsigned yv[2][4][4]; float gts[2][4];
#pragma unroll
            for (int j2 = 0; j2 < 2; ++j2) {
                const int tok = tok0 + j2;
#pragma unroll
                for (int j = 0; j < 4; ++j) { const unsigned long long m = __builtin_nontemporal_load((const unsigned long long*)((const bf16*)(ws + WS_HB) + (size_t)tok * D) + lane + 64 * j); const unsigned lo_ = (unsigned)m, hi_ = (unsigned)(m >> 32);
                    v[j2][j] = (f32x4){bf2f(lo_ & 0xffffu), bf2f(lo_ >> 16), bf2f(hi_ & 0xffffu), bf2f(hi_ >> 16)}; }
                const int4 ev = *(const int4*)((const int*)(ws + WS_TOKE) + tok * 4), sv = *(const int4*)((const int*)(ws + WS_TOKS) + tok * 4); const f32x4 gv = *(const f32x4*)((const float*)(ws + WS_TOKG) + tok * 4);
                const int es[4] = {ev.x, ev.y, ev.z, ev.w}, ss[4] = {sv.x, sv.y, sv.z, sv.w};
                gts[j2][0] = gv.x; gts[j2][1] = gv.y; gts[j2][2] = gv.z; gts[j2][3] = gv.w;
#pragma unroll
                for (int k = 0; k < 4; ++k) {
                    const unsigned* y4 = (const unsigned*)((const unsigned char*)(ws + WS_Y) + (size_t)(ut[UT_PST + es[k]] + ss[k]) * 1024) + lane;
#pragma unroll
                    for (int j = 0; j < 4; ++j) yv[j2][k][j] = __builtin_nontemporal_load(y4 + 64 * j);
                }
            }
#pragma unroll
            for (int j2 = 0; j2 < 2; ++j2) {
                const int tok = tok0 + j2;
#pragma unroll
                for (int k = 0; k < 4; ++k) { const float gt = gts[j2][k];
#pragma unroll
                    for (int j = 0; j < 4; ++j) { const int w = (int)yv[j2][k][j];
                        v[j2][j].x += gt * __builtin_amdgcn_cvt_f32_fp8(w, 0); v[j2][j].y += gt * __builtin_amdgcn_cvt_f32_fp8(w, 1); v[j2][j].z += gt * __builtin_amdgcn_cvt_f32_fp8(w, 2); v[j2][j].w += gt * __builtin_amdgcn_cvt_f32_fp8(w, 3); } }
                float s2 = 0.f;
#pragma unroll
                for (int j = 0; j < 4; ++j) s2 += (v[j2][j].x * v[j2][j].x + v[j2][j].y * v[j2][j].y) + (v[j2][j].z * v[j2][j].z + v[j2][j].w * v[j2][j].w);
                const float rs = 1.0f / sqrtf(wave_sum(s2) * (1.f / D) + EPS);
#pragma unroll
                for (int j = 0; j < 4; ++j) { const f32x4 gg = gg4[j]; f32x4 y; y.x = v[j2][j].x * rs * gg.x; y.y = v[j2][j].y * rs * gg.y; y.z = v[j2][j].z * rs * gg.z; y.w = v[j2][j].w * rs * gg.w; __builtin_nontemporal_store(y, (f32x4*)(dst + (size_t)tok * D) + lane + 64 * j); }
            }
        }
    }
#undef IN
#undef BOTH
#undef SEAM
}

extern "C" void kernel_launch(void* const* d_in, const int* in_sizes, int n_in, void* d_out, int out_size, void* d_ws, size_t ws_size, hipStream_t stream) {
    if (n_in != 25 || out_size != T * D || ws_size < WS_END) { fprintf(stderr, "kernel_launch: unexpected shapes n_in %d out %d ws %zu\n", n_in, out_size, ws_size); return; }
    Ptrs p{};
    for (int i = 0; i < 25; ++i) p.in[i] = (const float*)d_in[i];
    p.out = (float*)d_out; p.ws = (unsigned char*)d_ws;
    (void)hipMemsetAsync((char*)d_ws + WS_CTL, 0, CTL_BYTES, stream);
    static int grid = 0;
    if (grid == 0) {
        int dev = 0, cus = 0;
        if (hipGetDevice(&dev) != hipSuccess || hipDeviceGetAttribute(&cus, hipDeviceAttributeMultiprocessorCount, dev) != hipSuccess) { grid = -1; return; }
        if (hipFuncSetAttribute((const void*)mk_fwd, hipFuncAttributeMaxDynamicSharedMemorySize, LDS_BYTES) != hipSuccess) { fprintf(stderr, "hipFuncSetAttribute failed\n"); grid = -1; return; }
        int per_cu = 0;
        if (hipOccupancyMaxActiveBlocksPerMultiprocessor(&per_cu, (const void*)mk_fwd, NWAVES * 64, LDS_BYTES) != hipSuccess || per_cu < 1) { fprintf(stderr, "occupancy query: %d\n", per_cu); }
        (void)hipGetLastError();
        grid = cus;
    }
    if (grid < 0) return;
#if defined(PROBE_SPLIT)
    { const int k = PROBE_SPLIT; const int reps = PROBE_REPS;
      MKArgs a{}; a.p = p; a.ph_lo = 0; a.ph_hi = k + 1; a.li = 0; hipLaunchKernelGGL(mk_fwd, dim3(grid), dim3(NWAVES * 64), LDS_BYTES, stream, a);
      for (int r = 0; r < reps; ++r) { if (k == 4) (void)hipMemsetAsync((char*)d_ws + WS_CTL + CW_CNT * 4, 0, 128, stream);
          a.ph_lo = k; a.ph_hi = k + 1; hipLaunchKernelGGL(mk_fwd, dim3(grid), dim3(NWAVES * 64), LDS_BYTES, stream, a); }
      a.ph_lo = k + 1; a.ph_hi = 8; a.li = 1; hipLaunchKernelGGL(mk_fwd, dim3(grid), dim3(NWAVES * 64), LDS_BYTES, stream, a); }
#elif !defined(MK_PER_PHASE)
    { MKArgs a{}; a.p = p; a.ph_lo = 0; a.ph_hi = 8; hipLaunchKernelGGL(mk_fwd, dim3(grid), dim3(NWAVES * 64), LDS_BYTES, stream, a); }
#else
    for (int ph = 0; ph < 8; ++ph) { MKArgs a{}; a.p = p; a.ph_lo = ph; a.ph_hi = ph + 1; hipLaunchKernelGGL(mk_fwd, dim3(grid), dim3(NWAVES * 64), LDS_BYTES, stream, a); }
#endif
}
```
